# Optimizing an MI355X kernel written in HIP

```python
import jax, jax.numpy as jnp
from jax import lax
import numpy as np

D_MODEL = 1024
BATCH = 4
SEQ = 8192
DEPTH = 4

CTX_LEN = 256
GRID_W = 64
NORM_EPS = 1e-6
NEG_INF = -1e30

POOL_WINDOWS = (2, 4, 8, 16)
POOL_GROUPS = len(POOL_WINDOWS)
POOL_GROUP_DIM = D_MODEL // 16
POOL_DIM = POOL_GROUPS * POOL_GROUP_DIM

HEAD_DIM = 64
ATTN_HEADS = D_MODEL // 128
ATTN_KV_HEADS = ATTN_HEADS // 4
Q_PER_KV = ATTN_HEADS // ATTN_KV_HEADS
ATTN_DIM = ATTN_HEADS * HEAD_DIM
KV_DIM = ATTN_KV_HEADS * HEAD_DIM
ATTN_WINDOW = 128
ATTN_BLOCK = 128
ROPE_BASE = 10000.0
ROPE_AXIS_DIM = HEAD_DIM // 2

HG_HEADS = 4
HG_DIM = 64
HG_WIDTH = HG_HEADS * HG_DIM
HG_CHUNK = 64

MIX_WIDTH = POOL_DIM + ATTN_DIM + HG_WIDTH
IN_SIZES = (POOL_DIM, ATTN_DIM, KV_DIM, KV_DIM, HG_WIDTH, HG_WIDTH, HG_WIDTH, HG_WIDTH, HG_WIDTH)
IN_SPLITS = tuple(sum(IN_SIZES[:i + 1]) for i in range(len(IN_SIZES) - 1))
IN_COLS = sum(IN_SIZES)

N_GROUPS = 4
EXPERTS_PER_GROUP = 8
N_EXPERTS = N_GROUPS * EXPERTS_PER_GROUP
TOP_K = 2
EXPERT_HIDDEN = D_MODEL // 2
MOE_BLOCK = 256

kernel_name = 'hybrid_pool_swa_hgrn2_hmoe_dit'


def rms_norm(t, g):
    tf = t.astype(jnp.float32)
    y = tf * lax.rsqrt(jnp.mean(tf * tf, axis=-1, keepdims=True) + NORM_EPS)
    return (y * g.astype(jnp.float32)).astype(t.dtype)


def modulate(t, g, shift, scale):
    return rms_norm(t, g) * (1.0 + scale) + shift


def to_heads(t, n):
    return t.reshape(t.shape[0], t.shape[1], n, t.shape[-1] // n)


def axial_rope(n_rows):
    row = jnp.repeat(jnp.arange(n_rows, dtype=jnp.float32), GRID_W)
    col = jnp.tile(jnp.arange(GRID_W, dtype=jnp.float32), n_rows)
    inv = ROPE_BASE ** (-jnp.arange(0, ROPE_AXIS_DIM, 2, dtype=jnp.float32) / ROPE_AXIS_DIM)
    ang = jnp.concatenate([row[:, None] * inv, col[:, None] * inv], axis=-1)
    return jnp.cos(ang), jnp.sin(ang)


def apply_rope(t, cos, sin):
    tf = t.astype(jnp.float32)
    half = HEAD_DIM // 2
    t1, t2 = tf[..., :half], tf[..., half:]
    c, s = cos[:, None, :], sin[:, None, :]
    return jnp.concatenate([t1 * c - t2 * s, t2 * c + t1 * s], axis=-1).astype(t.dtype)


def pool_mixer(u, pool_w, pool_scale):
    B_, L, _ = u.shape
    uf = u.astype(jnp.float32)
    cs = jnp.concatenate([jnp.zeros((B_, 1, POOL_DIM), jnp.float32), jnp.cumsum(uf, axis=1)], axis=1)
    t = jnp.arange(L)
    means = []
    for gi, w in enumerate(POOL_WINDOWS):
        lo = jnp.clip(t - (w - 1) // 2, 0, L)
        hi = jnp.clip(t + w // 2 + 1, 0, L)
        csg = cs[..., gi * POOL_GROUP_DIM:(gi + 1) * POOL_GROUP_DIM]
        means.append((csg[:, hi] - csg[:, lo]) / (hi - lo).astype(jnp.float32)[None, :, None])
    pooled = jnp.concatenate(means, axis=-1) - uf
    y = jnp.einsum('blgc,gcd->blgd', pooled.reshape(B_, L, POOL_GROUPS, POOL_GROUP_DIM),
                   pool_w.astype(jnp.float32))
    return y.reshape(B_, L, POOL_DIM) * pool_scale.astype(jnp.float32)


def windowed_sink_attention(q, k, v, kc, vc, sink):
    B_, L = q.shape[:2]
    nb = L // ATTN_BLOCK
    scale = HEAD_DIM ** -0.5
    qb = q.reshape(B_, nb, ATTN_BLOCK, ATTN_KV_HEADS, Q_PER_KV, HEAD_DIM)

    def band_blocks(t):
        tp = jnp.pad(t, ((0, 0), (ATTN_BLOCK, ATTN_BLOCK), (0, 0), (0, 0)))
        tp = tp.reshape(B_, nb + 2, ATTN_BLOCK, ATTN_KV_HEADS, HEAD_DIM)
        return jnp.concatenate([tp[:, :-2], tp[:, 1:-1], tp[:, 2:]], axis=2)

    kb, vb = band_blocks(k), band_blocks(v)
    q_pos = jnp.arange(L).reshape(nb, ATTN_BLOCK)
    k_pos = jnp.arange(nb)[:, None] * ATTN_BLOCK - ATTN_BLOCK + jnp.arange(3 * ATTN_BLOCK)[None, :]
    band = ((jnp.abs(q_pos[:, :, None] - k_pos[:, None, :]) <= ATTN_WINDOW)
            & (k_pos[:, None, :] >= 0) & (k_pos[:, None, :] < L))
    s_loc = jnp.einsum('bnqkgd,bnskd->bkgnqs', qb, kb).astype(jnp.float32) * scale
    s_loc = jnp.where(band, s_loc, NEG_INF)
    s_ctx = jnp.einsum('bnqkgd,bckd->bkgnqc', qb, kc).astype(jnp.float32) * scale
    sink_l = jnp.broadcast_to(sink.astype(jnp.float32).reshape(1, ATTN_KV_HEADS, Q_PER_KV, 1, 1, 1),
                              s_loc.shape[:-1] + (1,))
    p = jax.nn.softmax(jnp.concatenate([s_loc, s_ctx, sink_l], axis=-1), axis=-1)
    n_loc = 3 * ATTN_BLOCK
    n_ctx = kc.shape[1]
    p_loc = p[..., :n_loc].astype(v.dtype)
    p_ctx = p[..., n_loc:n_loc + n_ctx].astype(v.dtype)
    o = (jnp.einsum('bkgnqs,bnskd->bnqkgd', p_loc, vb)
         + jnp.einsum('bkgnqc,bckd->bnqkgd', p_ctx, vc))
    return o.reshape(B_, L, ATTN_DIM)


def context_attention(qc, kc, vc, sink):
    B_, C = qc.shape[:2]
    qb = qc.reshape(B_, C, ATTN_KV_HEADS, Q_PER_KV, HEAD_DIM)
    s = jnp.einsum('bqkgd,bckd->bkgqc', qb, kc).astype(jnp.float32) * (HEAD_DIM ** -0.5)
    sink_c = jnp.broadcast_to(sink.astype(jnp.float32).reshape(1, ATTN_KV_HEADS, Q_PER_KV, 1, 1),
                              s.shape[:-1] + (1,))
    p = jax.nn.softmax(jnp.concatenate([s, sink_c], axis=-1), axis=-1)[..., :C]
    o = jnp.einsum('bkgqc,bckd->bqkgd', p.astype(vc.dtype), vc)
    return o.reshape(B_, C, ATTN_DIM)


def gla_chunk_scan(q, k, v, log_f, s0):
    B_, L, H, _ = q.shape
    dv = v.shape[-1]
    nc = L // HG_CHUNK

    def chunks(t):
        return t.astype(jnp.float32).reshape(B_, nc, HG_CHUNK, H, t.shape[-1]).transpose(1, 0, 3, 2, 4)

    tri = jnp.tril(jnp.ones((HG_CHUNK, HG_CHUNK), bool))[:, :, None]

    def step(S, inp):
        qi, ki, vi, gi = inp
        b = jnp.cumsum(gi, axis=2)
        diff = b[:, :, :, None, :] - b[:, :, None, :, :]
        decay = jnp.exp(jnp.where(tri, diff, NEG_INF))
        scores = jnp.einsum('bhtd,bhsd,bhtsd->bhts', qi, ki, decay)
        o = (jnp.einsum('bhts,bhsv->bhtv', scores, vi)
             + jnp.einsum('bhtd,bhdv->bhtv', qi * jnp.exp(b), S))
        b_end = b[:, :, -1:, :]
        S_new = (jnp.exp(b_end[:, :, 0, :])[..., None] * S
                 + jnp.einsum('bhsd,bhsv->bhdv', ki * jnp.exp(b_end - b), vi))
        return S_new, o

    s_fin, oc = lax.scan(step, s0.astype(jnp.float32), (chunks(q), chunks(k), chunks(v), chunks(log_f)))
    return oc.transpose(1, 0, 3, 2, 4).reshape(B_, L, H, dv), s_fin


def hgrn_forget(z, lb):
    f = lb + (1.0 - lb) * jax.nn.sigmoid(z)
    return jnp.log(f), (1.0 - lb) * jax.nn.sigmoid(-z)


def hgrn_prepare(parts, lb_f, lb_b):
    hq, hi, hzf, hzb, hgate = parts
    heads = lambda t: to_heads(t.astype(jnp.float32), HG_HEADS)
    q = jax.nn.silu(heads(hq))
    v = heads(hi)
    gf, kf = hgrn_forget(heads(hzf), lb_f.reshape(HG_HEADS, HG_DIM))
    gb, kb = hgrn_forget(heads(hzb), lb_b.reshape(HG_HEADS, HG_DIM))
    return q, v, gf, kf, gb, kb, heads(hgate)


def hgrn_readout(o, gate, norm_g):
    B_, L = o.shape[:2]
    return (rms_norm(o, norm_g) * jax.nn.silu(gate)).reshape(B_, L, HG_WIDTH)


def hgrn_mixer(lat_parts, ctx_parts, lb_f, lb_b, norm_g, ctx_out):
    q, v, gf, kf, gb, kb, gate = hgrn_prepare(lat_parts, lb_f, lb_b)
    qc, vc, gfc, kfc, gbc, kbc, gatec = hgrn_prepare(ctx_parts, lb_f, lb_b)
    rev = lambda t: jnp.flip(t, axis=1)
    s0 = jnp.zeros((q.shape[0], HG_HEADS, HG_DIM, HG_DIM), jnp.float32)
    oc_f, sc_f = gla_chunk_scan(qc, kfc, vc, gfc, s0)
    oc_b, sc_b = gla_chunk_scan(rev(qc), rev(kbc), rev(vc), rev(gbc), s0)
    o_f, _ = gla_chunk_scan(q, kf, v, gf, sc_f)
    o_b, _ = gla_chunk_scan(rev(q), rev(kb), rev(v), rev(gb), sc_b)
    out = hgrn_readout(o_f + rev(o_b), gate, norm_g)
    out_c = hgrn_readout(oc_f + rev(oc_b), gatec, norm_g) if ctx_out else None
    return out, out_c


def token_mixers(p, pc, pool_w, pool_scale, q_norm_g, k_norm_g, sink, lb_f, lb_b, hg_norm_g,
                 cos, sin, ctx_out):
    u, q, k, v, hq, hi, hzf, hzb, hgate = jnp.split(p, IN_SPLITS, axis=-1)
    uc, qc, kc, vc, hqc, hic, hzfc, hzbc, hgatec = jnp.split(pc, IN_SPLITS, axis=-1)
    dt = p.dtype
    a = pool_mixer(u, pool_w, pool_scale)
    q = apply_rope(rms_norm(to_heads(q, ATTN_HEADS), q_norm_g), cos, sin)
    k = apply_rope(rms_norm(to_heads(k, ATTN_KV_HEADS), k_norm_g), cos, sin)
    v = to_heads(v, ATTN_KV_HEADS)
    kc = rms_norm(to_heads(kc, ATTN_KV_HEADS), k_norm_g)
    vc = to_heads(vc, ATTN_KV_HEADS)
    b = windowed_sink_attention(q, k, v, kc, vc, sink)
    c_lat, c_ctx = hgrn_mixer((hq, hi, hzf, hzb, hgate), (hqc, hic, hzfc, hzbc, hgatec),
                              lb_f, lb_b, hg_norm_g, ctx_out)
    mix = jnp.concatenate([a.astype(dt), b.astype(dt), c_lat.astype(dt)], axis=-1)
    if not ctx_out:
        return mix, None
    ac = pool_mixer(uc, pool_w, pool_scale)
    bc = context_attention(rms_norm(to_heads(qc, ATTN_HEADS), q_norm_g), kc, vc, sink)
    mixc = jnp.concatenate([ac.astype(dt), bc.astype(dt), c_ctx.astype(dt)], axis=-1)
    return mix, mixc


def expert_ffn(h, expert_idx, gate_w, w_gate, w_up, w_down):
    T, D = h.shape
    A = T * TOP_K
    flat_e = expert_idx.reshape(-1)
    order = jnp.argsort(flat_e)
    sorted_e = flat_e[order]
    counts = jnp.bincount(flat_e, length=N_EXPERTS)
    padded = ((counts + MOE_BLOCK - 1) // MOE_BLOCK) * MOE_BLOCK
    padded_end = jnp.cumsum(padded)
    padded_start = padded_end - padded
    start = jnp.cumsum(counts) - counts
    dest = padded_start[sorted_e] + (jnp.arange(A) - start[sorted_e])
    n_blocks = -(-A // MOE_BLOCK) + N_EXPERTS
    P = n_blocks * MOE_BLOCK
    token_sorted = (order // TOP_K).astype(jnp.int32)
    token_of_slot = jnp.zeros((P,), jnp.int32).at[dest].set(token_sorted)
    block_expert = jnp.minimum(
        jnp.searchsorted(padded_end, jnp.arange(n_blocks) * MOE_BLOCK, side='right'), N_EXPERTS - 1)
    xs = h[token_of_slot].reshape(n_blocks, MOE_BLOCK, D)

    def run(args):
        xb, e = args
        hid = jax.nn.silu(xb @ w_gate[e]) * (xb @ w_up[e])
        return hid @ w_down[e]

    ys = lax.map(run, (xs, block_expert)).reshape(P, D)
    contrib = ys[dest].astype(jnp.float32) * gate_w.reshape(-1)[order][:, None]
    return jax.ops.segment_sum(contrib, token_sorted, num_segments=T).astype(h.dtype)


def hier_moe(h, wg, bg, we, be, w_gate, w_up, w_down):
    T = h.shape[0]
    lg = (h @ wg + bg).astype(jnp.float32)
    pg = jax.nn.softmax(lg, axis=-1)
    _, g_idx = lax.top_k(lg, 1)
    p_grp = jnp.take_along_axis(pg, g_idx, axis=-1)
    le = (h @ we + be).astype(jnp.float32).reshape(T, N_GROUPS, EXPERTS_PER_GROUP)
    le = jnp.take_along_axis(le, g_idx[:, :, None], axis=1)[:, 0]
    pe = jax.nn.softmax(le, axis=-1)
    w_top, e_top = lax.top_k(pe, TOP_K)
    w_top = w_top / jnp.sum(w_top, axis=-1, keepdims=True)
    expert_idx = g_idx * EXPERTS_PER_GROUP + e_top
    return expert_ffn(h, expert_idx, p_grp * w_top, w_gate, w_up, w_down)


def setup_inputs(seed: int = 0) -> dict:
    key = jax.random.key(seed)
    ks = jax.random.split(key, 24)
    f32 = jnp.float32
    d = D_MODEL

    def nrm(k, shape, s):
        return jax.random.normal(k, shape, f32) * s

    return {
        'x': nrm(ks[0], (BATCH, SEQ, d), 1.0),
        'c': nrm(ks[1], (BATCH, d), 1.0),
        'ctx': nrm(ks[2], (BATCH, CTX_LEN, d), 1.0),
        'c_ctx': nrm(ks[3], (d,), 1.0),
        'norm1_g': 1.0 + nrm(ks[4], (DEPTH, d), 0.05),
        'norm2_g': 1.0 + nrm(ks[5], (DEPTH, d), 0.05),
        'ada_w': nrm(ks[6], (DEPTH, d, 6 * d), 0.5 * d ** -0.5),
        'ada_b': nrm(ks[7], (DEPTH, 6 * d), 0.02),
        'w_in': nrm(ks[8], (DEPTH, d, IN_COLS), d ** -0.5),
        'w_out': nrm(ks[9], (DEPTH, MIX_WIDTH, d), MIX_WIDTH ** -0.5),
        'pool_w': nrm(ks[10], (DEPTH, POOL_GROUPS, POOL_GROUP_DIM, POOL_GROUP_DIM), POOL_GROUP_DIM ** -0.5),
        'pool_scale': 1.0 + nrm(ks[11], (DEPTH, POOL_DIM), 0.1),
        'q_norm_g': 1.0 + nrm(ks[12], (DEPTH, HEAD_DIM), 0.05),
        'k_norm_g': 1.0 + nrm(ks[13], (DEPTH, HEAD_DIM), 0.05),
        'attn_sink': nrm(ks[14], (DEPTH, ATTN_HEADS), 0.5),
        'hgrn_lb': nrm(ks[15], (DEPTH, 2, HG_WIDTH), 0.5),
        'hgrn_norm_g': 1.0 + nrm(ks[16], (DEPTH, HG_DIM), 0.05),
        'router_group_w': nrm(ks[17], (DEPTH, d, N_GROUPS), d ** -0.5),
        'router_group_b': nrm(ks[18], (DEPTH, N_GROUPS), 0.01),
        'router_expert_w': nrm(ks[19], (DEPTH, d, N_EXPERTS), d ** -0.5),
        'router_expert_b': nrm(ks[20], (DEPTH, N_EXPERTS), 0.01),
        'expert_w_gate': nrm(ks[21], (DEPTH, N_EXPERTS, d, EXPERT_HIDDEN), d ** -0.5),
        'expert_w_up': nrm(ks[22], (DEPTH, N_EXPERTS, d, EXPERT_HIDDEN), d ** -0.5),
        'expert_w_down': nrm(ks[23], (DEPTH, N_EXPERTS, EXPERT_HIDDEN, d), EXPERT_HIDDEN ** -0.5),
    }


def reference(x, c, ctx, c_ctx, norm1_g, norm2_g, ada_w, ada_b, w_in, w_out, pool_w, pool_scale,
              q_norm_g, k_norm_g, attn_sink, hgrn_lb, hgrn_norm_g, router_group_w, router_group_b,
              router_expert_w, router_expert_b, expert_w_gate, expert_w_up, expert_w_down):
    B_, L, _ = x.shape
    C = ctx.shape[1]
    n_rows = L // GRID_W
    cos, sin = axial_rope(n_rows)
    sm = jax.nn.softmax(hgrn_lb.astype(jnp.float32), axis=0)
    lb_all = jnp.cumsum(sm, axis=0) - sm[0]
    s_lat = jax.nn.silu(c)
    s_ctx = jax.nn.silu(c_ctx)
    for l in range(DEPTH):
        ctx_out = l < DEPTH - 1
        mod = (s_lat @ ada_w[l] + ada_b[l])[:, None, :]
        modc = s_ctx @ ada_w[l] + ada_b[l]
        sh1, sc1, g1, sh2, sc2, g2 = jnp.split(mod, 6, axis=-1)
        csh1, csc1, cg1, csh2, csc2, cg2 = jnp.split(modc, 6, axis=-1)
        h = modulate(x, norm1_g[l], sh1, sc1)
        hc = modulate(ctx, norm1_g[l], csh1, csc1)
        mix, mixc = token_mixers(h @ w_in[l], hc @ w_in[l], pool_w[l], pool_scale[l], q_norm_g[l],
                                 k_norm_g[l], attn_sink[l], lb_all[l, 0], lb_all[l, 1], hgrn_norm_g[l],
                                 cos, sin, ctx_out)
        x = x + g1 * (mix @ w_out[l])
        h2 = modulate(x, norm2_g[l], sh2, sc2).reshape(B_ * L, D_MODEL)
        moe_args = (router_group_w[l], router_group_b[l], router_expert_w[l], router_expert_b[l],
                    expert_w_gate[l], expert_w_up[l], expert_w_down[l])
        if ctx_out:
            ctx = ctx + cg1 * (mixc @ w_out[l])
            h2c = modulate(ctx, norm2_g[l], csh2, csc2).reshape(B_ * C, D_MODEL)
            y = hier_moe(jnp.concatenate([h2, h2c], axis=0), *moe_args)
            x = x + g2 * y[:B_ * L].reshape(B_, L, D_MODEL)
            ctx = ctx + cg2 * y[B_ * L:].reshape(B_, C, D_MODEL)
        else:
            y = hier_moe(h2, *moe_args)
            x = x + g2 * y.reshape(B_, L, D_MODEL)
    return x
```

```cpp
#include <hip/hip_runtime.h>
#include <cstdio>
#include <cstdint>

#define DI __device__ __forceinline__
#define LAS __attribute__((address_space(3)))
#define GAS __attribute__((address_space(1)))
typedef _Float16 f16;
typedef _Float16 f16x8 __attribute__((ext_vector_type(8)));
typedef _Float16 f16x4 __attribute__((ext_vector_type(4)));
typedef _Float16 f16x2 __attribute__((ext_vector_type(2)));
typedef short s16x8 __attribute__((ext_vector_type(8)));
typedef short s16x4 __attribute__((ext_vector_type(4)));
typedef float f32x4 __attribute__((ext_vector_type(4)));
typedef float f32x2 __attribute__((ext_vector_type(2)));
typedef float f32x16 __attribute__((ext_vector_type(16)));
typedef unsigned u32x4 __attribute__((ext_vector_type(4)));
typedef unsigned u32x2 __attribute__((ext_vector_type(2)));
typedef LAS unsigned char* ldsp;

constexpr int DM = 1024, NB = 4, SEQ = 8192, CTXL = 256, DEPTH = 4;
constexpr int TL = NB * SEQ, TC = NB * CTXL, TT = TL + TC;
constexpr int INC = 2304;
constexpr int C_U = 0, C_Q = 256, C_K = 768, C_V = 896, C_HQ = 1024, C_HI = 1280, C_HZF = 1536, C_HZB = 1792, C_HG = 2048;
constexpr int NEXP = 32, EH = 512;
constexpr int NPOS = 132;
constexpr float EPS = 1e-6f;
constexpr float LOG2E = 1.4426950408889634f;
constexpr int MAXBLK = 296;

constexpr size_t MiB = 1u << 20;
constexpr size_t WS_CTL = 0, CTL_ZERO_BYTES = 1 * MiB;
constexpr size_t WS_WIN = 1 * MiB;
constexpr size_t WS_WOUT = WS_WIN + (size_t)DEPTH * INC * DM * 2;
constexpr size_t WS_WGU = WS_WOUT + (size_t)DEPTH * DM * DM * 2;
constexpr size_t WS_WD = WS_WGU + (size_t)DEPTH * NEXP * 1024 * 1024 * 2;
constexpr size_t WS_POOLW = WS_WD + (size_t)DEPTH * NEXP * 1024 * 512 * 2;
constexpr size_t WS_WR = WS_POOLW + (size_t)DEPTH * 4 * 64 * 64 * 2;
constexpr size_t WS_MOD = WS_WR + (size_t)DEPTH * 1024 * 48 * 4;
constexpr size_t WS_LB = WS_MOD + (size_t)DEPTH * 5 * 6144 * 4;
constexpr size_t WS_ROPE = WS_LB + (size_t)DEPTH * 2 * 256 * 4;
constexpr size_t WS_XC = WS_ROPE + (size_t)(2 * 128 * 16 + 2 * 64 * 16) * 4;
constexpr size_t WS_GATES = WS_XC + (size_t)TC * DM * 4;
constexpr size_t WS_LIST = WS_GATES + (size_t)TT * 2 * 4;
constexpr size_t WS_H = WS_LIST + (size_t)NEXP * TT * 4;
constexpr size_t WS_P = WS_H + (size_t)TT * DM * 2;
constexpr size_t WS_Y2 = WS_P;
constexpr size_t WS_QN = WS_P + (size_t)TT * INC * 2;
constexpr size_t WS_KN = WS_QN + (size_t)TT * 512 * 2;
constexpr size_t WS_MIX = WS_KN + (size_t)TT * 128 * 2;
constexpr size_t WS_HS = WS_MIX + (size_t)TT * DM * 2;
constexpr size_t WS_HA = WS_HS + (size_t)2 * NB * NPOS * 4 * 4096 * 4;
constexpr size_t WS_END0 = WS_HA + (size_t)2 * NB * NPOS * 4 * 64 * 4;
constexpr size_t WS_HID = WS_QN;
constexpr size_t WS_END = WS_END0;
static_assert((size_t)2 * TT * DM * 2 <= (size_t)TT * INC * 2, "Y2 fits in P");
static_assert(WS_HID + (size_t)MAXBLK * 256 * EH * 2 <= WS_END0, "HID fits in its overlay");
static_assert(WS_WIN % 256 == 0 && WS_H % 256 == 0 && WS_P % 256 == 0 && WS_QN % 256 == 0 && WS_KN % 256 == 0 && WS_MIX % 256 == 0 && WS_HS % 256 == 0 && WS_HA % 256 == 0 && WS_XC % 256 == 0 && WS_LIST % 256 == 0 && WS_GATES % 256 == 0, "alignment");
constexpr int CW_BAR = 4096;
constexpr int CW_CNT = 16384;
constexpr int RING_BYTES = 131072;
constexpr int MISC_OFF = RING_BYTES;
constexpr int BLK_OFF = MISC_OFF + 512;
constexpr int LDS_BYTES = 147456;

struct Params {
    const float *x, *c, *ctx, *c_ctx, *norm1_g, *norm2_g, *ada_w, *ada_b, *w_in, *w_out, *pool_w, *pool_scale, *q_norm_g, *k_norm_g, *attn_sink, *hgrn_lb,
        *hgrn_norm_g, *rgw, *rgb, *rew, *reb, *ewg, *ewu, *ewd;
    float* out; unsigned char* ws;
};

DI unsigned short f2bf(float f) { unsigned u = __builtin_bit_cast(unsigned, f); return (unsigned short)((u + 0x7fffu + ((u >> 16) & 1u)) >> 16); }
DI float wave_sum(float v) {
#pragma unroll
    for (int o = 1; o < 64; o <<= 1) v += __shfl_xor(v, o);
    return v;
}
DI float siluf(float v) { return v / (1.f + __expf(-v)); }
DI int modb_of_row(int row) { return row < TL ? (row >> 13) : 4; }

#define XB_TMO      128
#define XB_XCNT(j)  (256  + 64 * (j))
#define XB_XSUB(j)  (1280 + 64 * (j))
#define XB_XGEN(j)  (2304 + 64 * (j))
#define XB_TOP      3328
#define XB_TOPGEN   3392
#define XCD_BAR_WORDS 3456
#define XB_SPIN_CAP (1u << 18)
__device__ __forceinline__ unsigned xb_ld(unsigned* p)              { return __hip_atomic_load(p, __ATOMIC_RELAXED, __HIP_MEMORY_SCOPE_AGENT); }
__device__ __forceinline__ unsigned xb_add(unsigned* p, unsigned v) { return __hip_atomic_fetch_add(p, v, __ATOMIC_RELAXED, __HIP_MEMORY_SCOPE_AGENT); }
__device__ __forceinline__ unsigned xb_xcc_id() { return (unsigned)__builtin_amdgcn_s_getreg((3 << 11) | 20) & 0xFu; }
#define XB_SPIN(cond, bar) do { unsigned _sp = 0; while (cond) { __builtin_amdgcn_s_sleep(1); \
    if ((++_sp & 255u) == 0u) { if (xb_ld(&(bar)[XB_TMO])) break; if (_sp > XB_SPIN_CAP) { atomicAdd(&(bar)[XB_TMO], 1u); break; } } } } while (0)
struct XcdBarrier { unsigned* bar; unsigned x; volatile LAS unsigned* st; };
__device__ __forceinline__ XcdBarrier xcd_barrier_post(unsigned* bar, volatile LAS unsigned* st) {
    XcdBarrier b; b.bar = bar; b.x = xb_xcc_id(); b.st = st;
    if (threadIdx.x == 0) (void)xb_add(&bar[XB_XCNT(b.x)], 1u);
    return b;
}
__device__ __forceinline__ void xcd_barrier_complete(unsigned* bar, unsigned x, unsigned& nloc, unsigned& nx) {
    const unsigned G = gridDim.x * gridDim.y * gridDim.z;
    unsigned sum, cnt, mine, sp = 0u;
    for (;;) {
        sum = 0u; cnt = 0u; mine = 0u;
#pragma unroll 1
        for (unsigned j = 0; j < 16; ++j) { const unsigned c = xb_ld(&bar[XB_XCNT(j)]); sum += c; cnt += (c > 0u) ? 1u : 0u; mine = (j == x) ? c : mine; }
        if (sum == G) break;
        __builtin_amdgcn_s_sleep(1);
        if ((++sp & 255u) == 0u) { if (xb_ld(&bar[XB_TMO])) break; if (sp > XB_SPIN_CAP) { atomicAdd(&bar[XB_TMO], 1u); break; } }
    }
    nloc = mine > 0u ? mine : 1u; nx = cnt > 0u ? cnt : 1u;
}
__device__ __forceinline__ void xcd_barrier(const XcdBarrier& b) {
    asm volatile("s_waitcnt vmcnt(0)" ::: "memory");
    __syncthreads();
    if (threadIdx.x == 0) {
        unsigned* bar = b.bar;
        __builtin_amdgcn_s_waitcnt(0);
        unsigned nloc = b.st[0], nx = b.st[1];
        if (nloc == 0u) { xcd_barrier_complete(bar, b.x, nloc, nx); b.st[0] = nloc; b.st[1] = nx; }
        const unsigned old = xb_add(&bar[XB_XSUB(b.x)], 1u);
        const unsigned gen = old / nloc;
        if (old + 1u == (gen + 1u) * nloc) {
            __builtin_amdgcn_fence(__ATOMIC_RELEASE, "agent");
            asm volatile("s_waitcnt vmcnt(0)" ::: "memory");
            const unsigned og = xb_add(&bar[XB_TOP], 1u);
            const unsigned tg = og / nx;
            if (og + 1u == (tg + 1u) * nx) xb_add(&bar[XB_TOPGEN], 1u);
            else XB_SPIN(xb_ld(&bar[XB_TOPGEN]) == tg, bar);
            __builtin_amdgcn_fence(__ATOMIC_ACQUIRE, "agent");
            xb_add(&bar[XB_XGEN(b.x)], 1u);
            asm volatile("s_waitcnt vmcnt(0)" ::: "memory");
        } else {
            XB_SPIN(xb_ld(&bar[XB_XGEN(b.x)]) == gen, bar);
            __builtin_amdgcn_fence(__ATOMIC_ACQUIRE, "agent");
            asm volatile("s_waitcnt vmcnt(0)" ::: "memory");
        }
    }
    __syncthreads();
}

namespace pg8 {
constexpr int BM = 256, BK = 64, HALF = 128, HTB = HALF * BK * 2, STAGE_BYTES = 8 * HTB, NXCD = 8, WGM = 8;
DI int lds_byte(int r, int c) { const int st = (r >> 4) * 2 + (c >> 5), rr = r & 15, cc = c & 31, ob = rr * 64 + cc * 2; return st * 1024 + (ob ^ (((ob >> 9) & 1) << 5)); }
DI void stage_rc(int b, int& R, int& C) { const int st = b / 1024, sb = b % 1024, swz = sb ^ (((sb >> 9) & 1) << 5); R = (st >> 1) * 16 + swz / 64; C = (st & 1) * 32 + (swz % 64) / 2; }
DI int perm32(int rho) { const int n = rho >> 4, i = rho & 15; return 8 * (i >> 2) + 4 * n + (i & 3); }

struct Unit { int pm, pn, e, lrb; };
struct Gemm { const f16* A; const f16* Bt; int K; size_t bstride; };

struct StaticOrder {
    int nM, nN, nwg, G, c;
    DI void init(int M, int N, int G_, int c_) { nM = M / BM; nN = N / BM; nwg = nM * nN; G = G_; c = c_; }
    DI bool next(int i, Unit& u) const {
        const long L = (long)i * G + c; if (L >= nwg) return false;
        int wgid = (int)L; { const int q = nwg / NXCD, r = nwg % NXCD, xcd = wgid % NXCD, off = wgid / NXCD; wgid = (xcd < r ? xcd * (q + 1) : r * (q + 1) + (xcd - r) * q) + off; }
        const int nig = WGM * nN, gid = wgid / nig, fm = gid * WGM, gsz = (nM - fm) < WGM ? (nM - fm) : WGM;
        u.pm = fm + ((wgid % nig) % gsz); u.pn = (wgid % nig) / gsz; u.e = 0; u.lrb = 0; return true;
    }
    DI unsigned arow(const Unit&, int) const { return 0u; }
};
struct MoeOrder {
    int G, c, nblk; const LAS int* blk; const LAS int* cnt; const int* list; int rowbytes;
    DI bool next(int i, Unit& u) const {
        const int L = i * G + c; if (L >= nblk * 4) return false;
        const int rb = L >> 2; u.pn = L & 3; u.pm = rb;
        int e = 0;
#pragma unroll 1
        for (int j = 1; j < NEXP; ++j) e = (blk[j] <= rb) ? j : e;
        u.e = e; u.lrb = rb - blk[e]; return true;
    }
    DI unsigned arow(const Unit& u, int r) const {
        const int pos = u.lrb * 256 + r; const int ent = (pos < cnt[u.e]) ? list[(size_t)u.e * TT + pos] : 0;
        return (unsigned)(ent >> 1) * (unsigned)rowbytes;
    }
};

template <class Epi, class Sched, bool ALIGN_EPI, bool GATHER>
DI void gemm_phase(ldsp lds, const Gemm g, const Sched& S, const Epi& E) {
    const int tid = threadIdx.x, wid = __builtin_amdgcn_readfirstlane(tid >> 6), lane = tid & 63, wr = wid >> 2, wc = wid & 3, fr = lane & 15, fq = lane >> 4;
    const int K = g.K, nt = K / BK;
    int Rr[2], Cc[2]; unsigned voffB[2], voffA[2];
#pragma unroll
    for (int i = 0; i < 2; ++i) { int R, C; stage_rc(tid * 16 + i * 8192, R, C); const int Rb = Epi::PERM ? ((R & ~31) + perm32(R & 31)) : R;
        Rr[i] = R; Cc[i] = C; voffB[i] = (unsigned)(Rb * K + C) * 2u; voffA[i] = (unsigned)(R * K + C) * 2u; }
    const size_t kstep = (size_t)(BK * 2);
    const size_t hstep = (size_t)HALF * K * 2;
    const size_t tstep = 2 * hstep;
    const unsigned ldsw = (unsigned)wid * 1024u;
    const int aoff = lds_byte(wr * 64 + fr, fq * 8), boff = lds_byte(wc * 32 + fr, fq * 8);
    const char* const Ab = (const char*)g.A;
#define PG8_SA(b, h) (((b) * 2 + (h)) * HTB)
#define PG8_SB(b, h) ((4 + (b) * 2 + (h)) * HTB)
#define PG8_STAGE(bufoff, gbase, voff) do { _Pragma("unroll") for (int _i = 0; _i < 2; ++_i) \
        __builtin_amdgcn_global_load_lds((const unsigned*)((const char*)(gbase) + (voff)[_i]), (LAS unsigned*)(lds + (bufoff) + ldsw + _i * 8192), 16, 0, 0); } while (0)
#define PG8_LDA(dst, b, h) do { _Pragma("unroll") for (int m = 0; m < 4; ++m) _Pragma("unroll") for (int k = 0; k < 2; ++k) dst[m][k] = *(const LAS f16x8*)(lds + PG8_SA(b, h) + aoff + m * 2048 + k * 1024); } while (0)
#define PG8_LDB(dst, b, h) do { _Pragma("unroll") for (int n = 0; n < 2; ++n) _Pragma("unroll") for (int k = 0; k < 2; ++k) dst[n][k] = *(const LAS f16x8*)(lds + PG8_SB(b, h) + boff + n * 2048 + k * 1024); } while (0)
#define PG8_MMA(ai, bj, At, Bt) do { __builtin_amdgcn_s_setprio(1); _Pragma("unroll") for (int m = 0; m < 4; ++m) _Pragma("unroll") for (int n = 0; n < 2; ++n) _Pragma("unroll") for (int k = 0; k < 2; ++k) \
        acc[ai][bj][m][n] = __builtin_amdgcn_mfma_f32_16x16x32_f16(Bt[n][k], At[m][k], acc[ai][bj][m][n], 0, 0, 0); __builtin_amdgcn_s_setprio(0); } while (0)
#define PG8_WAIT_V(n) asm volatile("s_waitcnt vmcnt(" #n ")" ::: "memory")
#define PG8_WAIT_L(n) asm volatile("s_waitcnt lgkmcnt(" #n ")" ::: "memory")
#define PG8_BAR __builtin_amdgcn_s_barrier()
#define PG8_SCHED __builtin_amdgcn_sched_barrier(0)
#define PG8_AOFF(dst, U) do { if constexpr (GATHER) { _Pragma("unroll") for (int _h = 0; _h < 2; ++_h) _Pragma("unroll") for (int _i = 0; _i < 2; ++_i) \
        dst[_h][_i] = S.arow(U, _h * HALF + Rr[_i]) + (unsigned)Cc[_i] * 2u; } } while (0)
#define PG8_STAGE_A(bufoff, kb, nx, h) do { if constexpr (GATHER) { if (nx) PG8_STAGE(bufoff, Ab + (kb), aon[h]); else PG8_STAGE(bufoff, Ab + (kb), aoc[h]); } \
        else { PG8_STAGE(bufoff, ((nx) ? nA : cA) + (kb) + (h) * hstep, voffA); } } while (0)
    Unit cur, nxt; int ui = 0;
    if (!S.next(0, cur)) return;
    f32x4 acc[2][2][4][2];
#pragma unroll
    for (int a = 0; a < 2; ++a)
#pragma unroll
        for (int b = 0; b < 2; ++b)
#pragma unroll
            for (int m = 0; m < 4; ++m)
#pragma unroll
                for (int n = 0; n < 2; ++n) acc[a][b][m][n] = (f32x4){0.f, 0.f, 0.f, 0.f};
    f16x8 At[4][2], B0[2][2], B1[2][2];
    unsigned aoc[2][2], aon[2][2];
    PG8_AOFF(aoc, cur);
    const char* cA = Ab + (GATHER ? (size_t)0 : (size_t)cur.pm * tstep); const char* nA = cA;
    const char* cB = (const char*)g.Bt + ((size_t)cur.e * g.bstride) * 2 + (size_t)cur.pn * tstep;
    PG8_STAGE(PG8_SB(0, 0), cB, voffB); PG8_STAGE(PG8_SB(0, 1), cB + hstep, voffB); PG8_STAGE_A(PG8_SA(0, 0), 0, 0, 0); PG8_STAGE_A(PG8_SA(0, 1), 0, 0, 1);
    if (wr == 1) PG8_BAR;
    PG8_WAIT_V(2); PG8_BAR;
    PG8_STAGE(PG8_SB(1, 0), cB + kstep, voffB); PG8_STAGE_A(PG8_SA(1, 0), kstep, 0, 0); PG8_STAGE(PG8_SB(1, 1), cB + hstep + kstep, voffB);
    PG8_WAIT_V(6); PG8_BAR;
    for (;;) {
        const bool has_next = S.next(ui + 1, nxt);
        if constexpr (GATHER) { if (has_next) { PG8_AOFF(aon, nxt); } else {
#pragma unroll
            for (int _h = 0; _h < 2; ++_h)
#pragma unroll
                for (int _i = 0; _i < 2; ++_i) aon[_h][_i] = aoc[_h][_i]; } }
        else { nA = has_next ? Ab + (size_t)nxt.pm * tstep : cA; }
        const char* nB = has_next ? (const char*)g.Bt + ((size_t)nxt.e * g.bstride) * 2 + (size_t)nxt.pn * tstep : cB;
        for (int t = 0; t < nt; t += 2) {
            const bool last = (t == nt - 2);
            const size_t k1 = (size_t)(t + 1) * kstep, k2 = last ? (size_t)0 : (size_t)(t + 2) * kstep, k3 = k2 + kstep;
            const char* b2 = last ? nB : cB + (size_t)(t + 2) * kstep; const char* b3 = b2 + kstep;
            PG8_LDB(B0, 0, 0); PG8_LDB(B1, 0, 1); PG8_SCHED; PG8_LDA(At, 0, 0); PG8_STAGE_A(PG8_SA(1, 1), k1, 0, 1);
            PG8_WAIT_V(8); PG8_WAIT_L(0); PG8_BAR; PG8_MMA(0, 0, At, B0); PG8_MMA(0, 1, At, B1); PG8_BAR; PG8_SCHED;
            PG8_LDA(At, 0, 1); PG8_STAGE(PG8_SB(0, 0), b2, voffB); PG8_STAGE(PG8_SB(0, 1), b2 + hstep, voffB); PG8_STAGE_A(PG8_SA(0, 0), k2, last, 0);
            PG8_WAIT_V(8); PG8_WAIT_L(0); PG8_BAR; PG8_MMA(1, 0, At, B0); PG8_MMA(1, 1, At, B1); PG8_BAR; PG8_SCHED;
            PG8_LDB(B0, 1, 0); PG8_LDB(B1, 1, 1); PG8_SCHED; PG8_LDA(At, 1, 0); PG8_STAGE_A(PG8_SA(0, 1), k2, last, 1);
            PG8_WAIT_V(8); PG8_WAIT_L(0); PG8_BAR; PG8_MMA(0, 0, At, B0); PG8_MMA(0, 1, At, B1); PG8_BAR; PG8_SCHED;
            PG8_LDA(At, 1, 1); PG8_STAGE(PG8_SB(1, 0), b3, voffB); PG8_STAGE(PG8_SB(1, 1), b3 + hstep, voffB); PG8_STAGE_A(PG8_SA(1, 0), k3, last, 0);
            PG8_WAIT_V(8); PG8_WAIT_L(0); PG8_BAR; PG8_MMA(1, 0, At, B0); PG8_MMA(1, 1, At, B1); PG8_BAR; PG8_SCHED;
        }
        if constexpr (ALIGN_EPI) { if (wr == 0) PG8_BAR; }
        E(acc, cur, wr, wc, fr, fq);
        if (!has_next) break;
#pragma unroll
        for (int a = 0; a < 2; ++a)
#pragma unroll
            for (int b = 0; b < 2; ++b)
#pragma unroll
                for (int m = 0; m < 4; ++m)
#pragma unroll
                    for (int n = 0; n < 2; ++n) acc[a][b][m][n] = (f32x4){0.f, 0.f, 0.f, 0.f};
        cur = nxt; cB = nB; cA = nA; ++ui;
        if constexpr (GATHER) {
#pragma unroll
        for (int _h = 0; _h < 2; ++_h)
#pragma unroll
            for (int _i = 0; _i < 2; ++_i) aoc[_h][_i] = aon[_h][_i]; }
        if constexpr (ALIGN_EPI) { if (wr == 1) PG8_BAR; }
    }
    PG8_WAIT_V(0);
    if constexpr (!ALIGN_EPI) { if (wr == 0) PG8_BAR; }
    PG8_BAR;
#undef PG8_SA
#undef PG8_SB
#undef PG8_STAGE
#undef PG8_LDA
#undef PG8_LDB
#undef PG8_MMA
#undef PG8_WAIT_V
#undef PG8_WAIT_L
#undef PG8_BAR
#undef PG8_SCHED
#undef PG8_AOFF
#undef PG8_STAGE_A
}
}

typedef f32x4 AccT[2][2][4][2];
DI u32x4 pack8_f16(f32x4 a, f32x4 b) {
    f16x8 h; h[0] = (f16)a[0]; h[1] = (f16)a[1]; h[2] = (f16)a[2]; h[3] = (f16)a[3]; h[4] = (f16)b[0]; h[5] = (f16)b[1]; h[6] = (f16)b[2]; h[7] = (f16)b[3];
    return __builtin_bit_cast(u32x4, h);
}
struct EpiP { static constexpr bool PERM = true; f16* O; int ldc;
    DI void operator()(const AccT& acc, const pg8::Unit& u, int wr, int wc, int fr, int fq) const {
        const int row0 = u.pm * 256 + wr * 64 + fr, col0 = u.pn * 256 + wc * 32 + 8 * fq;
#pragma unroll
        for (int ai = 0; ai < 2; ++ai)
#pragma unroll
            for (int m = 0; m < 4; ++m) { f16* rowp = O + (size_t)(row0 + ai * 128 + m * 16) * ldc + col0;
#pragma unroll
                for (int bj = 0; bj < 2; ++bj) *(u32x4*)(rowp + bj * 128) = pack8_f16(acc[ai][bj][m][0], acc[ai][bj][m][1]); }
    }
};
struct EpiOut { static constexpr bool PERM = false; const float* xlat; const float* xctx; float* olat; float* octx; const float* modl;
    DI void operator()(const AccT& acc, const pg8::Unit& u, int wr, int wc, int fr, int fq) const {
        const bool isl = u.pm < 128; const int pmr = isl ? u.pm : u.pm - 128;
        const char* src = (const char*)((isl ? xlat : xctx) + (size_t)pmr * 256 * DM); char* dst = (char*)((isl ? olat : octx) + (size_t)pmr * 256 * DM);
        const char* g1 = (const char*)(modl + (isl ? (u.pm >> 5) : 4) * 6144 + 2 * 1024 + u.pn * 256);
        unsigned loff = (unsigned)((wr * 64 + fr) * DM + u.pn * 256 + wc * 32 + 4 * fq) * 4u, goff = (unsigned)(wc * 32 + 4 * fq) * 4u;
        asm volatile("" : "+v"(loff), "+v"(goff));
#pragma unroll
        for (int bj = 0; bj < 2; ++bj)
#pragma unroll
            for (int n = 0; n < 2; ++n) { const f32x4 gv = *(const f32x4*)(g1 + goff + (bj * 128 + n * 16) * 4);
#pragma unroll
                for (int ai = 0; ai < 2; ++ai)
#pragma unroll
                    for (int m = 0; m < 4; ++m) { const size_t co = (size_t)((ai * 128 + m * 16) * DM + bj * 128 + n * 16) * 4;
                        const f32x4 xr = *(const f32x4*)(src + co + loff); *(f32x4*)(dst + co + loff) = xr + gv * acc[ai][bj][m][n]; } }
    }
};
struct EpiMoe1 { static constexpr bool PERM = true; f16* HID;
    DI void operator()(const AccT& acc, const pg8::Unit& u, int wr, int wc, int fr, int fq) const {
        const int row0 = u.pm * 256 + wr * 64 + fr, col0 = u.pn * 128 + wc * 32 + 8 * fq;
#pragma unroll
        for (int ai = 0; ai < 2; ++ai)
#pragma unroll
            for (int m = 0; m < 4; ++m) { f32x4 h0, h1;
#pragma unroll
                for (int i = 0; i < 4; ++i) { h0[i] = siluf(acc[ai][0][m][0][i]) * acc[ai][1][m][0][i]; h1[i] = siluf(acc[ai][0][m][1][i]) * acc[ai][1][m][1][i]; }
                *(u32x4*)(HID + (size_t)(row0 + ai * 128 + m * 16) * EH + col0) = pack8_f16(h0, h1); }
    }
};
struct EpiMoe2 { static constexpr bool PERM = true; f16* Y2; const int* list; const LAS int* cnt;
    DI void operator()(const AccT& acc, const pg8::Unit& u, int wr, int wc, int fr, int fq) const {
        const int col0 = u.pn * 256 + wc * 32 + 8 * fq; const int n_e = cnt[u.e]; const int* le = list + (size_t)u.e * TT + u.lrb * 256;
#pragma unroll
        for (int ai = 0; ai < 2; ++ai)
#pragma unroll
            for (int m = 0; m < 4; ++m) { const int r = ai * 128 + wr * 64 + m * 16 + fr;
                if (u.lrb * 256 + r < n_e) { const int ent = le[r]; f16* rowp = Y2 + (size_t)ent * DM + col0;
#pragma unroll
                    for (int bj = 0; bj < 2; ++bj) *(u32x4*)(rowp + bj * 128) = pack8_f16(acc[ai][bj][m][0], acc[ai][bj][m][1]); } }
    }
};

DI void p0_transpose_item(const float* W, int K, int N, f16* WT, int mode, LAS float* scr, int item, int lane) {
    const int nblk = N / 32, kb = item / nblk, nb = item % nblk, k0 = 64 * kb, n0 = 32 * nb;
    const int rbase = (mode == 0) ? n0 : (256 * (n0 >> 7) + (n0 & 127) + (mode == 2 ? 128 : 0));
#pragma unroll 8
    for (int i = 0; i < 32; ++i) { const int kk = 2 * i + (lane >> 5); scr[kk * 33 + (lane & 31)] = W[(size_t)(k0 + kk) * N + n0 + (lane & 31)]; }
    asm volatile("s_waitcnt lgkmcnt(0)" ::: "memory");
    const int c = lane & 7;
#pragma unroll
    for (int j = 0; j < 4; ++j) { const int n = (lane >> 3) + 8 * j; const LAS float* s = scr + (8 * c) * 33 + n;
        f16x8 o;
#pragma unroll
        for (int q = 0; q < 8; ++q) o[q] = (f16)s[q * 33];
        *(f16x8*)(WT + (size_t)(rbase + n) * K + k0 + 8 * c) = o; }
    asm volatile("s_waitcnt lgkmcnt(0)" ::: "memory");
}

DI void phase_prologue(const Params& p, ldsp lds, int tid, int lane, int wave, int vcu, int G) {
    unsigned char* ws = p.ws;
    LAS float* scr = (LAS float*)(lds + wave * 16384);
    const int gw = vcu * 8 + wave, NGW = G * 8;
    constexpr int PER_L = 1152 + 512 + 32 * 768;
    constexpr int NW_ITEMS = DEPTH * PER_L;
    for (int it = gw; it < NW_ITEMS + 32; it += NGW) {
        if (it >= NW_ITEMS) { const int j = it - NW_ITEMS, mat = j >> 1;
            p0_transpose_item(p.pool_w + (size_t)mat * 4096, 64, 64, (f16*)(ws + WS_POOLW) + (size_t)mat * 4096, 0, scr, j & 1, lane); continue; }
        const int l = it / PER_L; int r = it % PER_L;
        if (r < 1152) { p0_transpose_item(p.w_in + (size_t)l * DM * INC, DM, INC, (f16*)(ws + WS_WIN) + (size_t)l * INC * DM, 0, scr, r, lane); continue; } r -= 1152;
        if (r < 512) { p0_transpose_item(p.w_out + (size_t)l * DM * DM, DM, DM, (f16*)(ws + WS_WOUT) + (size_t)l * DM * DM, 0, scr, r, lane); continue; } r -= 512;
        const int e = r / 768, q = r % 768, which = q >> 8, item = q & 255; const size_t le = (size_t)l * NEXP + e;
        if (which == 0) p0_transpose_item(p.ewg + le * DM * EH, DM, EH, (f16*)(ws + WS_WGU) + le * 1024 * 1024, 1, scr, item, lane);
        else if (which == 1) p0_transpose_item(p.ewu + le * DM * EH, DM, EH, (f16*)(ws + WS_WGU) + le * 1024 * 1024, 2, scr, item, lane);
        else p0_transpose_item(p.ewd + le * EH * DM, EH, DM, (f16*)(ws + WS_WD) + le * 1024 * 512, 0, scr, item, lane);
    }
    { float* WR = (float*)(ws + WS_WR);
      for (int i = vcu * 512 + tid; i < DEPTH * 1024 * 48; i += G * 512) { const int o = i % 48, k = (i / 48) % 1024, l = i / (48 * 1024);
          float v = 0.f; if (o < 4) v = p.rgw[((size_t)l * 1024 + k) * 4 + o]; else if (o < 36) v = p.rew[((size_t)l * 1024 + k) * 32 + (o - 4)];
          WR[i] = v; } }
    { float* RT = (float*)(ws + WS_ROPE);
      for (int i = vcu * 512 + tid; i < (128 + 64) * 16; i += G * 512) { const int m = i & 15, pos = i >> 4;
          const float inv = powf(10000.f, -(float)m / 16.f); const float ang = (float)(pos < 128 ? pos : pos - 128) * inv; float s, c; sincosf(ang, &s, &c);
          if (pos < 128) { RT[pos * 16 + m] = c; RT[2048 + pos * 16 + m] = s; } else { RT[4096 + (pos - 128) * 16 + m] = c; RT[4096 + 1024 + (pos - 128) * 16 + m] = s; } } }
    if (vcu == 0) { float* LB = (float*)(ws + WS_LB);
        const float a0 = p.hgrn_lb[tid], a1 = p.hgrn_lb[512 + tid], a2 = p.hgrn_lb[1024 + tid], a3 = p.hgrn_lb[1536 + tid];
        const float mx = fmaxf(fmaxf(a0, a1), fmaxf(a2, a3)); const float e0 = expf(a0 - mx), e1 = expf(a1 - mx), e2 = expf(a2 - mx), e3 = expf(a3 - mx); const float inv = 1.f / (e0 + e1 + e2 + e3);
        LB[tid] = 0.f; LB[512 + tid] = e1 * inv; LB[1024 + tid] = (e1 + e2) * inv; LB[1536 + tid] = (e1 + e2 + e3) * inv; }
    __syncthreads();
    { LAS float* sl = (LAS float*)lds;
      LAS float* red = (LAS float*)(lds + 32768);
      for (int i = tid; i < 5 * 1024; i += 512) { const int b = i >> 10, k = i & 1023; const float v = (b < 4) ? p.c[b * 1024 + k] : p.c_ctx[k]; sl[i] = siluf(v); }
      __syncthreads();
      float* MOD = (float*)(ws + WS_MOD);
      for (int it = vcu; it < DEPTH * 96; it += G) { const int l = it / 96, col = (it % 96) * 64 + lane;
          const float* W = p.ada_w + (size_t)l * 1024 * 6144 + col; float a[5] = {0.f, 0.f, 0.f, 0.f, 0.f};
#pragma unroll 8
          for (int k = wave * 128; k < wave * 128 + 128; ++k) { const float w = W[(size_t)k * 6144];
#pragma unroll
              for (int b = 0; b < 5; ++b) a[b] += sl[b * 1024 + k] * w; }
#pragma unroll
          for (int b = 0; b < 5; ++b) red[(wave * 5 + b) * 64 + lane] = a[b];
          __syncthreads();
          if (tid < 320) { const int b = tid >> 6, cc = tid & 63; float s = 0.f;
#pragma unroll
              for (int w = 0; w < 8; ++w) s += red[(w * 5 + b) * 64 + cc];
              const int c2 = (it % 96) * 64 + cc; MOD[((size_t)l * 5 + b) * 6144 + c2] = s + p.ada_b[l * 6144 + c2]; }
          __syncthreads(); } }
}

DI void modulate_row_store(const f32x4 (&v)[4], float r, const float* gn, const float* sh, const float* sc, f16* hrow, int lane) {
#pragma unroll
    for (int j = 0; j < 4; ++j) { const int c = 256 * j + 4 * lane; const f32x4 g = *(const f32x4*)(gn + c), s = *(const f32x4*)(sh + c), k = *(const f32x4*)(sc + c);
        f16x4 o;
#pragma unroll
        for (int i = 0; i < 4; ++i) o[i] = (f16)(v[j][i] * r * g[i] * (1.f + k[i]) + s[i]);
        *(f16x4*)(hrow + c) = o; }
}
DI void phase_mod0(const Params& p, int lane, int wave, int vcu, int G) {
    const float* MOD = (const float*)(p.ws + WS_MOD); f16* H = (f16*)(p.ws + WS_H);
    for (int row = vcu * 8 + wave; row < TT; row += G * 8) {
        const float* xr = (row < TL) ? p.x + (size_t)row * DM : p.ctx + (size_t)(row - TL) * DM; const int b = modb_of_row(row);
        f32x4 v[4]; float s = 0.f;
#pragma unroll
        for (int j = 0; j < 4; ++j) { v[j] = *(const f32x4*)(xr + 256 * j + 4 * lane); s += v[j][0] * v[j][0] + v[j][1] * v[j][1] + v[j][2] * v[j][2] + v[j][3] * v[j][3]; }
        const float r = 1.f / sqrtf(wave_sum(s) * (1.f / DM) + EPS);
        modulate_row_store(v, r, p.norm1_g, MOD + (size_t)b * 6144, MOD + (size_t)b * 6144 + 1024, H + (size_t)row * DM, lane);
    }
}
DI void phase_combine(const Params& p, int l, int lane, int wave, int vcu, int G) {
    const float* MOD = (const float*)(p.ws + WS_MOD); f16* H = (f16*)(p.ws + WS_H); const f16* Y2 = (const f16*)(p.ws + WS_Y2); const float* GT = (const float*)(p.ws + WS_GATES);
    float* XC = (float*)(p.ws + WS_XC);
    const int nrows = (l == DEPTH - 1) ? TL : TT;
    for (int row = vcu * 8 + wave; row < nrows; row += G * 8) {
        float* xr = (row < TL) ? p.out + (size_t)row * DM : XC + (size_t)(row - TL) * DM; const int b = modb_of_row(row);
        const float* g2 = MOD + ((size_t)l * 5 + b) * 6144 + 5 * 1024; const float ga = GT[row * 2], gb = GT[row * 2 + 1];
        const f16* y0 = Y2 + (size_t)row * 2 * DM; const f16* y1 = y0 + DM;
        f32x4 v[4]; float s = 0.f;
#pragma unroll
        for (int j = 0; j < 4; ++j) { const int c = 256 * j + 4 * lane; v[j] = *(const f32x4*)(xr + c); const f16x4 a = *(const f16x4*)(y0 + c), bb = *(const f16x4*)(y1 + c); const f32x4 g = *(const f32x4*)(g2 + c);
#pragma unroll
            for (int i = 0; i < 4; ++i) v[j][i] += g[i] * (ga * (float)a[i] + gb * (float)bb[i]);
            *(f32x4*)(xr + c) = v[j]; s += v[j][0] * v[j][0] + v[j][1] * v[j][1] + v[j][2] * v[j][2] + v[j][3] * v[j][3]; }
        if (l < DEPTH - 1) { const float r = 1.f / sqrtf(wave_sum(s) * (1.f / DM) + EPS); const float* m1 = MOD + ((size_t)(l + 1) * 5 + b) * 6144;
            modulate_row_store(v, r, p.norm1_g + (l + 1) * DM, m1, m1 + 1024, H + (size_t)row * DM, lane); }
    }
}

DI f32x4 mma_f16(f16x8 a, f16x8 b, f32x4 c) { return __builtin_amdgcn_mfma_f32_16x16x32_f16(a, b, c, 0, 0, 0); }
DI f32x4 mma_bf16(s16x8 a, s16x8 b, f32x4 c) { return __builtin_amdgcn_mfma_f32_16x16x32_bf16(a, b, c, 0, 0, 0); }

constexpr int TP = 72;
struct TileInfo { int row0, t0, seqrow0, len, b, isctx, chunkpos_f, chunkpos_b; };
DI TileInfo tile_info(int tt) {
    TileInfo ti;
    if (tt < 512) { ti.b = tt >> 7; ti.t0 = (tt & 127) * 64; ti.seqrow0 = ti.b * SEQ; ti.len = SEQ; ti.isctx = 0; ti.chunkpos_f = 4 + (tt & 127); ti.chunkpos_b = 4 + 127 - (tt & 127); }
    else { const int j = tt - 512; ti.b = j >> 2; ti.t0 = (j & 3) * 64; ti.seqrow0 = TL + ti.b * CTXL; ti.len = CTXL; ti.isctx = 1; ti.chunkpos_f = (j & 3); ti.chunkpos_b = 3 - (j & 3); }
    ti.row0 = ti.seqrow0 + ti.t0; return ti;
}

DI void prep_qk(const Params& p, int l, const TileInfo& ti, int tid) {
    const f16* P = (const f16*)(p.ws + WS_P); f16* QN = (f16*)(p.ws + WS_QN); f16* KN = (f16*)(p.ws + WS_KN); const float* RT = (const float*)(p.ws + WS_ROPE);
    const int j8 = tid & 7;
#pragma unroll 2
    for (int it = 0; it < 10; ++it) {
        const int pidx = it * 64 + (tid >> 3); const int tok = pidx / 10, hh = pidx % 10; const int row = ti.row0 + tok;
        const f16x8 raw = *(const f16x8*)(P + (size_t)row * INC + C_Q + hh * 64 + 8 * j8);
        float v[8]; float s = 0.f;
#pragma unroll
        for (int i = 0; i < 8; ++i) { v[i] = (float)raw[i]; s += v[i] * v[i]; }
        s += __shfl_xor(s, 1); s += __shfl_xor(s, 2); s += __shfl_xor(s, 4);
        const float r = 1.f / sqrtf(s * (1.f / 64.f) + EPS);
        const float* gn = (hh < 8 ? p.q_norm_g : p.k_norm_g) + l * 64 + 8 * j8;
#pragma unroll
        for (int i = 0; i < 8; ++i) v[i] = v[i] * r * gn[i];
        if (!ti.isctx) {
            const int t = ti.t0 + tok, prow = t >> 6, pcol = t & 63; const int a0 = (8 * j8) & 31;
            const float* ct = (a0 < 16) ? RT + prow * 16 + a0 : RT + 4096 + pcol * 16 + (a0 - 16);
            const float* st = (a0 < 16) ? RT + 2048 + prow * 16 + a0 : RT + 4096 + 1024 + pcol * 16 + (a0 - 16);
#pragma unroll
            for (int i = 0; i < 8; ++i) { const float o = __shfl_xor(v[i], 4); const float c = ct[i], sn = st[i];
                v[i] = (j8 < 4) ? (v[i] * c - o * sn) : (v[i] * c + o * sn); }
        }
        const float sc = (hh < 8) ? 0.125f * LOG2E : 1.f;
        f16x8 o;
#pragma unroll
        for (int i = 0; i < 8; ++i) o[i] = (f16)(v[i] * sc);
        if (hh < 8) *(f16x8*)(QN + (size_t)row * 512 + hh * 64 + 8 * j8) = o; else *(f16x8*)(KN + (size_t)row * 128 + (hh - 8) * 64 + 8 * j8) = o;
    }
}

DI void prep_pool(const Params& p, int l, const TileInfo& ti, ldsp lds, int tid, int lane, int wave) {
    const f16* P = (const f16*)(p.ws + WS_P); f16* MIX = (f16*)(p.ws + WS_MIX); const f16* PW = (const f16*)(p.ws + WS_POOLW) + (size_t)l * 4 * 4096;
    constexpr int UP = 264;
    LAS f16* U = (LAS f16*)lds;
    LAS f16* PL = (LAS f16*)(lds + 80 * UP * 2);
    for (int i = tid; i < 80 * 32; i += 512) { const int rr = i >> 5, ch = i & 31; const int t = ti.t0 - 8 + rr;
        f16x8 v = (f16x8){0, 0, 0, 0, 0, 0, 0, 0};
        if (t >= 0 && t < ti.len) v = *(const f16x8*)(P + (size_t)(ti.seqrow0 + t) * INC + C_U + 8 * ch);
        *(LAS f16x8*)(U + rr * UP + 8 * ch) = v; }
    __syncthreads();
    { const int ch = tid & 255, gi = ch >> 6, w = 2 << gi, th = tid >> 8;
      for (int tk = th * 32; tk < th * 32 + 32; ++tk) { const int t = ti.t0 + tk; int lo = t - (w - 1) / 2, hi = t + w / 2 + 1; lo = lo < 0 ? 0 : lo; hi = hi > ti.len ? ti.len : hi;
          float s = 0.f; for (int q = lo; q < hi; ++q) s += (float)U[(q - ti.t0 + 8) * UP + ch];
          const float pooled = s / (float)(hi - lo) - (float)U[(tk + 8) * UP + ch];
          PL[tk * UP + ch] = (f16)pooled; } }
    __syncthreads();
    { const int g = wave >> 1, th = wave & 1; const int fr = lane & 15, fq = lane >> 4;
      f32x4 acc[2][4];
#pragma unroll
      for (int m = 0; m < 2; ++m)
#pragma unroll
          for (int n = 0; n < 4; ++n) acc[m][n] = (f32x4){0.f, 0.f, 0.f, 0.f};
#pragma unroll
      for (int ks = 0; ks < 2; ++ks) { f16x8 a[2], bfr[4];
#pragma unroll
          for (int m = 0; m < 2; ++m) a[m] = *(const LAS f16x8*)(PL + (th * 32 + m * 16 + fr) * UP + g * 64 + 32 * ks + 8 * fq);
#pragma unroll
          for (int n = 0; n < 4; ++n) bfr[n] = *(const f16x8*)(PW + (size_t)g * 4096 + (n * 16 + fr) * 64 + 32 * ks + 8 * fq);
#pragma unroll
          for (int m = 0; m < 2; ++m)
#pragma unroll
              for (int n = 0; n < 4; ++n) acc[m][n] = mma_f16(a[m], bfr[n], acc[m][n]); }
#pragma unroll
      for (int n = 0; n < 4; ++n) { const int d = g * 64 + n * 16 + fr; const float ps = p.pool_scale[l * 256 + d];
#pragma unroll
          for (int m = 0; m < 2; ++m)
#pragma unroll
              for (int i = 0; i < 4; ++i) { const int tk = th * 32 + m * 16 + 4 * fq + i; MIX[(size_t)(ti.row0 + tk) * DM + d] = (f16)(acc[m][n][i] * ps); } } }
    __syncthreads();
}

DI void hgrn_cumsum(const LAS f16* Z, float lb, int ch, int qtr, int dir, LAS float* tot, float (&bcum)[16], float (&kk)[16], float& bend, float& bref) {
    float run = 0.f;
#pragma unroll
    for (int i = 0; i < 16; ++i) { const int s = dir ? 63 - (16 * qtr + i) : 16 * qtr + i; const float z = (float)Z[s * TP + ch];
        const float sg = 1.f / (1.f + __expf(-z)); const float f = lb + (1.f - lb) * sg; run += __logf(f); bcum[i] = run; kk[i] = (1.f - lb) * (1.f - sg); }
    tot[(dir * 64 + ch) * 4 + qtr] = run;
    __syncthreads();
    float pre = 0.f, all = 0.f, mid = 0.f;
#pragma unroll
    for (int q = 0; q < 4; ++q) { const float tq = tot[(dir * 64 + ch) * 4 + q]; pre += (q < qtr) ? tq : 0.f; all += tq; mid += (q < 2) ? tq : 0.f; }
#pragma unroll
    for (int i = 0; i < 16; ++i) bcum[i] += pre;
    bend = all; bref = mid;
}

DI void prep_hgrn_state(const Params& p, int l, const TileInfo& ti, int h, ldsp lds, int tid, int lane, int wave) {
    const f16* P = (const f16*)(p.ws + WS_P); float* HS = (float*)(p.ws + WS_HS); float* HA = (float*)(p.ws + WS_HA); const float* LB = (const float*)(p.ws + WS_LB) + l * 512;
    LAS f16* ZF = (LAS f16*)lds; LAS f16* ZB = ZF + 64 * TP; LAS f16* VT = ZB + 64 * TP; LAS f16* KT = VT + 64 * TP;
    LAS float* tot = (LAS float*)(KT + 2 * 64 * TP);
    { const int s = tid >> 3, c8 = tid & 7; const f16* pr = P + (size_t)(ti.row0 + s) * INC + h * 64 + 8 * c8;
      *(LAS f16x8*)(ZF + s * TP + 8 * c8) = *(const f16x8*)(pr + C_HZF); *(LAS f16x8*)(ZB + s * TP + 8 * c8) = *(const f16x8*)(pr + C_HZB);
      const f16x8 v = *(const f16x8*)(pr + C_HI);
#pragma unroll
      for (int i = 0; i < 8; ++i) VT[(8 * c8 + i) * TP + s] = v[i]; }
    __syncthreads();
    { const int dir = tid >> 8, ch = (tid >> 2) & 63, qtr = tid & 3; float bc[16], kk[16], bend, bref;
      hgrn_cumsum(dir ? ZB : ZF, LB[dir * 256 + h * 64 + ch], ch, qtr, dir, tot, bc, kk, bend, bref);
#pragma unroll
      for (int i = 0; i < 16; ++i) { const int s = dir ? 63 - (16 * qtr + i) : 16 * qtr + i; KT[(dir * 64 + ch) * TP + s] = (f16)(kk[i] * __expf(bend - bc[i])); }
      if (qtr == 0) { const int pos = dir ? ti.chunkpos_b : ti.chunkpos_f; HA[((size_t)((dir * NB + ti.b) * NPOS + pos) * 4 + h) * 64 + ch] = __expf(bend); } }
    __syncthreads();
    { const int dir = wave >> 2, mt = wave & 3, fr = lane & 15, fq = lane >> 4;
      f32x4 acc[4];
#pragma unroll
      for (int n = 0; n < 4; ++n) acc[n] = (f32x4){0.f, 0.f, 0.f, 0.f};
#pragma unroll
      for (int ks = 0; ks < 2; ++ks) { const f16x8 a = *(const LAS f16x8*)(VT + (mt * 16 + fr) * TP + 32 * ks + 8 * fq);
#pragma unroll
          for (int n = 0; n < 4; ++n) { const f16x8 b = *(const LAS f16x8*)(KT + (dir * 64 + n * 16 + fr) * TP + 32 * ks + 8 * fq); acc[n] = mma_f16(a, b, acc[n]); } }
      const int pos = dir ? ti.chunkpos_b : ti.chunkpos_f; float* dst = HS + ((size_t)((dir * NB + ti.b) * NPOS + pos) * 4 + h) * 4096;
#pragma unroll
      for (int n = 0; n < 4; ++n)
#pragma unroll
          for (int i = 0; i < 4; ++i) dst[(mt * 16 + 4 * fq + i) * 64 + n * 16 + fr] = acc[n][i]; }
    __syncthreads();
}

DI void phase_prep(const Params& p, int l, ldsp lds, int tid, int lane, int wave, int vcu, int G) {
    for (int it = vcu; it < 528 * 5; it += G) { const int tt = it / 5, kind = it % 5; const TileInfo ti = tile_info(tt);
        if (kind == 0) { prep_qk(p, l, ti, tid); prep_pool(p, l, ti, lds, tid, lane, wave); }
        else prep_hgrn_state(p, l, ti, kind - 1, lds, tid, lane, wave); }
}

DI void phase_scan(const Params& p, int tid, int vcu, int G) {
    float* HS = (float*)(p.ws + WS_HS); const float* HA = (const float*)(p.ws + WS_HA);
    for (int gid = vcu * 512 + tid; gid < 2 * NB * 4 * 4096; gid += G * 512) {
        const int el = gid & 4095, h = (gid >> 12) & 3, db = gid >> 14;
        float* hs = HS + ((size_t)db * NPOS * 4 + h) * 4096 + el; const float* ha = HA + ((size_t)db * NPOS * 4 + h) * 64 + (el & 63);
        float S = 0.f;
        for (int pos = 0; pos < NPOS; pos += 4) { float u[4], a[4];
#pragma unroll
            for (int j = 0; j < 4; ++j) { u[j] = hs[(size_t)(pos + j) * 4 * 4096]; a[j] = ha[(size_t)(pos + j) * 4 * 64]; }
#pragma unroll
            for (int j = 0; j < 4; ++j) { hs[(size_t)(pos + j) * 4 * 4096] = S; S = a[j] * S + u[j]; } }
    }
}

DI int crow(int r, int hi) { return (r & 3) + 8 * (r >> 2) + 4 * hi; }
DI void attn_item(const Params& p, int l, int idx, ldsp lds, int tid, int lane, int wave) {
    const f16* P = (const f16*)(p.ws + WS_P); const f16* QN = (const f16*)(p.ws + WS_QN); const f16* KN = (const f16*)(p.ws + WS_KN); f16* MIX = (f16*)(p.ws + WS_MIX);
    int b, kvh, qb, isctx;
    if (idx < 1024) { b = idx >> 8; kvh = (idx >> 7) & 1; qb = idx & 127; isctx = 0; } else { const int j = idx - 1024; b = j >> 3; kvh = (j >> 2) & 1; qb = j & 3; isctx = 1; }
    const int q0 = qb * 64; const int qrowbase = isctx ? TL + b * CTXL : b * SEQ;
    const int r32 = lane & 31, hi = lane >> 5; const int hq = kvh * 4 + (wave >> 1); const int qpos = q0 + (wave & 1) * 32 + r32; const size_t qrow = (size_t)qrowbase + qpos;
    LAS f16* KB = (LAS f16*)lds;
    LAS f16* VTB = KB + 2 * 64 * TP;
    f16x8 qr[4];
#pragma unroll
    for (int d0 = 0; d0 < 4; ++d0) qr[d0] = *(const f16x8*)(QN + qrow * 512 + hq * 64 + 16 * d0 + 8 * hi);
    float m = p.attn_sink[l * 8 + hq] * LOG2E, lsum = hi ? 0.f : 1.f;
    f32x16 o[2];
#pragma unroll
    for (int r = 0; r < 16; ++r) { o[0][r] = 0.f; o[1][r] = 0.f; }
    const int srow = tid >> 3, sc8 = tid & 7;
    const int ntile = isctx ? 4 : 9;
    int cur = 0; bool have = false; f16x8 kreg, vreg;
    int tix = 0;
#define TILE_VALID(t) (isctx || (t) >= 5 || ((q0 - 128 + 64 * (t)) >= 0 && (q0 - 128 + 64 * (t)) < SEQ))
#define TILE_ROW(t) ((isctx || (t) >= 5) ? (TL + b * CTXL + 64 * (isctx ? (t) : (t) - 5)) : (b * SEQ + q0 - 128 + 64 * (t)))
    while (tix < ntile && !TILE_VALID(tix)) ++tix;
    { const size_t kr = (size_t)TILE_ROW(tix) + srow; kreg = *(const f16x8*)(KN + kr * 128 + kvh * 64 + 8 * sc8); vreg = *(const f16x8*)(P + kr * INC + C_V + kvh * 64 + 8 * sc8); }
    __syncthreads();
    { *(LAS f16x8*)(KB + srow * TP + 8 * sc8) = kreg;
#pragma unroll
      for (int i = 0; i < 8; ++i) VTB[(8 * sc8 + i) * TP + srow] = vreg[i]; }
    __syncthreads();
    while (tix < ntile) {
        int nx = tix + 1; while (nx < ntile && !TILE_VALID(nx)) ++nx;
        have = nx < ntile;
        if (have) { const size_t kr = (size_t)TILE_ROW(nx) + srow; kreg = *(const f16x8*)(KN + kr * 128 + kvh * 64 + 8 * sc8); vreg = *(const f16x8*)(P + kr * INC + C_V + kvh * 64 + 8 * sc8); }
        const LAS f16* Kc = KB + cur * 64 * TP; const LAS f16* Vc = VTB + cur * 64 * TP;
        f32x16 p0, p1;
#pragma unroll
        for (int r = 0; r < 16; ++r) { p0[r] = 0.f; p1[r] = 0.f; }
#pragma unroll
        for (int d0 = 0; d0 < 4; ++d0) { const f16x8 k0 = *(const LAS f16x8*)(Kc + r32 * TP + 16 * d0 + 8 * hi); const f16x8 k1 = *(const LAS f16x8*)(Kc + (32 + r32) * TP + 16 * d0 + 8 * hi);
            p0 = __builtin_amdgcn_mfma_f32_32x32x16_f16(k0, qr[d0], p0, 0, 0, 0); p1 = __builtin_amdgcn_mfma_f32_32x32x16_f16(k1, qr[d0], p1, 0, 0, 0); }
        if (!isctx && (tix == 0 || tix == 4)) { const int kstart = q0 - 128 + 64 * tix;
#pragma unroll
            for (int r = 0; r < 16; ++r) { const int d0_ = qpos - (kstart + crow(r, hi)); if (d0_ > 128 || d0_ < -128) p0[r] = -INFINITY; const int d1_ = d0_ - 32; if (d1_ > 128 || d1_ < -128) p1[r] = -INFINITY; } }
        float mx = fmaxf(p0[0], p1[0]);
#pragma unroll
        for (int r = 1; r < 16; ++r) mx = fmaxf(mx, fmaxf(p0[r], p1[r]));
        mx = fmaxf(mx, __shfl_xor(mx, 32));
        const float mn = fmaxf(m, mx); const float f = __builtin_amdgcn_exp2f(m - mn); m = mn; lsum *= f;
#pragma unroll
        for (int r = 0; r < 16; ++r) { o[0][r] *= f; o[1][r] *= f; }
        float ps = 0.f;
#pragma unroll
        for (int r = 0; r < 16; ++r) { p0[r] = __builtin_amdgcn_exp2f(p0[r] - mn); p1[r] = __builtin_amdgcn_exp2f(p1[r] - mn); ps += p0[r] + p1[r]; }
        lsum += ps;
        f16x8 pw[4];
#pragma unroll
        for (int j = 0; j < 8; ++j) { pw[0][j] = (f16)p0[j]; pw[1][j] = (f16)p0[8 + j]; pw[2][j] = (f16)p1[j]; pw[3][j] = (f16)p1[8 + j]; }
#pragma unroll
        for (int d1 = 0; d1 < 2; ++d1)
#pragma unroll
            for (int s = 0; s < 4; ++s) { const LAS f16* vp = Vc + (32 * d1 + r32) * TP + 16 * s + 4 * hi; const f16x4 lo = *(const LAS f16x4*)vp, hv = *(const LAS f16x4*)(vp + 8);
                const f16x8 vf = (f16x8){lo[0], lo[1], lo[2], lo[3], hv[0], hv[1], hv[2], hv[3]};
                o[d1] = __builtin_amdgcn_mfma_f32_32x32x16_f16(vf, pw[s], o[d1], 0, 0, 0); }
        if (have) { LAS f16* Kn = KB + (cur ^ 1) * 64 * TP; LAS f16* Vn = VTB + (cur ^ 1) * 64 * TP;
            *(LAS f16x8*)(Kn + srow * TP + 8 * sc8) = kreg;
#pragma unroll
            for (int i = 0; i < 8; ++i) Vn[(8 * sc8 + i) * TP + srow] = vreg[i]; }
        __syncthreads();
        cur ^= 1; tix = nx;
    }
#undef TILE_VALID
#undef TILE_ROW
    const float lt = lsum + __shfl_xor(lsum, 32); const float il = 1.f / lt;
    f16* orow = MIX + qrow * DM + 256 + hq * 64;
#pragma unroll
    for (int d1 = 0; d1 < 2; ++d1)
#pragma unroll
        for (int g = 0; g < 4; ++g) { f16x4 v;
#pragma unroll
            for (int i = 0; i < 4; ++i) v[i] = (f16)(o[d1][4 * g + i] * il);
            *(f16x4*)(orow + 32 * d1 + 8 * g + 4 * hi) = v; }
}
DI void phase_attn(const Params& p, int l, ldsp lds, int tid, int lane, int wave, int vcu, int G) {
    for (int it = vcu; it < 1056; it += G) attn_item(p, l, it, lds, tid, lane, wave);
    __syncthreads();
}

DI void hgrn_out_item(const Params& p, int l, const TileInfo& ti, int h, ldsp lds, int tid, int lane, int wave) {
    const f16* P = (const f16*)(p.ws + WS_P); const float* HS = (const float*)(p.ws + WS_HS); const float* LB = (const float*)(p.ws + WS_LB) + l * 512; f16* MIX = (f16*)(p.ws + WS_MIX);
    typedef unsigned short b16;
    LAS f16* ZF = (LAS f16*)lds; LAS f16* ZB = ZF + 64 * TP; LAS f16* QR = ZB + 64 * TP; LAS f16* GR = QR + 64 * TP;
    LAS b16* VT = (LAS b16*)(GR + 64 * TP);
    LAS b16* QP = VT + 64 * TP;
    LAS b16* KP = QP + 2 * 64 * TP;
    LAS b16* ST = KP + 2 * 64 * TP;
    LAS b16* PB = ST + 2 * 64 * TP;
    LAS float* OB = (LAS float*)ZF;
    LAS float* tot = (LAS float*)(PB + 8 * 16 * TP);
    LAS float* bref_s = tot + 512;
    { const int s = tid >> 3, c8 = tid & 7; const f16* pr = P + (size_t)(ti.row0 + s) * INC + h * 64 + 8 * c8;
      *(LAS f16x8*)(ZF + s * TP + 8 * c8) = *(const f16x8*)(pr + C_HZF); *(LAS f16x8*)(ZB + s * TP + 8 * c8) = *(const f16x8*)(pr + C_HZB);
      *(LAS f16x8*)(QR + s * TP + 8 * c8) = *(const f16x8*)(pr + C_HQ); *(LAS f16x8*)(GR + s * TP + 8 * c8) = *(const f16x8*)(pr + C_HG);
      const f16x8 v = *(const f16x8*)(pr + C_HI);
#pragma unroll
      for (int i = 0; i < 8; ++i) VT[(8 * c8 + i) * TP + s] = f2bf((float)v[i]); }
    __syncthreads();
    { const int dir = tid >> 8, ch = (tid >> 2) & 63, qtr = tid & 3; float bc[16], kk[16], bend, bref;
      hgrn_cumsum(dir ? ZB : ZF, LB[dir * 256 + h * 64 + ch], ch, qtr, dir, tot, bc, kk, bend, bref);
#pragma unroll
      for (int i = 0; i < 16; ++i) { const int s = dir ? 63 - (16 * qtr + i) : 16 * qtr + i; const float d = fminf(fmaxf(bc[i] - bref, -80.f), 80.f);
          const float qv = siluf((float)QR[s * TP + ch]);
          QP[(dir * 64 + s) * TP + ch] = f2bf(qv * __expf(d)); KP[(dir * 64 + s) * TP + ch] = f2bf(kk[i] * __expf(-d)); }
      if (qtr == 0) bref_s[dir * 64 + ch] = bref; }
    __syncthreads();
    { const float* hsf = HS + ((size_t)((0 * NB + ti.b) * NPOS + ti.chunkpos_f) * 4 + h) * 4096; const float* hsb = HS + ((size_t)((1 * NB + ti.b) * NPOS + ti.chunkpos_b) * 4 + h) * 4096;
      for (int i = tid; i < 2 * 1024; i += 512) { const int dir = i >> 10, e4 = (i & 1023) * 4; const int dv = e4 >> 6, dk = e4 & 63; const f32x4 sv = *(const f32x4*)((dir ? hsb : hsf) + e4);
#pragma unroll
          for (int q = 0; q < 4; ++q) ST[(dir * 64 + dv) * TP + dk + q] = f2bf(sv[q] * __expf(fmaxf(bref_s[dir * 64 + dk + q], -80.f))); } }
    __syncthreads();
    const int dir = wave >> 2, mt = wave & 3, fr = lane & 15, fq = lane >> 4;
    f32x4 oacc[4];
    { f32x4 sacc[4];
#pragma unroll
      for (int n = 0; n < 4; ++n) { sacc[n] = (f32x4){0.f, 0.f, 0.f, 0.f}; oacc[n] = (f32x4){0.f, 0.f, 0.f, 0.f}; }
      s16x8 qa[2];
#pragma unroll
      for (int ks = 0; ks < 2; ++ks) qa[ks] = *(const LAS s16x8*)(QP + (dir * 64 + mt * 16 + fr) * TP + 32 * ks + 8 * fq);
#pragma unroll
      for (int ks = 0; ks < 2; ++ks)
#pragma unroll
          for (int n = 0; n < 4; ++n) { const s16x8 kb = *(const LAS s16x8*)(KP + (dir * 64 + n * 16 + fr) * TP + 32 * ks + 8 * fq); sacc[n] = mma_bf16(qa[ks], kb, sacc[n]); }
#pragma unroll
      for (int n = 0; n < 4; ++n)
#pragma unroll
          for (int i = 0; i < 4; ++i) { const int t = mt * 16 + 4 * fq + i, s = n * 16 + fr; const bool keep = dir ? (s >= t) : (s <= t);
              PB[(wave * 16 + 4 * fq + i) * TP + s] = f2bf(keep ? sacc[n][i] : 0.f); }
      asm volatile("s_waitcnt lgkmcnt(0)" ::: "memory");
#pragma unroll
      for (int ks = 0; ks < 2; ++ks) { const s16x8 pa = *(const LAS s16x8*)(PB + (wave * 16 + fr) * TP + 32 * ks + 8 * fq);
#pragma unroll
          for (int n = 0; n < 4; ++n) { const s16x8 vb = *(const LAS s16x8*)(VT + (n * 16 + fr) * TP + 32 * ks + 8 * fq); oacc[n] = mma_bf16(pa, vb, oacc[n]);
              const s16x8 sb = *(const LAS s16x8*)(ST + (dir * 64 + n * 16 + fr) * TP + 32 * ks + 8 * fq); oacc[n] = mma_bf16(qa[ks], sb, oacc[n]); } }
    }
    if (dir == 1) {
#pragma unroll
        for (int n = 0; n < 4; ++n)
#pragma unroll
            for (int i = 0; i < 4; ++i) OB[(mt * 16 + 4 * fq + i) * 65 + n * 16 + fr] = oacc[n][i]; }
    __syncthreads();
    if (dir == 0) { float ss[4] = {0.f, 0.f, 0.f, 0.f};
#pragma unroll
        for (int n = 0; n < 4; ++n)
#pragma unroll
            for (int i = 0; i < 4; ++i) { oacc[n][i] += OB[(mt * 16 + 4 * fq + i) * 65 + n * 16 + fr]; ss[i] += oacc[n][i] * oacc[n][i]; }
#pragma unroll
        for (int i = 0; i < 4; ++i) { float s = ss[i]; s += __shfl_xor(s, 1); s += __shfl_xor(s, 2); s += __shfl_xor(s, 4); s += __shfl_xor(s, 8); ss[i] = 1.f / sqrtf(s * (1.f / 64.f) + EPS); }
#pragma unroll
        for (int n = 0; n < 4; ++n) { const int dv = n * 16 + fr; const float gn = p.hgrn_norm_g[l * 64 + dv];
#pragma unroll
            for (int i = 0; i < 4; ++i) { const int t = mt * 16 + 4 * fq + i; const float gate = siluf((float)GR[t * TP + dv]);
                MIX[(size_t)(ti.row0 + t) * DM + 768 + h * 64 + dv] = (f16)(oacc[n][i] * ss[i] * gn * gate); } } }
    __syncthreads();
}
DI void phase_hgrn_out(const Params& p, int l, ldsp lds, int tid, int lane, int wave, int vcu, int G) {
    for (int it = vcu; it < 528 * 4; it += G) { const TileInfo ti = tile_info(it >> 2); hgrn_out_item(p, l, ti, it & 3, lds, tid, lane, wave); }
}

DI void phase_router(const Params& p, int l, ldsp lds, int tid, int lane, int wave, int vcu, int G) {
    const float* MOD = (const float*)(p.ws + WS_MOD); f16* H = (f16*)(p.ws + WS_H); const float* XC = (const float*)(p.ws + WS_XC); const float* WR = (const float*)(p.ws + WS_WR) + (size_t)l * 1024 * 48;
    float* GT = (float*)(p.ws + WS_GATES); int* LIST = (int*)(p.ws + WS_LIST); unsigned* CNT = (unsigned*)(p.ws + WS_CTL) + CW_CNT + l * 32 * 16;
    constexpr int XP = 1028;
    LAS float* XT = (LAS float*)lds;
    LAS float* PART = XT + 16 * XP;
    LAS float* LG = PART + 8 * 16 * 48;
    const int fr = lane & 15, fq = lane >> 4;
    for (int tile = vcu; tile < TT / 16; tile += G) {
        const int row0 = tile * 16;
#pragma unroll 1
        for (int rr = wave; rr < 16; rr += 8) { const int row = row0 + rr; const float* xr = (row < TL) ? p.out + (size_t)row * DM : XC + (size_t)(row - TL) * DM; const int b = modb_of_row(row);
            const float* m2 = MOD + ((size_t)l * 5 + b) * 6144; const float* gn = p.norm2_g + l * DM;
            f32x4 v[4]; float s = 0.f;
#pragma unroll
            for (int j = 0; j < 4; ++j) { v[j] = *(const f32x4*)(xr + 256 * j + 4 * lane); s += v[j][0] * v[j][0] + v[j][1] * v[j][1] + v[j][2] * v[j][2] + v[j][3] * v[j][3]; }
            const float r = 1.f / sqrtf(wave_sum(s) * (1.f / DM) + EPS);
#pragma unroll
            for (int j = 0; j < 4; ++j) { const int c = 256 * j + 4 * lane; const f32x4 g = *(const f32x4*)(gn + c), sh = *(const f32x4*)(m2 + 3 * 1024 + c), sc = *(const f32x4*)(m2 + 4 * 1024 + c);
                f32x4 hv; f16x4 o;
#pragma unroll
                for (int i = 0; i < 4; ++i) { hv[i] = v[j][i] * r * g[i] * (1.f + sc[i]) + sh[i]; o[i] = (f16)hv[i]; }
                *(f16x4*)(H + (size_t)row * DM + c) = o; *(LAS f32x4*)(XT + rr * XP + c) = hv; } }
        __syncthreads();
        { f32x4 acc[3];
#pragma unroll
          for (int n = 0; n < 3; ++n) acc[n] = (f32x4){0.f, 0.f, 0.f, 0.f};
#pragma unroll 4
          for (int s = 0; s < 32; ++s) { const int k = wave * 128 + 4 * s + fq; const float a = XT[fr * XP + k];
#pragma unroll
              for (int n = 0; n < 3; ++n) { const float bv = WR[(size_t)k * 48 + 16 * n + fr]; acc[n] = __builtin_amdgcn_mfma_f32_16x16x4f32(a, bv, acc[n], 0, 0, 0); } }
#pragma unroll
          for (int n = 0; n < 3; ++n)
#pragma unroll
              for (int i = 0; i < 4; ++i) PART[(wave * 16 + 4 * fq + i) * 48 + 16 * n + fr] = acc[n][i]; }
        __syncthreads();
        for (int i = tid; i < 16 * 36; i += 512) { const int tk = i / 36, o = i % 36; float s = 0.f;
#pragma unroll
            for (int w = 0; w < 8; ++w) s += PART[(w * 16 + tk) * 48 + o];
            LG[tk * 48 + o] = s + (o < 4 ? p.rgb[l * 4 + o] : p.reb[l * 32 + (o - 4)]); }
        __syncthreads();
        if (tid < 16) { const int row = row0 + tid; const LAS float* lg = LG + tid * 48;
            int g = 0; float gm = lg[0];
#pragma unroll
            for (int j = 1; j < 4; ++j) if (lg[j] > gm) { gm = lg[j]; g = j; }
            float den = 0.f;
#pragma unroll
            for (int j = 0; j < 4; ++j) den += expf(lg[j] - gm);
            const float pg = 1.f / den;
            const LAS float* le = lg + 4 + 8 * g; int e0 = 0; float m0 = le[0];
#pragma unroll
            for (int j = 1; j < 8; ++j) if (le[j] > m0) { m0 = le[j]; e0 = j; }
            int e1 = -1; float m1 = -INFINITY;
#pragma unroll
            for (int j = 0; j < 8; ++j) if (j != e0 && le[j] > m1) { m1 = le[j]; e1 = j; }
            const float w0 = 1.f / (1.f + expf(m1 - m0)), w1 = 1.f - w0;
            GT[row * 2] = pg * w0; GT[row * 2 + 1] = pg * w1;
            const int E0 = 8 * g + e0, E1 = 8 * g + e1;
            const unsigned p0 = atomicAdd(CNT + E0 * 16, 1u); LIST[(size_t)E0 * TT + p0] = row * 2;
            const unsigned p1 = atomicAdd(CNT + E1 * 16, 1u); LIST[(size_t)E1 * TT + p1] = row * 2 + 1; }
        __syncthreads();
    }
}

DI int moe_setup(const Params& p, int l, ldsp lds, int tid) {
    LAS int* blk = (LAS int*)(lds + BLK_OFF); LAS int* cnt = blk + 40;
    const unsigned* CNT = (const unsigned*)(p.ws + WS_CTL) + CW_CNT + l * 32 * 16;
    if (tid < 32) cnt[tid] = (int)__hip_atomic_load(CNT + tid * 16, __ATOMIC_RELAXED, __HIP_MEMORY_SCOPE_AGENT);
    __syncthreads();
    if (tid == 0) { int a = 0; for (int e = 0; e < 32; ++e) { blk[e] = a; a += (cnt[e] + 255) >> 8; } blk[32] = a; }
    __syncthreads();
    return blk[32];
}

#if defined(__HIP_DEVICE_COMPILE__)
#define LOADP() Params p; { const __attribute__((address_space(4))) Params* kp_ = (const __attribute__((address_space(4))) Params*)__builtin_amdgcn_kernarg_segment_ptr(); asm volatile("" : "+s"(kp_)); \
    __builtin_memcpy(&p, (const Params*)kp_, sizeof(Params)); }
#else
#define LOADP() Params p = p_unused;
#endif
#define PV() int tid = tid0; asm volatile("" : "+v"(tid)); const int lane = tid & 63, wave = __builtin_amdgcn_readfirstlane(tid >> 6); int G = G0, bx = bx0; asm volatile("" : "+s"(G), "+s"(bx)); \
    const int vcu = (G % 8 == 0) ? (bx % 8) * (G / 8) + bx / 8 : bx; int l = l0; asm volatile("" : "+s"(l)); (void)lane; (void)wave; (void)vcu; (void)l;
template <int L0> DI void layer_body(const XcdBarrier& bar, ldsp lds, const int tid0, const int G0, const int bx0, const Params& p_unused) {
    constexpr int l0 = L0;


#ifndef SKIP_INPROJ
        { LOADP(); PV(); unsigned char* ws = p.ws; pg8::Gemm g{(const f16*)(ws + WS_H), (const f16*)(ws + WS_WIN) + (size_t)l * INC * DM, DM, 0}; pg8::StaticOrder S; S.init(TT, INC, G, bx);
          EpiP E{(f16*)(ws + WS_P), INC};
          pg8::gemm_phase<EpiP, pg8::StaticOrder, true, false>(lds, g, S, E); }
#endif

        xcd_barrier(bar);

#ifndef SKIP_PREP
        { LOADP(); PV(); phase_prep(p, l, lds, tid, lane, wave, vcu, G); }
#endif

        xcd_barrier(bar);

#ifndef SKIP_SCAN
        { LOADP(); PV(); phase_scan(p, tid, vcu, G); }
#endif


#ifndef SKIP_ATTN
        { LOADP(); PV(); phase_attn(p, l, lds, tid, lane, wave, vcu, G); }
#endif

        xcd_barrier(bar);

#ifndef SKIP_HOUT
        { LOADP(); PV(); phase_hgrn_out(p, l, lds, tid, lane, wave, vcu, G); }
#endif

        xcd_barrier(bar);

#ifndef SKIP_OUTPROJ
        { LOADP(); PV(); unsigned char* ws = p.ws; pg8::Gemm g{(const f16*)(ws + WS_MIX), (const f16*)(ws + WS_WOUT) + (size_t)l * DM * DM, DM, 0}; pg8::StaticOrder S; S.init(TT, DM, G, bx);
          EpiOut E{l == 0 ? p.x : p.out, l == 0 ? p.ctx : (const float*)(ws + WS_XC), p.out, (float*)(ws + WS_XC), (const float*)(ws + WS_MOD) + (size_t)l * 5 * 6144};
          pg8::gemm_phase<EpiOut, pg8::StaticOrder, true, false>(lds, g, S, E); }
#endif

        xcd_barrier(bar);

#ifndef SKIP_ROUTER
        { LOADP(); PV(); phase_router(p, l, lds, tid, lane, wave, vcu, G); }
#endif

        xcd_barrier(bar);

#ifndef SKIP_MOE1
        { LOADP(); PV(); unsigned char* ws = p.ws; const int nblk = moe_setup(p, l, lds, tid);
          pg8::Gemm g{(const f16*)(ws + WS_H), (const f16*)(ws + WS_WGU) + (size_t)l * NEXP * 1024 * 1024, DM, (size_t)1024 * 1024};
          pg8::MoeOrder S{G, bx, nblk, (const LAS int*)(lds + BLK_OFF), (const LAS int*)(lds + BLK_OFF) + 40, (const int*)(ws + WS_LIST), DM * 2};
          EpiMoe1 E{(f16*)(ws + WS_HID)};
          pg8::gemm_phase<EpiMoe1, pg8::MoeOrder, true, true>(lds, g, S, E); }
#endif

        xcd_barrier(bar);

#ifndef SKIP_MOE2
        { LOADP(); PV(); unsigned char* ws = p.ws; const int nblk = ((const LAS int*)(lds + BLK_OFF))[32];
          pg8::Gemm g{(const f16*)(ws + WS_HID), (const f16*)(ws + WS_WD) + (size_t)l * NEXP * 1024 * 512, EH, (size_t)1024 * 512};
          pg8::MoeOrder S{G, bx, nblk, (const LAS int*)(lds + BLK_OFF), (const LAS int*)(lds + BLK_OFF) + 40, (const int*)(ws + WS_LIST), EH * 2};
          EpiMoe2 E{(f16*)(ws + WS_Y2), (const int*)(ws + WS_LIST), (const LAS int*)(lds + BLK_OFF) + 40};
          pg8::gemm_phase<EpiMoe2, pg8::MoeOrder, true, false>(lds, g, S, E); }
#endif

        xcd_barrier(bar);

#ifndef SKIP_COMBINE
        { LOADP(); PV(); phase_combine(p, l, lane, wave, vcu, G); }
#endif

        if (l0 < DEPTH - 1) xcd_barrier(bar);

}

__global__ void __launch_bounds__(512, 2) fwd_kernel(Params p_unused) {
    extern __shared__ __attribute__((aligned(16))) unsigned char lds_raw[];
    ldsp lds = (ldsp)lds_raw;
    const int tid0 = threadIdx.x; const int G0 = gridDim.x; const int bx0 = blockIdx.x;
    const int tid = tid0;
    volatile LAS unsigned* MISC = (volatile LAS unsigned*)(lds + MISC_OFF);
    for (int u = tid; u < (LDS_BYTES - MISC_OFF) / 4; u += 512) ((LAS unsigned*)(lds + MISC_OFF))[u] = 0u;
    __syncthreads();
    XcdBarrier bar;
    { LOADP(); bar = xcd_barrier_post((unsigned*)(p.ws + WS_CTL) + CW_BAR, MISC + 8); }


    const int l0 = 0;
#ifndef SKIP_PROLOGUE
    { LOADP(); PV(); phase_prologue(p, lds, tid, lane, wave, vcu, G); }
#endif

    xcd_barrier(bar);

#ifndef SKIP_MOD0
        { LOADP(); PV(); phase_mod0(p, lane, wave, vcu, G); }
#endif

    xcd_barrier(bar);
    layer_body<0>(bar, lds, tid0, G0, bx0, p_unused); layer_body<1>(bar, lds, tid0, G0, bx0, p_unused); layer_body<2>(bar, lds, tid0, G0, bx0, p_unused); layer_body<3>(bar, lds, tid0, G0, bx0, p_unused);
}

extern "C" void kernel_launch(void* const* d_in, const int* in_sizes, int n_in, void* d_out, int out_size, void* d_ws, size_t ws_size, hipStream_t stream) {
    static int grid = 0;
    if (grid == 0) {
        if (n_in != 24 || out_size != TL * DM || ws_size < WS_END) { fprintf(stderr, "kernel_launch: unexpected shapes (n_in %d, out %d, ws %zu < %zu)\n", n_in, out_size, ws_size, (size_t)WS_END); grid = -1; return; }
        int dev = 0, cus = 0, per_cu = 0;
        if (hipGetDevice(&dev) != hipSuccess || hipDeviceGetAttribute(&cus, hipDeviceAttributeMultiprocessorCount, dev) != hipSuccess) { grid = -1; return; }
        if (hipFuncSetAttribute((const void*)fwd_kernel, hipFuncAttributeMaxDynamicSharedMemorySize, LDS_BYTES) != hipSuccess) { fprintf(stderr, "kernel_launch: hipFuncSetAttribute failed\n"); grid = -1; return; }
        if (hipOccupancyMaxActiveBlocksPerMultiprocessor(&per_cu, (const void*)fwd_kernel, 512, LDS_BYTES) != hipSuccess || per_cu < 1) { fprintf(stderr, "kernel_launch: occupancy query reports %d\n", per_cu); }
        (void)hipGetLastError();
        grid = cus;
    }
    if (grid < 0) return;
    (void)hipMemsetAsync((char*)d_ws + WS_CTL, 0, CTL_ZERO_BYTES, stream);
    Params p{};
    const float** pp = (const float**)&p;
    for (int i = 0; i < 24; ++i) pp[i] = (const float*)d_in[i];
    p.out = (float*)d_out; p.ws = (unsigned char*)d_ws;
    hipLaunchKernelGGL(fwd_kernel, dim3(grid), dim3(512), LDS_BYTES, stream, p);
}
```

```cpp
#include <hip/hip_runtime.h>
#include <cstdio>
#include <cstdint>

#define DI __device__ __forceinline__
#ifndef AMP_PHASE
#define AMP_PHASE 0
#endif
#define AMP_K 4
#ifndef DUP_PHASE
#define DUP_PHASE 0
#endif
#define LAS __attribute__((address_space(3)))
#define GAS __attribute__((address_space(1)))
typedef _Float16 f16;
typedef _Float16 f16x8 __attribute__((ext_vector_type(8)));
typedef _Float16 f16x4 __attribute__((ext_vector_type(4)));
typedef _Float16 f16x2 __attribute__((ext_vector_type(2)));
typedef short s16x8 __attribute__((ext_vector_type(8)));
typedef short s16x4 __attribute__((ext_vector_type(4)));
typedef float f32x4 __attribute__((ext_vector_type(4)));
typedef float f32x2 __attribute__((ext_vector_type(2)));
typedef float f32x16 __attribute__((ext_vector_type(16)));
typedef unsigned u32x4 __attribute__((ext_vector_type(4)));
typedef unsigned u32x2 __attribute__((ext_vector_type(2)));
typedef LAS unsigned char* ldsp;

constexpr int DM = 1024, NB = 4, SEQ = 8192, CTXL = 256, DEPTH = 4;
constexpr int TL = NB * SEQ, TC = NB * CTXL, TT = TL + TC;
constexpr int INC = 2304;
constexpr int C_U = 0, C_Q = 256, C_K = 768, C_V = 896, C_HQ = 1024, C_HI = 1280, C_HZF = 1536, C_HZB = 1792, C_HG = 2048;
constexpr int NEXP = 32, EH = 512;
constexpr int NPOS = 132;
constexpr float EPS = 1e-6f;
constexpr float LOG2E = 1.4426950408889634f;
constexpr int MAXBLK = 296;

constexpr size_t MiB = 1u << 20;
constexpr size_t WS_CTL = 0, CTL_ZERO_BYTES = 1 * MiB;
constexpr size_t WS_WIN = 1 * MiB;
constexpr size_t WS_WOUT = WS_WIN + (size_t)DEPTH * INC * DM * 2;
constexpr size_t WS_WGU = WS_WOUT + (size_t)DEPTH * DM * DM * 2;
constexpr size_t WS_WD = WS_WGU + (size_t)DEPTH * NEXP * 1024 * 1024 * 2;
constexpr size_t WS_POOLW = WS_WD + (size_t)DEPTH * NEXP * 1024 * 512 * 2;
constexpr size_t WS_WR = WS_POOLW + (size_t)DEPTH * 4 * 64 * 64 * 2;
constexpr size_t WS_MOD = WS_WR + (size_t)DEPTH * 1024 * 48 * 4;
constexpr size_t WS_LB = WS_MOD + (size_t)DEPTH * 5 * 6144 * 4;
constexpr size_t WS_ROPE = WS_LB + (size_t)DEPTH * 2 * 256 * 4;
constexpr size_t WS_XC = WS_ROPE + (size_t)(2 * 128 * 16 + 2 * 64 * 16) * 4;
constexpr size_t WS_GATES = WS_XC + (size_t)TC * DM * 4;
constexpr size_t WS_SLOT = WS_GATES + (size_t)TT * 2 * 4;
constexpr size_t WS_LIST = WS_SLOT + (size_t)TT * 2 * 4;
constexpr size_t WS_H = WS_LIST + (size_t)NEXP * TT * 4;
constexpr size_t WS_P = WS_H + (size_t)TT * DM * 2;
constexpr size_t WS_Y2 = WS_P;
constexpr size_t WS_DELTA = WS_P;
constexpr size_t WS_QN = WS_P + (size_t)TT * INC * 2;
constexpr size_t WS_KN = WS_QN + (size_t)TT * 512 * 2;
constexpr size_t WS_MIX = WS_KN + (size_t)TT * 128 * 2;
constexpr size_t WS_HS = WS_MIX + (size_t)TT * DM * 2;
constexpr size_t WS_HA = WS_HS + (size_t)2 * NB * NPOS * 4 * 4096 * 4;
constexpr size_t WS_HSB = WS_HA + (size_t)2 * NB * NPOS * 4 * 64 * 4;
constexpr size_t WS_QS = WS_HSB + (size_t)2 * NB * NPOS * 4 * 4096 * 2;
constexpr size_t WS_END0 = WS_QS + (size_t)TT * 256 * 2;
constexpr size_t WS_HID = WS_QN;
constexpr size_t WS_DUMMY = WS_END0;
constexpr size_t WS_END = WS_END0 + (DUP_PHASE ? 144 * MiB : 0);
static_assert((size_t)2 * TT * DM * 2 <= (size_t)TT * INC * 2, "Y2 fits in P");
static_assert(WS_HID + (size_t)MAXBLK * 256 * EH * 2 <= WS_END0, "HID fits in its overlay");
static_assert(WS_WIN % 256 == 0 && WS_H % 256 == 0 && WS_P % 256 == 0 && WS_QN % 256 == 0 && WS_KN % 256 == 0 && WS_MIX % 256 == 0 && WS_HS % 256 == 0 && WS_HA % 256 == 0 && WS_XC % 256 == 0 && WS_LIST % 256 == 0 && WS_GATES % 256 == 0, "alignment");
constexpr int CW_BAR = 4096;
constexpr int CW_QUEUE = 12288;
constexpr int CW_CVQ = 13312;
constexpr int CW_CNT = 16384;
constexpr int RING_BYTES = 131072;
constexpr int MISC_OFF = RING_BYTES;
constexpr int BLK_OFF = MISC_OFF + 512;
constexpr int LDS_BYTES = 147456;

struct Params {
    const float *x, *c, *ctx, *c_ctx, *norm1_g, *norm2_g, *ada_w, *ada_b, *w_in, *w_out, *pool_w, *pool_scale, *q_norm_g, *k_norm_g, *attn_sink, *hgrn_lb,
        *hgrn_norm_g, *rgw, *rgb, *rew, *reb, *ewg, *ewu, *ewd;
    float* out; unsigned char* ws;
};

DI unsigned short f2bf(float f) { unsigned u = __builtin_bit_cast(unsigned, f); return (unsigned short)((u + 0x7fffu + ((u >> 16) & 1u)) >> 16); }
DI float wave_sum(float v) {
#pragma unroll
    for (int o = 1; o < 64; o <<= 1) v += __shfl_xor(v, o);
    return v;
}
DI float fast_rcp(float v) { return __builtin_amdgcn_rcpf(v); }
DI float siluf(float v) { return v * fast_rcp(1.f + __expf(-v)); }
DI unsigned cvt_pk_bf16(float lo, float hi) { unsigned r; asm volatile("v_cvt_pk_bf16_f32 %0, %1, %2" : "=v"(r) : "v"(lo), "v"(hi)); return r; }
DI int modb_of_row(int row) { return row < TL ? (row >> 13) : 4; }

#define XB_TMO      128
#define XB_XCNT(j)  (256  + 64 * (j))
#define XB_XSUB(j)  (1280 + 64 * (j))
#define XB_XGEN(j)  (2304 + 64 * (j))
#define XB_TOP      3328
#define XB_TOPGEN   3392
#define XCD_BAR_WORDS 3456
#define XB_SPIN_CAP (1u << 18)
__device__ __forceinline__ unsigned xb_ld(unsigned* p)              { return __hip_atomic_load(p, __ATOMIC_RELAXED, __HIP_MEMORY_SCOPE_AGENT); }
__device__ __forceinline__ unsigned xb_add(unsigned* p, unsigned v) { return __hip_atomic_fetch_add(p, v, __ATOMIC_RELAXED, __HIP_MEMORY_SCOPE_AGENT); }
__device__ __forceinline__ unsigned xb_xcc_id() { return (unsigned)__builtin_amdgcn_s_getreg((3 << 11) | 20) & 0xFu; }
#define XB_SPIN(cond, bar) do { unsigned _sp = 0; while (cond) { __builtin_amdgcn_s_sleep(1); \
    if ((++_sp & 255u) == 0u) { if (xb_ld(&(bar)[XB_TMO])) break; if (_sp > XB_SPIN_CAP) { atomicAdd(&(bar)[XB_TMO], 1u); break; } } } } while (0)
struct XcdBarrier { unsigned* bar; unsigned x; volatile LAS unsigned* st; };
__device__ __forceinline__ XcdBarrier xcd_barrier_post(unsigned* bar, volatile LAS unsigned* st) {
    XcdBarrier b; b.bar = bar; b.x = xb_xcc_id(); b.st = st;
    if (threadIdx.x == 0) (void)xb_add(&bar[XB_XCNT(b.x)], 1u);
    return b;
}
__device__ __forceinline__ void xcd_barrier_complete(unsigned* bar, unsigned x, unsigned& nloc, unsigned& nx) {
    const unsigned G = gridDim.x * gridDim.y * gridDim.z;
    unsigned sum, cnt, mine, sp = 0u;
    for (;;) {
        sum = 0u; cnt = 0u; mine = 0u;
#pragma unroll 1
        for (unsigned j = 0; j < 16; ++j) { const unsigned c = xb_ld(&bar[XB_XCNT(j)]); sum += c; cnt += (c > 0u) ? 1u : 0u; mine = (j == x) ? c : mine; }
        if (sum == G) break;
        __builtin_amdgcn_s_sleep(1);
        if ((++sp & 255u) == 0u) { if (xb_ld(&bar[XB_TMO])) break; if (sp > XB_SPIN_CAP) { atomicAdd(&bar[XB_TMO], 1u); break; } }
    }
    nloc = mine > 0u ? mine : 1u; nx = cnt > 0u ? cnt : 1u;
}
__device__ __forceinline__ void xcd_barrier(const XcdBarrier& b) {
    asm volatile("s_waitcnt vmcnt(0)" ::: "memory");
    __syncthreads();
    if (threadIdx.x == 0) {
        unsigned* bar = b.bar;
        __builtin_amdgcn_s_waitcnt(0);
        unsigned nloc = b.st[0], nx = b.st[1];
        if (nloc == 0u) { xcd_barrier_complete(bar, b.x, nloc, nx); b.st[0] = nloc; b.st[1] = nx; }
        const unsigned old = xb_add(&bar[XB_XSUB(b.x)], 1u);
        const unsigned gen = old / nloc;
        if (old + 1u == (gen + 1u) * nloc) {
            __builtin_amdgcn_fence(__ATOMIC_RELEASE, "agent");
            asm volatile("s_waitcnt vmcnt(0)" ::: "memory");
            const unsigned og = xb_add(&bar[XB_TOP], 1u);
            const unsigned tg = og / nx;
            if (og + 1u == (tg + 1u) * nx) xb_add(&bar[XB_TOPGEN], 1u);
            else XB_SPIN(xb_ld(&bar[XB_TOPGEN]) == tg, bar);
            __builtin_amdgcn_fence(__ATOMIC_ACQUIRE, "agent");
            xb_add(&bar[XB_XGEN(b.x)], 1u);
            asm volatile("s_waitcnt vmcnt(0)" ::: "memory");
        } else {
            XB_SPIN(xb_ld(&bar[XB_XGEN(b.x)]) == gen, bar);
            __builtin_amdgcn_fence(__ATOMIC_ACQUIRE, "agent");
            asm volatile("s_waitcnt vmcnt(0)" ::: "memory");
        }
    }
    __syncthreads();
}

namespace pg8 {
constexpr int BM = 256, BK = 64, HALF = 128, HTB = HALF * BK * 2, STAGE_BYTES = 8 * HTB, NXCD = 8, WGM = 8;
DI int lds_byte(int r, int c) { const int st = (r >> 4) * 2 + (c >> 5), rr = r & 15, cc = c & 31, ob = rr * 64 + cc * 2; return st * 1024 + (ob ^ (((ob >> 9) & 1) << 5)); }
DI void stage_rc(int b, int& R, int& C) { const int st = b / 1024, sb = b % 1024, swz = sb ^ (((sb >> 9) & 1) << 5); R = (st >> 1) * 16 + swz / 64; C = (st & 1) * 32 + (swz % 64) / 2; }
DI int perm32(int rho) { const int n = rho >> 4, i = rho & 15; return 8 * (i >> 2) + 4 * n + (i & 3); }

struct Unit { int pm, pn, e, lrb; };
struct Gemm { const f16* A; const f16* Bt; int K; size_t bstride; };

struct StaticOrder {
    int nM, nN, nwg, G, c;
    DI void init(int M, int N, int G_, int c_) { nM = M / BM; nN = N / BM; nwg = nM * nN; G = G_; c = c_; }
    DI bool next(int i, Unit& u) const {
        const long L = (long)i * G + c; if (L >= nwg) return false;
        int wgid = (int)L; { const int q = nwg / NXCD, r = nwg % NXCD, xcd = wgid % NXCD, off = wgid / NXCD; wgid = (xcd < r ? xcd * (q + 1) : r * (q + 1) + (xcd - r) * q) + off; }
        const int nig = WGM * nN, gid = wgid / nig, fm = gid * WGM, gsz = (nM - fm) < WGM ? (nM - fm) : WGM;
        u.pm = fm + ((wgid % nig) % gsz); u.pn = (wgid % nig) / gsz; u.e = 0; u.lrb = 0; return true;
    }
    DI unsigned arow(const Unit&, int) const { return 0u; }
};
DI int moe_unit(int i, int G, int c, int U) {
    if (G % 8 != 0) { const int L = i * G + c; return L < U ? L : -1; }
    const int x = c & 7, j = c >> 3, W = G >> 3; const int lo = (int)(((long)U * x) >> 3), hi = (int)(((long)U * (x + 1)) >> 3); const int k = lo + i * W + j; return k < hi ? k : -1;
}
struct MoeOrder {
    int G, c, nblk; const LAS int* blk; const LAS int* cnt; const int* list; int rowbytes;
    const LAS int* utab;
    DI bool next(int i, Unit& u) const {
        const int L = moe_unit(i, G, c, nblk * 4); if (L < 0) return false;
        const int rb = L >> 2; u.pn = L & 3; u.pm = rb;
        const int t = utab[i]; u.e = t >> 16; u.lrb = t & 0xffff; return true;
    }
    DI unsigned arow(const Unit& u, int r) const {
        const int pos = u.lrb * 256 + r; const int ent = (pos < cnt[u.e]) ? list[(size_t)u.e * TT + pos] : 0;
        return (unsigned)(ent >> 1) * (unsigned)rowbytes;
    }
};

template <class Epi, class Sched, bool ALIGN_EPI, bool GATHER>
DI void gemm_phase(ldsp lds, const Gemm g, const Sched& S, const Epi& E, const int tid) {
    const int wid = __builtin_amdgcn_readfirstlane(tid >> 6), lane = tid & 63, wr = wid >> 2, wc = wid & 3, fr = lane & 15, fq = lane >> 4;
    const int K = g.K, nt = K / BK;
    int Rr[2], Cc[2]; unsigned voffB[2], voffA[2];
#pragma unroll
    for (int i = 0; i < 2; ++i) { int R, C; stage_rc(tid * 16 + i * 8192, R, C); const int Rb = Epi::PERM ? ((R & ~31) + perm32(R & 31)) : R;
        Rr[i] = R; Cc[i] = C; voffB[i] = (unsigned)(Rb * K + C) * 2u; voffA[i] = (unsigned)(R * K + C) * 2u; }
    const size_t kstep = (size_t)(BK * 2);
    const size_t hstep = (size_t)HALF * K * 2;
    const size_t tstep = 2 * hstep;
    const unsigned ldsw = (unsigned)wid * 1024u;
    const int aoff = lds_byte(wr * 64 + fr, fq * 8), boff = lds_byte(wc * 32 + fr, fq * 8);
    const char* const Ab = (const char*)g.A;
#define PG8_SA(b, h) (((b) * 2 + (h)) * HTB)
#define PG8_SB(b, h) ((4 + (b) * 2 + (h)) * HTB)
#define PG8_STAGE(bufoff, gbase, voff) do { _Pragma("unroll") for (int _i = 0; _i < 2; ++_i) \
        __builtin_amdgcn_global_load_lds((const unsigned*)((const char*)(gbase) + (voff)[_i]), (LAS unsigned*)(lds + (bufoff) + ldsw + _i * 8192), 16, 0, 0); } while (0)
#define PG8_LDA(dst, b, h) do { _Pragma("unroll") for (int m = 0; m < 4; ++m) _Pragma("unroll") for (int k = 0; k < 2; ++k) dst[m][k] = *(const LAS f16x8*)(lds + PG8_SA(b, h) + aoff + m * 2048 + k * 1024); } while (0)
#define PG8_LDB(dst, b, h) do { _Pragma("unroll") for (int n = 0; n < 2; ++n) _Pragma("unroll") for (int k = 0; k < 2; ++k) dst[n][k] = *(const LAS f16x8*)(lds + PG8_SB(b, h) + boff + n * 2048 + k * 1024); } while (0)
#define PG8_MMA(ai, bj, At, Bt) do { __builtin_amdgcn_s_setprio(1); _Pragma("unroll") for (int m = 0; m < 4; ++m) _Pragma("unroll") for (int n = 0; n < 2; ++n) _Pragma("unroll") for (int k = 0; k < 2; ++k) \
        acc[ai][bj][m][n] = __builtin_amdgcn_mfma_f32_16x16x32_f16(Bt[n][k], At[m][k], acc[ai][bj][m][n], 0, 0, 0); __builtin_amdgcn_s_setprio(0); } while (0)
#define PG8_WAIT_V(n) asm volatile("s_waitcnt vmcnt(" #n ")" ::: "memory")
#define PG8_WAIT_L(n) asm volatile("s_waitcnt lgkmcnt(" #n ")" ::: "memory")
#define PG8_BAR __builtin_amdgcn_s_barrier()
#define PG8_SCHED __builtin_amdgcn_sched_barrier(0)
#define PG8_AOFF(dst, U) do { if constexpr (GATHER) { _Pragma("unroll") for (int _h = 0; _h < 2; ++_h) _Pragma("unroll") for (int _i = 0; _i < 2; ++_i) \
        dst[_h][_i] = S.arow(U, _h * HALF + Rr[_i]) + (unsigned)Cc[_i] * 2u; } } while (0)
#define PG8_STAGE_A(bufoff, kb, nx, h) do { if constexpr (GATHER) { if (nx) PG8_STAGE(bufoff, Ab + (kb), aon[h]); else PG8_STAGE(bufoff, Ab + (kb), aoc[h]); } \
        else { PG8_STAGE(bufoff, ((nx) ? nA : cA) + (kb) + (h) * hstep, voffA); } } while (0)
    Unit cur, nxt; int ui = 0;
    if (!S.next(0, cur)) return;
    f32x4 acc[2][2][4][2];
#pragma unroll
    for (int a = 0; a < 2; ++a)
#pragma unroll
        for (int b = 0; b < 2; ++b)
#pragma unroll
            for (int m = 0; m < 4; ++m)
#pragma unroll
                for (int n = 0; n < 2; ++n) acc[a][b][m][n] = (f32x4){0.f, 0.f, 0.f, 0.f};
    f16x8 At[4][2], B0[2][2], B1[2][2];
    unsigned aoc[2][2], aon[2][2];
    PG8_AOFF(aoc, cur);
    const char* cA = Ab + (GATHER ? (size_t)0 : (size_t)cur.pm * tstep); const char* nA = cA;
    const char* cB = (const char*)g.Bt + ((size_t)cur.e * g.bstride) * 2 + (size_t)cur.pn * tstep;
    PG8_STAGE(PG8_SB(0, 0), cB, voffB); PG8_STAGE(PG8_SB(0, 1), cB + hstep, voffB); PG8_STAGE_A(PG8_SA(0, 0), 0, 0, 0); PG8_STAGE_A(PG8_SA(0, 1), 0, 0, 1);
    if (wr == 1) PG8_BAR;
    PG8_WAIT_V(2); PG8_BAR;
    PG8_STAGE(PG8_SB(1, 0), cB + kstep, voffB); PG8_STAGE_A(PG8_SA(1, 0), kstep, 0, 0); PG8_STAGE(PG8_SB(1, 1), cB + hstep + kstep, voffB);
    PG8_WAIT_V(6); PG8_BAR;
    for (;;) {
        const bool has_next = S.next(ui + 1, nxt);
        if constexpr (GATHER) { if (has_next) { PG8_AOFF(aon, nxt); } else {
#pragma unroll
            for (int _h = 0; _h < 2; ++_h)
#pragma unroll
                for (int _i = 0; _i < 2; ++_i) aon[_h][_i] = aoc[_h][_i]; } }
        else { nA = has_next ? Ab + (size_t)nxt.pm * tstep : cA; }
        const char* nB = has_next ? (const char*)g.Bt + ((size_t)nxt.e * g.bstride) * 2 + (size_t)nxt.pn * tstep : cB;
        for (int t = 0; t < nt; t += 2) {
            const bool last = (t == nt - 2);
            const size_t k1 = (size_t)(t + 1) * kstep, k2 = last ? (size_t)0 : (size_t)(t + 2) * kstep, k3 = k2 + kstep;
            const char* b2 = last ? nB : cB + (size_t)(t + 2) * kstep; const char* b3 = b2 + kstep;
            PG8_LDB(B0, 0, 0); PG8_LDB(B1, 0, 1); PG8_SCHED; PG8_LDA(At, 0, 0); PG8_STAGE_A(PG8_SA(1, 1), k1, 0, 1);
            PG8_WAIT_V(8); PG8_WAIT_L(0); PG8_BAR; PG8_MMA(0, 0, At, B0); PG8_MMA(0, 1, At, B1); PG8_BAR; PG8_SCHED;
            PG8_LDA(At, 0, 1); PG8_STAGE(PG8_SB(0, 0), b2, voffB); PG8_STAGE(PG8_SB(0, 1), b2 + hstep, voffB); PG8_STAGE_A(PG8_SA(0, 0), k2, last, 0);
            PG8_WAIT_V(8); PG8_WAIT_L(0); PG8_BAR; PG8_MMA(1, 0, At, B0); PG8_MMA(1, 1, At, B1); PG8_BAR; PG8_SCHED;
            PG8_LDB(B0, 1, 0); PG8_LDB(B1, 1, 1); PG8_SCHED; PG8_LDA(At, 1, 0); PG8_STAGE_A(PG8_SA(0, 1), k2, last, 1);
            PG8_WAIT_V(8); PG8_WAIT_L(0); PG8_BAR; PG8_MMA(0, 0, At, B0); PG8_MMA(0, 1, At, B1); PG8_BAR; PG8_SCHED;
            PG8_LDA(At, 1, 1); PG8_STAGE(PG8_SB(1, 0), b3, voffB); PG8_STAGE(PG8_SB(1, 1), b3 + hstep, voffB); PG8_STAGE_A(PG8_SA(1, 0), k3, last, 0);
            PG8_WAIT_V(8); PG8_WAIT_L(0); PG8_BAR; PG8_MMA(1, 0, At, B0); PG8_MMA(1, 1, At, B1); PG8_BAR; PG8_SCHED;
        }
        if constexpr (ALIGN_EPI) { if (wr == 0) PG8_BAR; }
        E(acc, cur, wr, wc, fr, fq);
        if (!has_next) break;
#pragma unroll
        for (int a = 0; a < 2; ++a)
#pragma unroll
            for (int b = 0; b < 2; ++b)
#pragma unroll
                for (int m = 0; m < 4; ++m)
#pragma unroll
                    for (int n = 0; n < 2; ++n) acc[a][b][m][n] = (f32x4){0.f, 0.f, 0.f, 0.f};
        cur = nxt; cB = nB; cA = nA; ++ui;
        if constexpr (GATHER) {
#pragma unroll
        for (int _h = 0; _h < 2; ++_h)
#pragma unroll
            for (int _i = 0; _i < 2; ++_i) aoc[_h][_i] = aon[_h][_i]; }
        if constexpr (ALIGN_EPI) { if (wr == 1) PG8_BAR; }
    }
    PG8_WAIT_V(0);
    if constexpr (!ALIGN_EPI) { if (wr == 0) PG8_BAR; }
    PG8_BAR;
#undef PG8_SA
#undef PG8_SB
#undef PG8_STAGE
#undef PG8_LDA
#undef PG8_LDB
#undef PG8_MMA
#undef PG8_WAIT_V
#undef PG8_WAIT_L
#undef PG8_BAR
#undef PG8_SCHED
#undef PG8_AOFF
#undef PG8_STAGE_A
}
}

typedef f32x4 AccT[2][2][4][2];
DI u32x4 pack8_f16(f32x4 a, f32x4 b) {
    f16x8 h; h[0] = (f16)a[0]; h[1] = (f16)a[1]; h[2] = (f16)a[2]; h[3] = (f16)a[3]; h[4] = (f16)b[0]; h[5] = (f16)b[1]; h[6] = (f16)b[2]; h[7] = (f16)b[3];
    return __builtin_bit_cast(u32x4, h);
}
struct EpiP { static constexpr bool PERM = true; f16* O; int ldc;
    DI void operator()(const AccT& acc, const pg8::Unit& u, int wr, int wc, int fr, int fq) const {
        char* base = (char*)(O + (size_t)u.pm * 256 * ldc + u.pn * 256);
        unsigned loff = (unsigned)((wr * 64 + fr) * ldc + wc * 32 + 8 * fq) * 2u;
        asm volatile("" : "+v"(loff));
#pragma unroll
        for (int ai = 0; ai < 2; ++ai)
#pragma unroll
            for (int m = 0; m < 4; ++m) {
#pragma unroll
                for (int bj = 0; bj < 2; ++bj) *(u32x4*)(base + (size_t)((ai * 128 + m * 16) * ldc + bj * 128) * 2 + loff) = pack8_f16(acc[ai][bj][m][0], acc[ai][bj][m][1]); }
    }
};
struct EpiOut { static constexpr bool PERM = true; f16* D; const float* modl;
    DI void operator()(const AccT& acc, const pg8::Unit& u, int wr, int wc, int fr, int fq) const {
        char* base = (char*)(D + (size_t)u.pm * 256 * DM + u.pn * 256);
        const float* g1 = modl + (u.pm < 128 ? (u.pm >> 5) : 4) * 6144 + 2 * 1024 + u.pn * 256;
        unsigned loff = (unsigned)((wr * 64 + fr) * DM + wc * 32 + 8 * fq) * 2u, goff = (unsigned)(wc * 32 + 8 * fq);
        asm volatile("" : "+v"(loff), "+v"(goff));
#pragma unroll
        for (int bj = 0; bj < 2; ++bj) { const f32x4 g0 = *(const f32x4*)(g1 + goff + bj * 128), g4 = *(const f32x4*)(g1 + goff + bj * 128 + 4);
#pragma unroll
            for (int ai = 0; ai < 2; ++ai)
#pragma unroll
                for (int m = 0; m < 4; ++m) *(u32x4*)(base + (size_t)((ai * 128 + m * 16) * DM + bj * 128) * 2 + loff) = pack8_f16(acc[ai][bj][m][0] * g0, acc[ai][bj][m][1] * g4); }
    }
};
struct EpiMoe1 { static constexpr bool PERM = true; f16* HID;
    DI void operator()(const AccT& acc, const pg8::Unit& u, int wr, int wc, int fr, int fq) const {
        char* base = (char*)(HID + (size_t)u.pm * 256 * EH + u.pn * 128);
        unsigned loff = (unsigned)((wr * 64 + fr) * EH + wc * 32 + 8 * fq) * 2u;
        asm volatile("" : "+v"(loff));
#pragma unroll
        for (int ai = 0; ai < 2; ++ai)
#pragma unroll
            for (int m = 0; m < 4; ++m) { f32x4 h0, h1;
#pragma unroll
                for (int i = 0; i < 4; ++i) { h0[i] = siluf(acc[ai][0][m][0][i]) * acc[ai][1][m][0][i]; h1[i] = siluf(acc[ai][0][m][1][i]) * acc[ai][1][m][1][i]; }
                *(u32x4*)(base + (size_t)((ai * 128 + m * 16) * EH) * 2 + loff) = pack8_f16(h0, h1); }
    }
};
struct EpiMoe2 { static constexpr bool PERM = true; f16* Y2;
    DI void operator()(const AccT& acc, const pg8::Unit& u, int wr, int wc, int fr, int fq) const {
        char* base = (char*)(Y2 + (size_t)u.pm * 256 * DM + u.pn * 256);
        unsigned loff = (unsigned)((wr * 64 + fr) * DM + wc * 32 + 8 * fq) * 2u;
        asm volatile("" : "+v"(loff));
#pragma unroll
        for (int ai = 0; ai < 2; ++ai)
#pragma unroll
            for (int m = 0; m < 4; ++m) {
#pragma unroll
                for (int bj = 0; bj < 2; ++bj) *(u32x4*)(base + (size_t)((ai * 128 + m * 16) * DM + bj * 128) * 2 + loff) = pack8_f16(acc[ai][bj][m][0], acc[ai][bj][m][1]); }
    }
};

DI void p0_transpose_item(const float* W, int K, int N, f16* WT, int mode, LAS float* scr, int item, int lane) {
    const int nblk = N / 32, kb = item / nblk, nb = item % nblk, k0 = 64 * kb, n0 = 32 * nb;
    const int rbase = (mode == 0) ? n0 : (256 * (n0 >> 7) + (n0 & 127) + (mode == 2 ? 128 : 0));
#pragma unroll 8
    for (int i = 0; i < 32; ++i) { const int kk = 2 * i + (lane >> 5); scr[kk * 33 + (lane & 31)] = W[(size_t)(k0 + kk) * N + n0 + (lane & 31)]; }
    asm volatile("s_waitcnt lgkmcnt(0)" ::: "memory");
    const int c = lane & 7;
#pragma unroll
    for (int j = 0; j < 4; ++j) { const int n = (lane >> 3) + 8 * j; const LAS float* s = scr + (8 * c) * 33 + n;
        f16x8 o;
#pragma unroll
        for (int q = 0; q < 8; ++q) o[q] = (f16)s[q * 33];
        *(f16x8*)(WT + (size_t)(rbase + n) * K + k0 + 8 * c) = o; }
    asm volatile("s_waitcnt lgkmcnt(0)" ::: "memory");
}

constexpr int CV_CHUNKS = 768;
DI void expert_item(const Params& p, int l, int r, LAS float* scr, int lane) {
    unsigned char* ws = p.ws; const int e = r / 768, q = r % 768, which = q >> 8, item = q & 255; const size_t le = (size_t)l * NEXP + e;
    if (which == 0) p0_transpose_item(p.ewg + le * DM * EH, DM, EH, (f16*)(ws + WS_WGU) + le * 1024 * 1024, 1, scr, item, lane);
    else if (which == 1) p0_transpose_item(p.ewu + le * DM * EH, DM, EH, (f16*)(ws + WS_WGU) + le * 1024 * 1024, 2, scr, item, lane);
    else p0_transpose_item(p.ewd + le * EH * DM, EH, DM, (f16*)(ws + WS_WD) + le * 1024 * 512, 0, scr, item, lane);
}
DI void convert_steal(const Params& p, int l, int maxpull, ldsp lds, int tid, int lane, int wave) {
    unsigned* qh = (unsigned*)(p.ws + WS_CTL) + CW_CVQ + l * 64; volatile LAS unsigned* slot = (volatile LAS unsigned*)(lds + MISC_OFF) + 24;
    LAS float* scr = (LAS float*)(lds + wave * 16384);
    for (int k = 0; k < maxpull; ++k) {
        __syncthreads();
        if (tid == 0) slot[0] = atomicAdd(qh, 1u);
        __syncthreads();
        const unsigned c = slot[0];
        if (c >= (unsigned)CV_CHUNKS) break;
#pragma unroll 1
        for (int j = 0; j < 4; ++j) expert_item(p, l, (int)c * 32 + wave * 4 + j, scr, lane);
    }
    __syncthreads();
}

DI void phase_prologue(const Params& p, ldsp lds, int tid, int lane, int wave, int vcu, int G) {
    unsigned char* ws = p.ws;
    LAS float* scr = (LAS float*)(lds + wave * 16384);
    const int gw = vcu * 8 + wave, NGW = G * 8;
    constexpr int PER_L = 1152 + 512;
    constexpr int NW_ITEMS = DEPTH * PER_L;
    for (int it = gw; it < NW_ITEMS + 32; it += NGW) {
        if (it >= NW_ITEMS) { const int j = it - NW_ITEMS, mat = j >> 1;
            p0_transpose_item(p.pool_w + (size_t)mat * 4096, 64, 64, (f16*)(ws + WS_POOLW) + (size_t)mat * 4096, 0, scr, j & 1, lane); continue; }
        const int l = it / PER_L; int r = it % PER_L;
        if (r < 1152) { p0_transpose_item(p.w_in + (size_t)l * DM * INC, DM, INC, (f16*)(ws + WS_WIN) + (size_t)l * INC * DM, 0, scr, r, lane); continue; } r -= 1152;
        p0_transpose_item(p.w_out + (size_t)l * DM * DM, DM, DM, (f16*)(ws + WS_WOUT) + (size_t)l * DM * DM, 0, scr, r, lane);
    }
    for (int it = gw; it < 32 * 768; it += NGW) expert_item(p, 0, it, scr, lane);
    { f16* WRH = (f16*)(ws + WS_WR); f16* WRL = WRH + (size_t)DEPTH * 48 * 1024;
      for (int i = vcu * 512 + tid; i < DEPTH * 48 * 1024; i += G * 512) { const int k = i & 1023, o = (i >> 10) % 48, l = i / (48 * 1024);
          float v = 0.f; if (o < 4) v = p.rgw[((size_t)l * 1024 + k) * 4 + o]; else if (o < 36) v = p.rew[((size_t)l * 1024 + k) * 32 + (o - 4)];
          v *= 1024.f; const f16 hi = (f16)v; WRH[i] = hi; WRL[i] = (f16)(v - (float)hi); } }
    { float* RT = (float*)(ws + WS_ROPE);
      for (int i = vcu * 512 + tid; i < (128 + 64) * 16; i += G * 512) { const int m = i & 15, pos = i >> 4;
          const float inv = powf(10000.f, -(float)m / 16.f); const float ang = (float)(pos < 128 ? pos : pos - 128) * inv; float s, c; sincosf(ang, &s, &c);
          if (pos < 128) { RT[pos * 16 + m] = c; RT[2048 + pos * 16 + m] = s; } else { RT[4096 + (pos - 128) * 16 + m] = c; RT[4096 + 1024 + (pos - 128) * 16 + m] = s; } } }
    if (vcu == 0) { float* LB = (float*)(ws + WS_LB);
        const float a0 = p.hgrn_lb[tid], a1 = p.hgrn_lb[512 + tid], a2 = p.hgrn_lb[1024 + tid], a3 = p.hgrn_lb[1536 + tid];
        const float mx = fmaxf(fmaxf(a0, a1), fmaxf(a2, a3)); const float e0 = expf(a0 - mx), e1 = expf(a1 - mx), e2 = expf(a2 - mx), e3 = expf(a3 - mx); const float inv = 1.f / (e0 + e1 + e2 + e3);
        LB[tid] = 0.f; LB[512 + tid] = e1 * inv; LB[1024 + tid] = (e1 + e2) * inv; LB[1536 + tid] = (e1 + e2 + e3) * inv; }
    __syncthreads();
    { LAS float* sl = (LAS float*)lds;
      LAS float* red = (LAS float*)(lds + 32768);
      for (int i = tid; i < 5 * 1024; i += 512) { const int b = i >> 10, k = i & 1023; const float v = (b < 4) ? p.c[b * 1024 + k] : p.c_ctx[k]; sl[i] = siluf(v); }
      __syncthreads();
      float* MOD = (float*)(ws + WS_MOD);
      for (int it = vcu; it < DEPTH * 96; it += G) { const int l = it / 96, col = (it % 96) * 64 + lane;
          const float* W = p.ada_w + (size_t)l * 1024 * 6144 + col; float a[5] = {0.f, 0.f, 0.f, 0.f, 0.f};
#pragma unroll 8
          for (int k = wave * 128; k < wave * 128 + 128; ++k) { const float w = W[(size_t)k * 6144];
#pragma unroll
              for (int b = 0; b < 5; ++b) a[b] += sl[b * 1024 + k] * w; }
#pragma unroll
          for (int b = 0; b < 5; ++b) red[(wave * 5 + b) * 64 + lane] = a[b];
          __syncthreads();
          if (tid < 320) { const int b = tid >> 6, cc = tid & 63; float s = 0.f;
#pragma unroll
              for (int w = 0; w < 8; ++w) s += red[(w * 5 + b) * 64 + cc];
              const int c2 = (it % 96) * 64 + cc; MOD[((size_t)l * 5 + b) * 6144 + c2] = s + p.ada_b[l * 6144 + c2]; }
          __syncthreads(); } }
}

DI void modulate_row_store(const f32x4 (&v)[4], float r, const float* gn, const float* sh, const float* sc, f16* hrow, int lane) {
#pragma unroll
    for (int j = 0; j < 4; ++j) { const int c = 256 * j + 4 * lane; const f32x4 g = *(const f32x4*)(gn + c), s = *(const f32x4*)(sh + c), k = *(const f32x4*)(sc + c);
        f16x4 o;
#pragma unroll
        for (int i = 0; i < 4; ++i) o[i] = (f16)(v[j][i] * r * g[i] * (1.f + k[i]) + s[i]);
        *(f16x4*)(hrow + c) = o; }
}
DI void phase_mod0(const Params& p, int lane, int wave, int vcu, int G) {
    const float* MOD = (const float*)(p.ws + WS_MOD); f16* H = (f16*)(p.ws + WS_H);
    for (int row = vcu * 8 + wave; row < TT; row += G * 8) {
        const float* xr = (row < TL) ? p.x + (size_t)row * DM : p.ctx + (size_t)(row - TL) * DM; const int b = modb_of_row(row);
        f32x4 v[4]; float s = 0.f;
#pragma unroll
        for (int j = 0; j < 4; ++j) { v[j] = *(const f32x4*)(xr + 256 * j + 4 * lane); s += v[j][0] * v[j][0] + v[j][1] * v[j][1] + v[j][2] * v[j][2] + v[j][3] * v[j][3]; }
        const float r = __builtin_amdgcn_rsqf(wave_sum(s) * (1.f / DM) + EPS);
        modulate_row_store(v, r, p.norm1_g, MOD + (size_t)b * 6144, MOD + (size_t)b * 6144 + 1024, H + (size_t)row * DM, lane);
    }
}
DI void phase_combine(const Params& p, int l, ldsp lds, int lane, int wave, int vcu, int G, int dry) {
    const LAS int* blk = (const LAS int*)(lds + BLK_OFF); const int* SLOT = (const int*)(p.ws + WS_SLOT);
    const float* MOD = (const float*)(p.ws + WS_MOD); f16* H = (f16*)(p.ws + (dry ? WS_DUMMY + 64 * MiB : WS_H)); const f16* Y2 = (const f16*)(p.ws + WS_Y2); const float* GT = (const float*)(p.ws + WS_GATES);
    float* XC = (float*)(p.ws + WS_XC);
    const int nrows = (l == DEPTH - 1) ? TL : TT; const int NGW = G * 8;
    for (int row0 = vcu * 8 + wave; row0 < nrows; row0 += 2 * NGW) {
        f32x4 v[2][4]; f16x4 ya[2][4], yb[2][4]; float ga[2], gb[2]; int rows[2]; bool ok[2];
#pragma unroll
        for (int q = 0; q < 2; ++q) { const int rr = row0 + q * NGW; ok[q] = rr < nrows; const int row = ok[q] ? rr : row0; rows[q] = row;
            const float* xr = (row < TL) ? p.out + (size_t)row * DM : XC + (size_t)(row - TL) * DM;
            const int s0 = SLOT[row * 2], s1 = SLOT[row * 2 + 1]; const f16* y0 = Y2 + ((size_t)blk[s0 >> 20] * 256 + (s0 & 0xfffff)) * DM; const f16* y1 = Y2 + ((size_t)blk[s1 >> 20] * 256 + (s1 & 0xfffff)) * DM;
            ga[q] = GT[row * 2]; gb[q] = GT[row * 2 + 1];
#pragma unroll
            for (int j = 0; j < 4; ++j) { const int c = 256 * j + 4 * lane; v[q][j] = *(const f32x4*)(xr + c); ya[q][j] = *(const f16x4*)(y0 + c); yb[q][j] = *(const f16x4*)(y1 + c); } }
        float ssum[2];
#pragma unroll
        for (int q = 0; q < 2; ++q) { const int row = rows[q]; const int b = modb_of_row(row); const float* g2 = MOD + ((size_t)l * 5 + b) * 6144 + 5 * 1024;
            float* xr = (row < TL) ? p.out + (size_t)row * DM : XC + (size_t)(row - TL) * DM; float* xw = dry ? (float*)(p.ws + WS_DUMMY) + (size_t)(row & 8191) * DM : xr; float s = 0.f;
#pragma unroll
            for (int j = 0; j < 4; ++j) { const int c = 256 * j + 4 * lane; const f32x4 g = *(const f32x4*)(g2 + c);
#pragma unroll
                for (int i = 0; i < 4; ++i) v[q][j][i] += g[i] * (ga[q] * (float)ya[q][j][i] + gb[q] * (float)yb[q][j][i]);
                if (ok[q]) *(f32x4*)(xw + c) = v[q][j];
                s += v[q][j][0] * v[q][j][0] + v[q][j][1] * v[q][j][1] + v[q][j][2] * v[q][j][2] + v[q][j][3] * v[q][j][3]; }
            ssum[q] = s; }
        if (l < DEPTH - 1) {
#pragma unroll
            for (int o = 1; o < 64; o <<= 1) { ssum[0] += __shfl_xor(ssum[0], o); ssum[1] += __shfl_xor(ssum[1], o); }
#pragma unroll
            for (int q = 0; q < 2; ++q) if (ok[q]) { const int row = rows[q]; const int b = modb_of_row(row); const float r = __builtin_amdgcn_rsqf(ssum[q] * (1.f / DM) + EPS); const float* m1 = MOD + ((size_t)(l + 1) * 5 + b) * 6144;
                modulate_row_store(v[q], r, p.norm1_g + (l + 1) * DM, m1, m1 + 1024, H + (size_t)row * DM, lane); } }
    }
}

DI f32x4 mma_f16(f16x8 a, f16x8 b, f32x4 c) { return __builtin_amdgcn_mfma_f32_16x16x32_f16(a, b, c, 0, 0, 0); }
DI f32x4 mma_bf16(s16x8 a, s16x8 b, f32x4 c) { return __builtin_amdgcn_mfma_f32_16x16x32_bf16(a, b, c, 0, 0, 0); }

constexpr int TP = 72;
struct TileInfo { int row0, t0, seqrow0, len, b, isctx, chunkpos_f, chunkpos_b; };
DI TileInfo tile_info(int tt) {
    TileInfo ti;
    if (tt < 512) { ti.b = tt >> 7; ti.t0 = (tt & 127) * 64; ti.seqrow0 = ti.b * SEQ; ti.len = SEQ; ti.isctx = 0; ti.chunkpos_f = 4 + (tt & 127); ti.chunkpos_b = 4 + 127 - (tt & 127); }
    else { const int j = tt - 512; ti.b = j >> 2; ti.t0 = (j & 3) * 64; ti.seqrow0 = TL + ti.b * CTXL; ti.len = CTXL; ti.isctx = 1; ti.chunkpos_f = (j & 3); ti.chunkpos_b = 3 - (j & 3); }
    ti.row0 = ti.seqrow0 + ti.t0; return ti;
}

typedef short v4i16_t __attribute__((ext_vector_type(4)));
DI int crow(int r, int hi) { return (r & 3) + 8 * (r >> 2) + 4 * hi; }
DI int swz(int row, int col) { return row * 64 + ((((col >> 3) ^ (row & 7)) << 3) | (col & 7)); }
DI s16x4 tr_read(const LAS unsigned short* p) { return __builtin_bit_cast(s16x4, __builtin_amdgcn_ds_read_tr16_b64_v4i16((LAS v4i16_t*)p)); }
#define LGKM0() asm volatile("s_waitcnt lgkmcnt(0)" ::: "memory")
DI void wave_load_tile64(LAS unsigned short* T, const f16* src, int pitch, int lane) {
    const int c = lane & 7;
    unsigned lo = (unsigned)((lane >> 3) * pitch + 8 * c) * 2u;
    asm volatile("" : "+v"(lo));
    const char* base = (const char*)src;
#pragma unroll
    for (int it = 0; it < 8; ++it) { const int row = 8 * it + (lane >> 3); const u32x4 v = *(const u32x4*)(base + (size_t)it * 8 * pitch * 2 + lo); *(LAS u32x4*)(T + row * 64 + ((c ^ (row & 7)) << 3)) = v; }
}
DI s16x8 tr_frag16(const LAS unsigned short* T, int k0, int n0, int lane) {
    const int g = lane >> 4, i = lane & 15, q = i >> 2, pp = i & 3; const int r0 = k0 + 8 * g + q;
    const s16x4 a = tr_read(T + swz(r0, n0 + 4 * pp)), b = tr_read(T + swz(r0 + 4, n0 + 4 * pp));
    return (s16x8){a[0], a[1], a[2], a[3], b[0], b[1], b[2], b[3]};
}

template <int CTRL, int RMASK> DI float dpp_add0(float v) { return __builtin_bit_cast(float, __builtin_amdgcn_update_dpp(0, __builtin_bit_cast(int, v), CTRL, RMASK, 0xf, true)); }
DI float bcast_lane(float v, int srclane) { return __builtin_bit_cast(float, __builtin_amdgcn_readlane(__builtin_bit_cast(int, v), srclane)); }
template <int CTRL, int RMASK> DI float dpp_mul1(float v) { return __builtin_bit_cast(float, __builtin_amdgcn_update_dpp(0x3f800000, __builtin_bit_cast(int, v), CTRL, RMASK, 0xf, false)); }
DI float wave_scan_mul(float v) {
    v *= dpp_mul1<0x111, 0xf>(v); v *= dpp_mul1<0x112, 0xf>(v); v *= dpp_mul1<0x114, 0xf>(v); v *= dpp_mul1<0x118, 0xf>(v);
    v *= dpp_mul1<0x142, 0xa>(v); v *= dpp_mul1<0x143, 0xc>(v);
    return v;
}
#define SCAN8_STEP(ctrl) \
    "v_mul_f32_dpp %0, %0, %0 " ctrl "\n\tv_mul_f32_dpp %1, %1, %1 " ctrl "\n\tv_mul_f32_dpp %2, %2, %2 " ctrl "\n\tv_mul_f32_dpp %3, %3, %3 " ctrl "\n\t" \
    "v_mul_f32_dpp %4, %4, %4 " ctrl "\n\tv_mul_f32_dpp %5, %5, %5 " ctrl "\n\tv_mul_f32_dpp %6, %6, %6 " ctrl "\n\tv_mul_f32_dpp %7, %7, %7 " ctrl "\n\t"
DI void wave_scan_mul8(float (&g)[8]) {
    asm volatile("s_nop 1\n\t"
        SCAN8_STEP("row_shr:1 row_mask:0xf bank_mask:0xf") SCAN8_STEP("row_shr:2 row_mask:0xf bank_mask:0xf") SCAN8_STEP("row_shr:4 row_mask:0xf bank_mask:0xf")
        SCAN8_STEP("row_shr:8 row_mask:0xf bank_mask:0xf") SCAN8_STEP("row_bcast:15 row_mask:0xa bank_mask:0xf") SCAN8_STEP("row_bcast:31 row_mask:0xc bank_mask:0xf")
        "s_nop 1"
        : "+v"(g[0]), "+v"(g[1]), "+v"(g[2]), "+v"(g[3]), "+v"(g[4]), "+v"(g[5]), "+v"(g[6]), "+v"(g[7]));
}
DI void hgrn_state_wave(const Params& p, int l, int item, LAS unsigned short* wl, int lane) {
    const int dir = item & 1, h = (item >> 1) & 3; const TileInfo ti = tile_info(item >> 3);
    const f16* P = (const f16*)(p.ws + WS_P); float* HS = (float*)(p.ws + WS_HS); float* HA = (float*)(p.ws + WS_HA);
    LAS unsigned short* Z = wl; LAS unsigned short* V = wl + 4096;
    const f16* prow = P + (size_t)ti.row0 * INC + h * 64;
    wave_load_tile64(Z, prow + (dir ? C_HZB : C_HZF), INC, lane); wave_load_tile64(V, prow + C_HI, INC, lane);
    const float* lbp = (const float*)(p.ws + WS_LB) + l * 512 + dir * 256 + h * 64;
    const int pos = dir ? ti.chunkpos_b : ti.chunkpos_f; const size_t slot = (size_t)((dir * NB + ti.b) * NPOS + pos) * 4 + h;
    float amine = 0.f;
    const int s_ = dir ? 63 - lane : lane;
    LGKM0();
#pragma unroll 1
    for (int c = 0; c < 8; ++c) { float g[8], kk[8]; LAS f16x8* zp = (LAS f16x8*)(Z + s_ * 64 + ((c ^ (s_ & 7)) << 3)); const f16x8 zv = *zp;
#pragma unroll
        for (int j = 0; j < 8; ++j) { const float lb = lbp[8 * c + j]; const float z = (float)zv[j]; const float sg = fast_rcp(1.f + __expf(-z)); g[j] = lb + (1.f - lb) * sg; kk[j] = (1.f - lb) * (1.f - sg); }
        wave_scan_mul8(g);
#pragma unroll
        for (int j = 0; j < 8; ++j) g[j] = fmaxf(g[j], 1e-37f);
        f16x8 ko;
#pragma unroll
        for (int j = 0; j < 8; ++j) { const float pend = bcast_lane(g[j], 63); ko[j] = (f16)(kk[j] * pend * fast_rcp(g[j])); amine = (lane == 8 * c + j) ? pend : amine; }
        *zp = ko; }
    HA[slot * 64 + lane] = amine;
    LGKM0();
    f32x4 acc[4][4];
#pragma unroll
    for (int m = 0; m < 4; ++m)
#pragma unroll
        for (int n = 0; n < 4; ++n) acc[m][n] = (f32x4){0.f, 0.f, 0.f, 0.f};
#pragma unroll
    for (int ks = 0; ks < 2; ++ks) { s16x8 a[4], b[4];
#pragma unroll
        for (int m = 0; m < 4; ++m) { a[m] = tr_frag16(V, 32 * ks, 16 * m, lane); b[m] = tr_frag16(Z, 32 * ks, 16 * m, lane); }
#pragma unroll
        for (int m = 0; m < 4; ++m)
#pragma unroll
            for (int n = 0; n < 4; ++n) acc[m][n] = mma_f16(__builtin_bit_cast(f16x8, a[m]), __builtin_bit_cast(f16x8, b[n]), acc[m][n]); }
    float* dst = HS + slot * 4096; const int fr = lane & 15, fq = lane >> 4;
#pragma unroll
    for (int m = 0; m < 4; ++m)
#pragma unroll
        for (int n = 0; n < 4; ++n)
#pragma unroll
            for (int i = 0; i < 4; ++i) dst[(16 * m + 4 * fq + i) * 64 + 16 * n + fr] = acc[m][n][i];
    LGKM0();
}

DI void qk_wave(const Params& p, int l, int pair8, int lane) {
    const f16* P = (const f16*)(p.ws + WS_P); f16* QN = (f16*)(p.ws + WS_QN); f16* KN = (f16*)(p.ws + WS_KN); const float* RT = (const float*)(p.ws + WS_ROPE);
    const int j8 = lane & 7; const int pidx = pair8 * 8 + (lane >> 3); const int row = pidx / 10, hh = pidx % 10;
    const f16x8 raw = *(const f16x8*)(P + (size_t)row * INC + C_Q + hh * 64 + 8 * j8);
    const bool lat = row < TL; const int t = lat ? (row & (SEQ - 1)) : 0; const int prow = t >> 6, pcol = t & 63; const int a0 = (8 * j8) & 31;
    const float* ct = (a0 < 16) ? RT + prow * 16 + a0 : RT + 4096 + pcol * 16 + (a0 - 16);
    const float* st = (a0 < 16) ? RT + 2048 + prow * 16 + a0 : RT + 4096 + 1024 + pcol * 16 + (a0 - 16);
    const float* gn = (hh < 8 ? p.q_norm_g : p.k_norm_g) + l * 64 + 8 * j8;
    const f32x4 c0 = *(const f32x4*)ct, c1 = *(const f32x4*)(ct + 4), s0 = *(const f32x4*)st, s1 = *(const f32x4*)(st + 4), g0 = *(const f32x4*)gn, g1 = *(const f32x4*)(gn + 4);
    float v[8]; float s = 0.f;
#pragma unroll
    for (int i = 0; i < 8; ++i) { v[i] = (float)raw[i]; s += v[i] * v[i]; }
    s += __shfl_xor(s, 1); s += __shfl_xor(s, 2); s += __shfl_xor(s, 4);
    const float r = __builtin_amdgcn_rsqf(s * (1.f / 64.f) + EPS) * ((hh < 8) ? 0.125f * LOG2E : 1.f);
    const float sgn = (j8 < 4) ? -1.f : 1.f;
    f16x8 o;
#pragma unroll
    for (int i = 0; i < 8; ++i) { const float gi = (i < 4) ? g0[i & 3] : g1[i & 3]; const float ci = lat ? ((i < 4) ? c0[i & 3] : c1[i & 3]) : 1.f, si = lat ? ((i < 4) ? s0[i & 3] : s1[i & 3]) * sgn : 0.f;
        v[i] = v[i] * r * gi; const float ot = __shfl_xor(v[i], 4); o[i] = (f16)(v[i] * ci + ot * si); }
    if (hh < 8) *(f16x8*)(QN + (size_t)row * 512 + hh * 64 + 8 * j8) = o; else *(f16x8*)(KN + (size_t)row * 128 + (hh - 8) * 64 + 8 * j8) = o;
}

DI void pool_wave(const Params& p, int l, int item, LAS unsigned short* wl, int lane) {
    const int g = item & 3; const TileInfo ti = tile_info(item >> 2); const int w = 2 << g;
    const f16* P = (const f16*)(p.ws + WS_P); f16* MIX = (f16*)(p.ws + WS_MIX); const f16* PW = (const f16*)(p.ws + WS_POOLW) + ((size_t)l * 4 + g) * 4096;
    { const int c = lane & 7;
#pragma unroll
      for (int it = 0; it < 10; ++it) { const int row = 8 * it + (lane >> 3); const int t = ti.t0 - 8 + row; u32x4 v = (u32x4){0u, 0u, 0u, 0u};
          if (t >= 0 && t < ti.len) v = *(const u32x4*)(P + (size_t)(ti.seqrow0 + t) * INC + C_U + g * 64 + 8 * c);
          *(LAS u32x4*)(wl + row * 64 + ((c ^ (row & 7)) << 3)) = v; } }
    LGKM0();
    const int r32 = lane & 31, hi = lane >> 5, i16 = lane & 15, g1 = (lane >> 4) & 1;
    f32x16 X[2][2];
#pragma unroll
    for (int a = 0; a < 2; ++a)
#pragma unroll
        for (int b = 0; b < 2; ++b)
#pragma unroll
            for (int r = 0; r < 16; ++r) X[a][b][r] = 0.f;
    int qlo[2], qhi[2], tq[2]; float inv[2];
#pragma unroll
    for (int tb = 0; tb < 2; ++tb) { const int t = ti.t0 + 32 * tb + r32; int lo = t - (w - 1) / 2, hh = t + w / 2 + 1; lo = lo < 0 ? 0 : lo; hh = hh > ti.len ? ti.len : hh; qlo[tb] = lo; qhi[tb] = hh; tq[tb] = t; inv[tb] = fast_rcp((float)(hh - lo)); }
#pragma unroll
    for (int ks = 0; ks < 5; ++ks) {
        f16x8 wb[2];
#pragma unroll
        for (int tb = 0; tb < 2; ++tb)
#pragma unroll
            for (int j = 0; j < 8; ++j) { const int q = ti.t0 - 8 + 16 * ks + 8 * hi + j; const float wv = ((q >= qlo[tb] && q < qhi[tb]) ? inv[tb] : 0.f) - (q == tq[tb] ? 1.f : 0.f); wb[tb][j] = (f16)wv; }
#pragma unroll
        for (int cb = 0; cb < 2; ++cb) {
            const int r0 = 16 * ks + 8 * hi + (i16 >> 2), c0 = 32 * cb + 16 * g1 + 4 * (i16 & 3);
            const s16x4 a = tr_read(wl + swz(r0, c0)), b = tr_read(wl + swz(r0 + 4, c0));
            const f16x8 uf = __builtin_bit_cast(f16x8, (s16x8){a[0], a[1], a[2], a[3], b[0], b[1], b[2], b[3]});
#pragma unroll
            for (int tb = 0; tb < 2; ++tb) X[cb][tb] = __builtin_amdgcn_mfma_f32_32x32x16_f16(uf, wb[tb], X[cb][tb], 0, 0, 0); } }
    f32x16 Y[2][2];
#pragma unroll
    for (int a = 0; a < 2; ++a)
#pragma unroll
        for (int b = 0; b < 2; ++b)
#pragma unroll
            for (int r = 0; r < 16; ++r) Y[a][b][r] = 0.f;
#pragma unroll
    for (int cb = 0; cb < 2; ++cb)
#pragma unroll
        for (int ss = 0; ss < 2; ++ss) { f16x8 xb[2];
#pragma unroll
            for (int tb = 0; tb < 2; ++tb)
#pragma unroll
                for (int j = 0; j < 8; ++j) xb[tb][j] = (f16)X[cb][tb][8 * ss + j];
#pragma unroll
            for (int db = 0; db < 2; ++db) { const f16* wp = PW + (32 * db + r32) * 64 + 32 * cb + 16 * ss + 4 * hi; const f16x4 w0 = *(const f16x4*)wp, w1 = *(const f16x4*)(wp + 8);
                const f16x8 wf = (f16x8){w0[0], w0[1], w0[2], w0[3], w1[0], w1[1], w1[2], w1[3]};
#pragma unroll
                for (int tb = 0; tb < 2; ++tb) Y[db][tb] = __builtin_amdgcn_mfma_f32_32x32x16_f16(wf, xb[tb], Y[db][tb], 0, 0, 0); } }
    const float* psc = p.pool_scale + l * 256 + g * 64;
#pragma unroll
    for (int db = 0; db < 2; ++db)
#pragma unroll
        for (int g4 = 0; g4 < 4; ++g4) { const int d0 = 32 * db + 8 * g4 + 4 * hi; const f32x4 ps = *(const f32x4*)(psc + d0);
#pragma unroll
            for (int tb = 0; tb < 2; ++tb) { f16x4 ov;
#pragma unroll
                for (int i = 0; i < 4; ++i) ov[i] = (f16)(Y[db][tb][4 * g4 + i] * ps[i]);
                *(f16x4*)(MIX + (size_t)(ti.row0 + 32 * tb + r32) * DM + g * 64 + d0) = ov; } }
    LGKM0();
}

DI void qs_wave(const Params& p, int item, int lane) {
    const int h = item & 3; const TileInfo ti = tile_info(item >> 2);
    const f16* prow = (const f16*)(p.ws + WS_P) + (size_t)ti.row0 * INC + C_HQ + h * 64; f16* QS = (f16*)(p.ws + WS_QS) + (size_t)ti.row0 * 256 + h * 64; const int c = lane & 7;
    f16x8 qv[8];
#pragma unroll
    for (int it = 0; it < 8; ++it) qv[it] = *(const f16x8*)(prow + (size_t)(8 * it + (lane >> 3)) * INC + 8 * c);
#pragma unroll
    for (int it = 0; it < 8; ++it) { f16x8 o;
#pragma unroll
        for (int j = 0; j < 8; ++j) o[j] = (f16)siluf((float)qv[it][j]);
        *(f16x8*)(QS + (size_t)(8 * it + (lane >> 3)) * 256 + 8 * c) = o; }
}

DI void phase_prep_w(const Params& p, int l, ldsp lds, int lane, int wave, int vcu, int G) {
    LAS unsigned short* wl = (LAS unsigned short*)(lds + wave * 16384);
    LAS unsigned* ctr = (LAS unsigned*)(lds + MISC_OFF) + 20;
    __syncthreads();
    if (threadIdx.x < 4) ctr[threadIdx.x] = 0u;
    __syncthreads();
    const int nH = (528 * 8 - vcu + G - 1) / G, nP = (528 * 4 - vcu + G - 1) / G;
    const int nQ8 = TT * 10 / 8; const int nQ = (nQ8 - vcu + G - 1) / G; const int nQc = (nQ + 4) / 5;
#define PULL(k) ({ unsigned t_ = 0; if (lane == 0) t_ = __hip_atomic_fetch_add(ctr + (k), 1u, __ATOMIC_RELAXED, __HIP_MEMORY_SCOPE_WORKGROUP); __builtin_amdgcn_readfirstlane((int)t_); })
    for (int idx = PULL(0); idx < nH; idx = PULL(0)) hgrn_state_wave(p, l, vcu + idx * G, wl, lane);
    for (int idx = PULL(1); idx < nP; idx = PULL(1)) pool_wave(p, l, vcu + idx * G, wl, lane);
    for (int idx = PULL(3); idx < nP; idx = PULL(3)) qs_wave(p, vcu + idx * G, lane);
    for (int idx = PULL(2); idx < nQc; idx = PULL(2)) { const int c0 = idx * 5;
#pragma unroll
        for (int k = c0; k < c0 + 5; ++k) qk_wave(p, l, vcu + (k < nQ ? k : nQ - 1) * G, lane); }
#undef PULL
}

DI void hgrn_out_wave(const Params& p, int l, int item, LAS unsigned short* wl, LAS float* wx, int lane) {
    const int h = item & 3; const TileInfo ti = tile_info(item >> 2);
    const f16* P = (const f16*)(p.ws + WS_P); const unsigned short* HS = (const unsigned short*)(p.ws + WS_HSB); f16* MIX = (f16*)(p.ws + WS_MIX);
    LAS unsigned short* BA = wl; LAS unsigned short* BB = wl + 4096;
    const f16* prow = P + (size_t)ti.row0 * INC + h * 64;
    const int r32 = lane & 31, hi = lane >> 5;
    f32x16 o[2][2];
#pragma unroll
    for (int a = 0; a < 2; ++a)
#pragma unroll
        for (int b = 0; b < 2; ++b)
#pragma unroll
            for (int r = 0; r < 16; ++r) o[a][b][r] = 0.f;
#pragma unroll 1
    for (int dir = 0; dir < 2; ++dir) {
        wave_load_tile64(BA, prow + (dir ? C_HZB : C_HZF), INC, lane); wave_load_tile64(BB, (const f16*)(p.ws + WS_QS) + (size_t)ti.row0 * 256 + h * 64, 256, lane);
        u32x4 vreg[8], sreg[8];
        { const int pos = dir ? ti.chunkpos_b : ti.chunkpos_f; const char* hs = (const char*)(HS + ((size_t)((dir * NB + ti.b) * NPOS + pos) * 4 + h) * 4096); const char* vb = (const char*)(prow + C_HI);
          unsigned lov = (unsigned)((lane >> 3) * INC + 8 * (lane & 7)) * 2u, los = (unsigned)((lane >> 3) * 64 + 8 * (lane & 7)) * 2u; asm volatile("" : "+v"(lov), "+v"(los));
#pragma unroll
          for (int it = 0; it < 8; ++it) { vreg[it] = *(const u32x4*)(vb + (size_t)it * 8 * INC * 2 + lov); sreg[it] = *(const u32x4*)(hs + (size_t)it * 8 * 64 * 2 + los); } }
        const float* lbp = (const float*)(p.ws + WS_LB) + l * 512 + dir * 256 + h * 64;
        float er_mine = 0.f;
        LGKM0();
        const int s_ = dir ? 63 - lane : lane;
#pragma unroll 1
        for (int c = 0; c < 8; ++c) { float g[8], kk[8]; LAS f16x8* zp = (LAS f16x8*)(BA + s_ * 64 + ((c ^ (s_ & 7)) << 3)); LAS f16x8* qp = (LAS f16x8*)(BB + s_ * 64 + ((c ^ (s_ & 7)) << 3));
            const f16x8 zv = *zp, qv = *qp;
#pragma unroll
            for (int j = 0; j < 8; ++j) { const float lb = lbp[8 * c + j]; const float z = (float)zv[j]; const float sg = fast_rcp(1.f + __expf(-z)); g[j] = lb + (1.f - lb) * sg; kk[j] = (1.f - lb) * (1.f - sg); }
            wave_scan_mul8(g);
#pragma unroll
            for (int j = 0; j < 8; ++j) g[j] = fmaxf(g[j], 1e-37f);
            float kf_[8], qf_[8];
#pragma unroll
            for (int j = 0; j < 8; ++j) { const float r = fast_rcp(g[j]); const float pref = bcast_lane(g[j], 31), rpref = bcast_lane(r, 31);
                kf_[j] = kk[j] * pref * r; qf_[j] = (float)qv[j] * g[j] * rpref; er_mine = (lane == 8 * c + j) ? pref : er_mine; }
            u32x4 ko, qo;
#pragma unroll
            for (int j = 0; j < 4; ++j) { ko[j] = cvt_pk_bf16(kf_[2 * j], kf_[2 * j + 1]); qo[j] = cvt_pk_bf16(qf_[2 * j], qf_[2 * j + 1]); }
            *(LAS u32x4*)zp = ko; *(LAS u32x4*)qp = qo; }
        wx[lane] = er_mine;
        LGKM0();
        s16x8 qf[2][4];
#pragma unroll
        for (int b = 0; b < 2; ++b)
#pragma unroll
            for (int d0 = 0; d0 < 4; ++d0) { const int row = 32 * b + r32, ch = 2 * d0 + hi; qf[b][d0] = *(const LAS s16x8*)(BB + row * 64 + ((ch ^ (row & 7)) << 3)); }
        LGKM0();
        { const int c = lane & 7;
#pragma unroll
          for (int it = 0; it < 8; ++it) { const int row = 8 * it + (lane >> 3); *(LAS u32x4*)(BB + row * 64 + ((c ^ (row & 7)) << 3)) = vreg[it]; } }
        LGKM0();
#pragma unroll
        for (int tb = 0; tb < 2; ++tb)
#pragma unroll
            for (int sb = 0; sb < 2; ++sb) {
                const bool diag = (sb == tb); const bool full = dir ? (sb > tb) : (sb < tb);
                if (!diag && !full) continue;
                f32x16 pt;
#pragma unroll
                for (int r = 0; r < 16; ++r) pt[r] = 0.f;
#pragma unroll
                for (int d0 = 0; d0 < 4; ++d0) { const int row = 32 * sb + r32, ch = 2 * d0 + hi; const s16x8 kf = *(const LAS s16x8*)(BA + row * 64 + ((ch ^ (row & 7)) << 3));
                    pt = __builtin_amdgcn_mfma_f32_32x32x16_bf16(kf, qf[tb][d0], pt, 0, 0, 0); }
                if (diag) {
#pragma unroll
                    for (int r = 0; r < 16; ++r) { const int sl = crow(r, hi); const bool keep = dir ? (sl >= r32) : (sl <= r32); pt[r] = keep ? pt[r] : 0.f; } }
                f16x8 pw[2];
#pragma unroll
                for (int j = 0; j < 8; ++j) { pw[0][j] = (f16)pt[j]; pw[1][j] = (f16)pt[8 + j]; }
#pragma unroll
                for (int dvb = 0; dvb < 2; ++dvb)
#pragma unroll
                    for (int ss = 0; ss < 2; ++ss) { const int i16 = lane & 15, g1 = (lane >> 4) & 1; const int r0 = 32 * sb + 16 * ss + 4 * hi + (i16 >> 2), c0 = 32 * dvb + 16 * g1 + 4 * (i16 & 3);
                        const s16x4 a = tr_read(BB + swz(r0, c0)), b = tr_read(BB + swz(r0 + 8, c0));
                        const s16x8 vf = (s16x8){a[0], a[1], a[2], a[3], b[0], b[1], b[2], b[3]};
                        o[dvb][tb] = __builtin_amdgcn_mfma_f32_32x32x16_f16(__builtin_bit_cast(f16x8, vf), pw[ss], o[dvb][tb], 0, 0, 0); }
            }
        LGKM0();
        { const int c8 = lane & 7; const f32x4 er0 = *(const LAS f32x4*)(wx + 8 * c8), er1 = *(const LAS f32x4*)(wx + 8 * c8 + 4);
#pragma unroll
          for (int it = 0; it < 8; ++it) { const int row = 8 * it + (lane >> 3); const u32x4 sv = sreg[it];
              u32x4 w4;
#pragma unroll
              for (int q = 0; q < 4; ++q) { const float lo = __builtin_bit_cast(float, sv[q] << 16), hi2 = __builtin_bit_cast(float, sv[q] & 0xffff0000u);
                  const float e0 = (q < 2) ? er0[2 * q] : er1[2 * q - 4], e1 = (q < 2) ? er0[2 * q + 1] : er1[2 * q - 3]; w4[q] = cvt_pk_bf16(lo * e0, hi2 * e1); }
              *(LAS u32x4*)(BA + row * 64 + ((c8 ^ (row & 7)) << 3)) = w4; } }
        LGKM0();
#pragma unroll
        for (int dvb = 0; dvb < 2; ++dvb)
#pragma unroll
            for (int d0 = 0; d0 < 4; ++d0) { const int row = 32 * dvb + r32, ch = 2 * d0 + hi; const s16x8 sf = *(const LAS s16x8*)(BA + row * 64 + ((ch ^ (row & 7)) << 3));
#pragma unroll
                for (int tb = 0; tb < 2; ++tb) o[dvb][tb] = __builtin_amdgcn_mfma_f32_32x32x16_bf16(sf, qf[tb][d0], o[dvb][tb], 0, 0, 0); }
        LGKM0();
    }
    const float* gn = p.hgrn_norm_g + l * 64;
#pragma unroll
    for (int tb = 0; tb < 2; ++tb) { float ss = 0.f;
#pragma unroll
        for (int dvb = 0; dvb < 2; ++dvb)
#pragma unroll
            for (int r = 0; r < 16; ++r) ss += o[dvb][tb][r] * o[dvb][tb][r];
        ss += __shfl_xor(ss, 32); const float rn = __builtin_amdgcn_rsqf(ss * (1.f / 64.f) + EPS);
        const size_t row = (size_t)ti.row0 + 32 * tb + r32;
#pragma unroll
        for (int dvb = 0; dvb < 2; ++dvb)
#pragma unroll
            for (int g4 = 0; g4 < 4; ++g4) { const int dv0 = 32 * dvb + 8 * g4 + 4 * hi; const f16x4 gt = *(const f16x4*)(P + row * INC + C_HG + h * 64 + dv0); const f32x4 gg = *(const f32x4*)(gn + dv0);
                f16x4 ov;
#pragma unroll
                for (int i = 0; i < 4; ++i) ov[i] = (f16)(o[dvb][tb][4 * g4 + i] * rn * gg[i] * siluf((float)gt[i]));
                *(f16x4*)(MIX + row * DM + 768 + h * 64 + dv0) = ov; } }
}
DI void phase_hgrn_out_w(const Params& p, int l, ldsp lds, int lane, int wave, int vcu, int G) {
    LAS unsigned short* wl = (LAS unsigned short*)(lds + wave * 16384); LAS float* wx = (LAS float*)(lds + BLK_OFF + 1024 + wave * 512);
    const int gw = vcu * 8 + wave, NGW = G * 8;
    const int nit = (l == DEPTH - 1) ? 512 * 4 : 528 * 4;
    for (int it = gw; it < nit; it += NGW) hgrn_out_wave(p, l, it, wl, wx, lane);
}

DI void phase_scan(const Params& p, int tid, int vcu, int G, int dry) {
    const float* HS = (const float*)(p.ws + WS_HS); const float* HA = (const float*)(p.ws + WS_HA); unsigned short* HSB = (unsigned short*)(p.ws + (dry ? WS_DUMMY : WS_HSB));
    for (int gid = vcu * 512 + tid; gid < 2 * NB * 4 * 4096; gid += G * 512) {
        const int el = gid & 4095, h = (gid >> 12) & 3, db = gid >> 14;
        const size_t hoff = ((size_t)db * NPOS * 4 + h) * 4096 + el; const float* hs = HS + hoff; unsigned short* hso = HSB + hoff; const float* ha = HA + ((size_t)db * NPOS * 4 + h) * 64 + (el & 63);
        float S = 0.f;
        for (int pos = 0; pos < NPOS; pos += 12) { float u[12], a[12];
#pragma unroll
            for (int j = 0; j < 12; ++j) { u[j] = hs[(size_t)(pos + j) * 4 * 4096]; a[j] = ha[(size_t)(pos + j) * 4 * 64]; }
#pragma unroll
            for (int j = 0; j < 12; ++j) { hso[(size_t)(pos + j) * 4 * 4096] = f2bf(S); S = a[j] * S + u[j]; } }
    }
}

DI void attn_item(const Params& p, int l, int idx, ldsp lds, int tid, int lane, int wave) {
    const f16* P = (const f16*)(p.ws + WS_P); const f16* QN = (const f16*)(p.ws + WS_QN); const f16* KN = (const f16*)(p.ws + WS_KN); f16* MIX = (f16*)(p.ws + WS_MIX);
    int b, kvh, qb, isctx;
    if (idx < 1024) { b = idx >> 8; kvh = (idx >> 7) & 1; qb = idx & 127; isctx = 0; } else { const int j = idx - 1024; b = j >> 3; kvh = (j >> 2) & 1; qb = j & 3; isctx = 1; }
    const int q0 = qb * 64; const int qrowbase = isctx ? TL + b * CTXL : b * SEQ;
    const int r32 = lane & 31, hi = lane >> 5; const int hq = kvh * 4 + (wave >> 1); const int qpos = q0 + (wave & 1) * 32 + r32; const size_t qrow = (size_t)qrowbase + qpos;
    LAS f16* KB = (LAS f16*)lds;
    LAS f16* VTB = KB + 2 * 64 * TP;
    f16x8 qr[4];
#pragma unroll
    for (int d0 = 0; d0 < 4; ++d0) qr[d0] = *(const f16x8*)(QN + qrow * 512 + hq * 64 + 16 * d0 + 8 * hi);
    float m = p.attn_sink[l * 8 + hq] * LOG2E, lsum = hi ? 0.f : 1.f;
    f32x16 o[2];
#pragma unroll
    for (int r = 0; r < 16; ++r) { o[0][r] = 0.f; o[1][r] = 0.f; }
    const int srow = tid >> 3, sc8 = tid & 7;
    const int ntile = isctx ? 4 : 9;
    int cur = 0; bool have = false; f16x8 kreg, vreg;
    int tix = 0;
#define TILE_VALID(t) (isctx || (t) >= 5 || ((q0 - 128 + 64 * (t)) >= 0 && (q0 - 128 + 64 * (t)) < SEQ))
#define TILE_ROW(t) ((isctx || (t) >= 5) ? (TL + b * CTXL + 64 * (isctx ? (t) : (t) - 5)) : (b * SEQ + q0 - 128 + 64 * (t)))
    while (tix < ntile && !TILE_VALID(tix)) ++tix;
    { const size_t kr = (size_t)TILE_ROW(tix) + srow; kreg = *(const f16x8*)(KN + kr * 128 + kvh * 64 + 8 * sc8); vreg = *(const f16x8*)(P + kr * INC + C_V + kvh * 64 + 8 * sc8); }
    __syncthreads();
    { *(LAS f16x8*)(KB + srow * TP + 8 * sc8) = kreg;
#pragma unroll
      for (int i = 0; i < 8; ++i) VTB[(8 * sc8 + i) * TP + srow] = vreg[i]; }
    __syncthreads();
    while (tix < ntile) {
        int nx = tix + 1; while (nx < ntile && !TILE_VALID(nx)) ++nx;
        have = nx < ntile;
        if (have) { const size_t kr = (size_t)TILE_ROW(nx) + srow; kreg = *(const f16x8*)(KN + kr * 128 + kvh * 64 + 8 * sc8); vreg = *(const f16x8*)(P + kr * INC + C_V + kvh * 64 + 8 * sc8); }
        const LAS f16* Kc = KB + cur * 64 * TP; const LAS f16* Vc = VTB + cur * 64 * TP;
        f32x16 p0, p1;
#pragma unroll
        for (int r = 0; r < 16; ++r) { p0[r] = -m; p1[r] = -m; }
#pragma unroll
        for (int d0 = 0; d0 < 4; ++d0) { const f16x8 k0 = *(const LAS f16x8*)(Kc + r32 * TP + 16 * d0 + 8 * hi); const f16x8 k1 = *(const LAS f16x8*)(Kc + (32 + r32) * TP + 16 * d0 + 8 * hi);
            p0 = __builtin_amdgcn_mfma_f32_32x32x16_f16(k0, qr[d0], p0, 0, 0, 0); p1 = __builtin_amdgcn_mfma_f32_32x32x16_f16(k1, qr[d0], p1, 0, 0, 0); }
        if (!isctx && (tix == 0 || tix == 4)) { const int kstart = q0 - 128 + 64 * tix;
#pragma unroll
            for (int r = 0; r < 16; ++r) { const int d0_ = qpos - (kstart + crow(r, hi)); if (d0_ > 128 || d0_ < -128) p0[r] = -INFINITY; const int d1_ = d0_ - 32; if (d1_ > 128 || d1_ < -128) p1[r] = -INFINITY; } }
        float mx = fmaxf(p0[0], p1[0]);
#pragma unroll
        for (int r = 1; r < 16; ++r) mx = fmaxf(mx, fmaxf(p0[r], p1[r]));
        mx = fmaxf(mx, __shfl_xor(mx, 32));
        if (__any(mx > 4.f)) {
            const float dl = fmaxf(mx, 0.f); const float f = __builtin_amdgcn_exp2f(-dl); m += dl; lsum *= f;
#pragma unroll
            for (int r = 0; r < 16; ++r) { o[0][r] *= f; o[1][r] *= f; p0[r] -= dl; p1[r] -= dl; } }
        float ps = 0.f;
#pragma unroll
        for (int r = 0; r < 16; ++r) { p0[r] = __builtin_amdgcn_exp2f(p0[r]); p1[r] = __builtin_amdgcn_exp2f(p1[r]); ps += p0[r] + p1[r]; }
        lsum += ps;
        f16x8 pw[4];
#pragma unroll
        for (int j = 0; j < 8; ++j) { pw[0][j] = (f16)p0[j]; pw[1][j] = (f16)p0[8 + j]; pw[2][j] = (f16)p1[j]; pw[3][j] = (f16)p1[8 + j]; }
#pragma unroll
        for (int d1 = 0; d1 < 2; ++d1)
#pragma unroll
            for (int s = 0; s < 4; ++s) { const LAS f16* vp = Vc + (32 * d1 + r32) * TP + 16 * s + 4 * hi; const f16x4 lo = *(const LAS f16x4*)vp, hv = *(const LAS f16x4*)(vp + 8);
                const f16x8 vf = (f16x8){lo[0], lo[1], lo[2], lo[3], hv[0], hv[1], hv[2], hv[3]};
                o[d1] = __builtin_amdgcn_mfma_f32_32x32x16_f16(vf, pw[s], o[d1], 0, 0, 0); }
        if (have) { LAS f16* Kn = KB + (cur ^ 1) * 64 * TP; LAS f16* Vn = VTB + (cur ^ 1) * 64 * TP;
            *(LAS f16x8*)(Kn + srow * TP + 8 * sc8) = kreg;
#pragma unroll
            for (int i = 0; i < 8; ++i) Vn[(8 * sc8 + i) * TP + srow] = vreg[i]; }
        __syncthreads();
        cur ^= 1; tix = nx;
    }
#undef TILE_VALID
#undef TILE_ROW
    const float lt = lsum + __shfl_xor(lsum, 32); const float il = 1.f / lt;
    f16* orow = MIX + qrow * DM + 256 + hq * 64;
#pragma unroll
    for (int d1 = 0; d1 < 2; ++d1)
#pragma unroll
        for (int g = 0; g < 4; ++g) { f16x4 v;
#pragma unroll
            for (int i = 0; i < 4; ++i) v[i] = (f16)(o[d1][4 * g + i] * il);
            *(f16x4*)(orow + 32 * d1 + 8 * g + 4 * hi) = v; }
}
DI void phase_attn(const Params& p, int l, ldsp lds, int tid, int lane, int wave, int vcu, int G, int rep) {
    unsigned* qc = (unsigned*)(p.ws + WS_CTL) + CW_QUEUE + (l * 2 + rep) * 64; volatile LAS unsigned* slot = (volatile LAS unsigned*)(lds + MISC_OFF) + 16;
    const int nitems = (l == DEPTH - 1) ? 1024 : 1056;
    __syncthreads();
    if (tid == 0) slot[0] = atomicAdd(qc, 1u);
    __syncthreads();
    unsigned it = slot[0];
    while (it < (unsigned)nitems) {
        __syncthreads();
        if (tid == 0) slot[0] = atomicAdd(qc, 1u);
        attn_item(p, l, (int)it, lds, tid, lane, wave);
        __syncthreads();
        it = slot[0];
    }
    __syncthreads();
}

DI void phase_outproj_ctx(const Params& p, int l, int lane, int wave, int vcu, int G, int dry) {
    const f16* MIX = (const f16*)(p.ws + WS_MIX) + (size_t)TL * DM; const f16* W = (const f16*)(p.ws + WS_WOUT) + (size_t)l * DM * DM;
    f16* xd = (f16*)(p.ws + (dry ? WS_DUMMY + 136 * MiB : WS_DELTA)) + (dry ? 0 : (size_t)TL * DM);
    const float* g1 = (const float*)(p.ws + WS_MOD) + ((size_t)l * 5 + 4) * 6144 + 2 * 1024;
    const int fr = lane & 15, fq = lane >> 4;
    for (int it = vcu; it < 256; it += G) { const int r0 = (it >> 4) * 64 + 16 * (wave & 3), c0 = (it & 15) * 64 + 32 * (wave >> 2);
        f32x4 acc[2] = {(f32x4){0.f, 0.f, 0.f, 0.f}, (f32x4){0.f, 0.f, 0.f, 0.f}};
        const f16* ap = MIX + (size_t)(r0 + fr) * DM + 8 * fq; const f16* bp = W + (size_t)(c0 + fr) * DM + 8 * fq;
#pragma unroll 8
        for (int ks = 0; ks < 32; ++ks) { const f16x8 a = *(const f16x8*)(ap + 32 * ks); const f16x8 b0 = *(const f16x8*)(bp + 32 * ks), b1 = *(const f16x8*)(bp + 16 * DM + 32 * ks);
            acc[0] = mma_f16(a, b0, acc[0]); acc[1] = mma_f16(a, b1, acc[1]); }
#pragma unroll
        for (int n = 0; n < 2; ++n) { const int col = c0 + 16 * n + fr; const float gv = g1[col];
#pragma unroll
            for (int i = 0; i < 4; ++i) xd[(size_t)(r0 + 4 * fq + i) * DM + col] = (f16)(gv * acc[n][i]); } }
}

DI void phase_router(const Params& p, int l, ldsp lds, int tid, int lane, int wave, int vcu, int G, int dry) {
    const float* MOD = (const float*)(p.ws + WS_MOD); f16* H = (f16*)(p.ws + (dry ? WS_DUMMY : WS_H)); const float* XC = (const float*)(p.ws + WS_XC); const f16* WRH = (const f16*)(p.ws + WS_WR) + (size_t)l * 48 * 1024; const f16* WRL = WRH + (size_t)DEPTH * 48 * 1024;
    int* SLOT = (int*)(p.ws + (dry ? WS_DUMMY + 88 * MiB : WS_SLOT)); float* GT = (float*)(p.ws + (dry ? WS_DUMMY + 80 * MiB : WS_GATES)); int* LIST = (int*)(p.ws + (dry ? WS_DUMMY + 96 * MiB : WS_LIST)); unsigned* CNT = (unsigned*)(p.ws + WS_CTL) + CW_CNT + l * 32 * 16 + (dry ? 4096 : 0);
    constexpr int XP = 1028;
    LAS float* XT = (LAS float*)lds;
    LAS float* PART = XT + 16 * XP;
    LAS float* LG = PART + 8 * 16 * 48;
    const int fr = lane & 15, fq = lane >> 4;
    f16x8 wh[4][3], wl_[4][3];
#pragma unroll
    for (int ks = 0; ks < 4; ++ks)
#pragma unroll
        for (int n = 0; n < 3; ++n) { const size_t o = (size_t)(16 * n + fr) * 1024 + wave * 128 + 32 * ks + 8 * fq; wh[ks][n] = *(const f16x8*)(WRH + o); wl_[ks][n] = *(const f16x8*)(WRL + o); }
    const int ntiles = (l == DEPTH - 1 ? TL : TT) / 16;
    LAS int* SEL = (LAS int*)(LG + 16 * 48);
    LAS int* BASE = SEL + 64;
    f32x4 v[2][4];
    const float* xsl = (l == 0) ? p.x : p.out; const float* xsc = (l == 0) ? p.ctx : XC; const f16* DL = (const f16*)(p.ws + WS_DELTA);
    float* xwl = dry ? (float*)(p.ws + WS_DUMMY + 8 * MiB) : p.out; float* xwc = dry ? (float*)(p.ws + WS_DUMMY + 8 * MiB) : (float*)(p.ws + WS_XC);
    f16x4 dv[2][4];
#define RT_LOAD(tile_) do { _Pragma("unroll") for (int q = 0; q < 2; ++q) { const int row = (tile_) * 16 + wave + 8 * q; const float* xr_ = (row < TL) ? xsl + (size_t)row * DM : xsc + (size_t)(row - TL) * DM; \
        _Pragma("unroll") for (int j = 0; j < 4; ++j) { v[q][j] = *(const f32x4*)(xr_ + 256 * j + 4 * lane); dv[q][j] = *(const f16x4*)(DL + (size_t)row * DM + 256 * j + 4 * lane); } } } while (0)
#define RT_FLUSH(buf_, row0_) do { if (tid < 32) { const int e = SEL[(buf_) * 32 + tid]; int rank = 0; \
        _Pragma("unroll") for (int j = 0; j < 32; ++j) rank += (j < tid && SEL[(buf_) * 32 + j] == e) ? 1 : 0; \
        const int pos_ = BASE[(buf_) * 32 + e] + rank; const int ent_ = ((row0_) + (tid >> 1)) * 2 + (tid & 1); LIST[(size_t)e * TT + pos_] = ent_; SLOT[ent_] = (e << 20) | pos_; } } while (0)
    int tile = vcu; int cur = 0; int prev_row0 = -1; unsigned pend = 0u; bool pend_valid = false;
    if (tile < ntiles) RT_LOAD(tile);
    for (; tile < ntiles; tile += G, cur ^= 1) {
        const int row0 = tile * 16;
        { float ssum[2];
#pragma unroll
          for (int q = 0; q < 2; ++q) { float s = 0.f; const int row = row0 + wave + 8 * q; float* xw_ = (row < TL) ? xwl + (size_t)(dry ? (row & 1023) : row) * DM : xwc + (size_t)(row - TL) * DM;
#pragma unroll
              for (int j = 0; j < 4; ++j) {
#pragma unroll
                  for (int i = 0; i < 4; ++i) v[q][j][i] += (float)dv[q][j][i];
                  *(f32x4*)(xw_ + 256 * j + 4 * lane) = v[q][j];
                  s += v[q][j][0] * v[q][j][0] + v[q][j][1] * v[q][j][1] + v[q][j][2] * v[q][j][2] + v[q][j][3] * v[q][j][3]; }
              ssum[q] = s; }
#pragma unroll
          for (int o = 1; o < 64; o <<= 1) { ssum[0] += __shfl_xor(ssum[0], o); ssum[1] += __shfl_xor(ssum[1], o); }
          const int b = modb_of_row(row0); const float* m2 = MOD + ((size_t)l * 5 + b) * 6144; const float* gn = p.norm2_g + l * DM;
#pragma unroll
          for (int j = 0; j < 4; ++j) { const int c = 256 * j + 4 * lane; const f32x4 g = *(const f32x4*)(gn + c), sh = *(const f32x4*)(m2 + 3 * 1024 + c), sc = *(const f32x4*)(m2 + 4 * 1024 + c);
#pragma unroll
              for (int q = 0; q < 2; ++q) { const int rr = wave + 8 * q; const float r = __builtin_amdgcn_rsqf(ssum[q] * (1.f / DM) + EPS); f32x4 hv; f16x4 o;
#pragma unroll
                  for (int i = 0; i < 4; ++i) { hv[i] = v[q][j][i] * r * g[i] * (1.f + sc[i]) + sh[i]; o[i] = (f16)hv[i]; }
                  *(f16x4*)(H + (size_t)(row0 + rr) * DM + c) = o; *(LAS f32x4*)(XT + rr * XP + c) = hv; } } }
        if (pend_valid) BASE[(cur ^ 1) * 32 + tid] = (int)pend;
        __syncthreads();
        if (tile + G < ntiles) RT_LOAD(tile + G);
        if (prev_row0 >= 0) RT_FLUSH(cur ^ 1, prev_row0);
        { f32x4 acc[3];
#pragma unroll
          for (int n = 0; n < 3; ++n) acc[n] = (f32x4){0.f, 0.f, 0.f, 0.f};
#pragma unroll
          for (int ks = 0; ks < 4; ++ks) { const LAS float* xp = XT + fr * XP + wave * 128 + 32 * ks + 8 * fq; const f32x4 x0 = *(const LAS f32x4*)xp, x1 = *(const LAS f32x4*)(xp + 4);
              f16x8 ah, al;
#pragma unroll
              for (int j = 0; j < 4; ++j) { ah[j] = (f16)x0[j]; al[j] = (f16)(x0[j] - (float)ah[j]); ah[4 + j] = (f16)x1[j]; al[4 + j] = (f16)(x1[j] - (float)ah[4 + j]); }
#pragma unroll
              for (int n = 0; n < 3; ++n) { acc[n] = mma_f16(ah, wh[ks][n], acc[n]); acc[n] = mma_f16(ah, wl_[ks][n], acc[n]); acc[n] = mma_f16(al, wh[ks][n], acc[n]); } }
#pragma unroll
          for (int n = 0; n < 3; ++n)
#pragma unroll
              for (int i = 0; i < 4; ++i) PART[(wave * 16 + 4 * fq + i) * 48 + 16 * n + fr] = acc[n][i] * (1.f / 1024.f); }
        __syncthreads();
        for (int i = tid; i < 16 * 36; i += 512) { const int tk = i / 36, o = i % 36; float s = 0.f;
#pragma unroll
            for (int w = 0; w < 8; ++w) s += PART[(w * 16 + tk) * 48 + o];
            LG[tk * 48 + o] = s + (o < 4 ? p.rgb[l * 4 + o] : p.reb[l * 32 + (o - 4)]); }
        __syncthreads();
        if (tid < 16) { const int row = row0 + tid; const LAS float* lg = LG + tid * 48;
            int g = 0; float gm = lg[0];
#pragma unroll
            for (int j = 1; j < 4; ++j) if (lg[j] > gm) { gm = lg[j]; g = j; }
            float den = 0.f;
#pragma unroll
            for (int j = 0; j < 4; ++j) den += expf(lg[j] - gm);
            const float pg = 1.f / den;
            const LAS float* le = lg + 4 + 8 * g; int e0 = 0; float m0 = le[0];
#pragma unroll
            for (int j = 1; j < 8; ++j) if (le[j] > m0) { m0 = le[j]; e0 = j; }
            int e1 = -1; float m1 = -INFINITY;
#pragma unroll
            for (int j = 0; j < 8; ++j) if (j != e0 && le[j] > m1) { m1 = le[j]; e1 = j; }
            const float w0 = 1.f / (1.f + expf(m1 - m0)), w1 = 1.f - w0;
            *(f32x2*)(GT + row * 2) = (f32x2){pg * w0, pg * w1};
            SEL[cur * 32 + tid * 2] = 8 * g + e0; SEL[cur * 32 + tid * 2 + 1] = 8 * g + e1; }
        __syncthreads();
        pend_valid = false;
        if (tid < 32) { int c = 0;
#pragma unroll
            for (int j = 0; j < 32; ++j) c += (SEL[cur * 32 + j] == tid) ? 1 : 0;
            if (c > 0) { pend = atomicAdd(CNT + tid * 16, (unsigned)c); pend_valid = true; } }
        prev_row0 = row0;
    }
    if (pend_valid) BASE[(cur ^ 1) * 32 + tid] = (int)pend;
    __syncthreads();
    if (prev_row0 >= 0) RT_FLUSH(cur ^ 1, prev_row0);
    __syncthreads();
#undef RT_LOAD
#undef RT_FLUSH
}

DI int moe_setup(const Params& p, int l, ldsp lds, int tid, int G, int bx) {
    LAS int* blk = (LAS int*)(lds + BLK_OFF); LAS int* cnt = blk + 40; LAS int* utab = blk + 80;
    const unsigned* CNT = (const unsigned*)(p.ws + WS_CTL) + CW_CNT + l * 32 * 16;
    if (tid < 32) cnt[tid] = (int)__hip_atomic_load(CNT + tid * 16, __ATOMIC_RELAXED, __HIP_MEMORY_SCOPE_AGENT);
    __syncthreads();
    if (tid == 0) { int a = 0; for (int e = 0; e < 32; ++e) { blk[e] = a; a += (cnt[e] + 255) >> 8; } blk[32] = a; }
    __syncthreads();
    if (tid < 16) { const int Lq = pg8::moe_unit(tid, G, bx, blk[32] * 4); const int L = Lq < 0 ? 0 : Lq; const int rb = L >> 2; int e = 0;
        for (int j = 1; j < NEXP; ++j) e = (blk[j] <= rb) ? j : e;
        utab[tid] = (e << 16) | ((rb - blk[e]) & 0xffff); }
    __syncthreads();
    return blk[32];
}


#if defined(__HIP_DEVICE_COMPILE__)
#define LOADP() Params p; { const __attribute__((address_space(4))) Params* kp_ = (const __attribute__((address_space(4))) Params*)__builtin_amdgcn_kernarg_segment_ptr(); asm volatile("" : "+s"(kp_)); \
    __builtin_memcpy(&p, (const Params*)kp_, sizeof(Params)); }
#else
#define LOADP() Params p = p_unused;
#endif
#define PV() int tid = tid0; asm volatile("" : "+v"(tid)); const int lane = tid & 63, wave = __builtin_amdgcn_readfirstlane(tid >> 6); int G = G0, bx = bx0; asm volatile("" : "+s"(G), "+s"(bx)); \
    const int vcu = (G % 8 == 0) ? (bx % 8) * (G / 8) + bx / 8 : bx; int l = l0; asm volatile("" : "+s"(l)); (void)lane; (void)wave; (void)vcu; (void)l;
#define AMP_T0(n) unsigned long long amp_t0_ = 0; if (AMP_PHASE == (n)) amp_t0_ = __builtin_amdgcn_s_memrealtime();
#define AMP_WAIT(n) if (AMP_PHASE == (n)) { const unsigned long long t1_ = __builtin_amdgcn_s_memrealtime(); const unsigned long long w_ = (t1_ - amp_t0_) * AMP_K; while (__builtin_amdgcn_s_memrealtime() - t1_ < w_) __builtin_amdgcn_s_sleep(8); }
template <int L0> DI void layer_body(const XcdBarrier& bar, ldsp lds, const int tid0, const int G0, const int bx0, const Params& p_unused) {
    constexpr int l0 = L0;


{ AMP_T0(2)
#ifndef SKIP_INPROJ
        for (int rep_ = 0; rep_ < (DUP_PHASE == 2 ? 2 : 1); ++rep_) { LOADP(); PV(); unsigned char* ws = p.ws; pg8::Gemm g{(const f16*)(ws + WS_H), (const f16*)(ws + WS_WIN) + (size_t)l * INC * DM, DM, 0}; pg8::StaticOrder S; S.init(TT, INC, G, bx);
          EpiP E{(f16*)(ws + WS_P), INC};
          pg8::gemm_phase<EpiP, pg8::StaticOrder, true, false>(lds, g, S, E, tid);
          if (l < DEPTH - 1 && rep_ == 0) { const int nu = (TT / 256) * (INC / 256); if ((nu - bx + G - 1) / G < (nu + G - 1) / G) convert_steal(p, l + 1, 2, lds, tid, lane, wave); } }
#endif

        xcd_barrier(bar); AMP_WAIT(2) }

{ AMP_T0(3)
#ifndef SKIP_PREP
        for (int rep_ = 0; rep_ < (DUP_PHASE == 3 ? 2 : 1); ++rep_) { LOADP(); PV(); phase_prep_w(p, l, lds, lane, wave, vcu, G); }
#endif

        xcd_barrier(bar); AMP_WAIT(3) }

{ AMP_T0(5)
#ifndef SKIP_SCAN
        for (int rep_ = (DUP_PHASE == 4 ? 1 : 0); rep_ >= 0; --rep_) { LOADP(); PV(); phase_scan(p, tid, vcu, G, rep_); }
#endif
        xcd_barrier(bar); AMP_WAIT(5) }
{ AMP_T0(6)
#ifndef SKIP_HOUT
        for (int rep_ = 0; rep_ < (DUP_PHASE == 6 ? 2 : 1); ++rep_) { LOADP(); PV(); phase_hgrn_out_w(p, l, lds, lane, wave, vcu, G); }
#endif
#ifndef SKIP_ATTN
        for (int rep_ = 0; rep_ < (DUP_PHASE == 5 ? 2 : 1); ++rep_) { LOADP(); PV(); phase_attn(p, l, lds, tid, lane, wave, vcu, G, rep_); }
#endif
        xcd_barrier(bar); AMP_WAIT(6) }

{ AMP_T0(7)
#ifndef SKIP_OUTPROJ
        for (int rep_ = (DUP_PHASE == 7 ? 1 : 0); rep_ >= 0; --rep_) { LOADP(); PV(); unsigned char* ws = p.ws; pg8::Gemm g{(const f16*)(ws + WS_MIX), (const f16*)(ws + WS_WOUT) + (size_t)l * DM * DM, DM, 0}; pg8::StaticOrder S; S.init(TL, DM, G, bx);
          EpiOut E{(f16*)(ws + (rep_ ? WS_DUMMY : WS_DELTA)), (const float*)(ws + WS_MOD) + (size_t)l * 5 * 6144};
          pg8::gemm_phase<EpiOut, pg8::StaticOrder, true, false>(lds, g, S, E, tid);
          if (l < DEPTH - 1) phase_outproj_ctx(p, l, lane, wave, vcu, G, rep_); }
#endif

        xcd_barrier(bar); AMP_WAIT(7) }

{ AMP_T0(8)
#ifndef SKIP_ROUTER
        for (int rep_ = (DUP_PHASE == 8 ? 1 : 0); rep_ >= 0; --rep_) { LOADP(); PV(); if (l > 0 && rep_ == 0) convert_steal(p, l, 1 << 20, lds, tid, lane, wave); phase_router(p, l, lds, tid, lane, wave, vcu, G, rep_); }
#endif

        xcd_barrier(bar); AMP_WAIT(8) }

{ AMP_T0(9)
#ifndef SKIP_MOE1
        for (int rep_ = 0; rep_ < (DUP_PHASE == 9 ? 2 : 1); ++rep_) { LOADP(); PV(); unsigned char* ws = p.ws; const int nblk = moe_setup(p, l, lds, tid, G, bx);
          pg8::Gemm g{(const f16*)(ws + WS_H), (const f16*)(ws + WS_WGU) + (size_t)l * NEXP * 1024 * 1024, DM, (size_t)1024 * 1024};
          pg8::MoeOrder S{G, bx, nblk, (const LAS int*)(lds + BLK_OFF), (const LAS int*)(lds + BLK_OFF) + 40, (const int*)(ws + WS_LIST), DM * 2, (const LAS int*)(lds + BLK_OFF) + 80};
          EpiMoe1 E{(f16*)(ws + WS_HID)};
          pg8::gemm_phase<EpiMoe1, pg8::MoeOrder, true, true>(lds, g, S, E, tid);
          if (l < DEPTH - 1 && rep_ == 0) { const int nu = nblk * 4; if (pg8::moe_unit((nu + G - 1) / G - 1, G, bx, nu) < 0) convert_steal(p, l + 1, 2, lds, tid, lane, wave); } }
#endif

        xcd_barrier(bar); AMP_WAIT(9) }

{ AMP_T0(10)
#ifndef SKIP_MOE2
        for (int rep_ = 0; rep_ < (DUP_PHASE == 10 ? 2 : 1); ++rep_) { LOADP(); PV(); unsigned char* ws = p.ws; const int nblk = ((const LAS int*)(lds + BLK_OFF))[32];
          pg8::Gemm g{(const f16*)(ws + WS_HID), (const f16*)(ws + WS_WD) + (size_t)l * NEXP * 1024 * 512, EH, (size_t)1024 * 512};
          pg8::MoeOrder S{G, bx, nblk, (const LAS int*)(lds + BLK_OFF), (const LAS int*)(lds + BLK_OFF) + 40, (const int*)(ws + WS_LIST), EH * 2, (const LAS int*)(lds + BLK_OFF) + 80};
          EpiMoe2 E{(f16*)(ws + WS_Y2)};
          pg8::gemm_phase<EpiMoe2, pg8::MoeOrder, true, false>(lds, g, S, E, tid);
          if (l < DEPTH - 1 && rep_ == 0) { const int nu = nblk * 4; if (pg8::moe_unit((nu + G - 1) / G - 1, G, bx, nu) < 0) convert_steal(p, l + 1, 1, lds, tid, lane, wave); } }
#endif

        xcd_barrier(bar); AMP_WAIT(10) }

{ AMP_T0(11)
#ifndef SKIP_COMBINE
        for (int rep_ = (DUP_PHASE == 11 ? 1 : 0); rep_ >= 0; --rep_) { LOADP(); PV(); phase_combine(p, l, lds, lane, wave, vcu, G, rep_); }
#endif

        if (l0 < DEPTH - 1) xcd_barrier(bar); AMP_WAIT(11) }
        if (DUP_PHASE == 13) { for (int q_ = 0; q_ < 8; ++q_) xcd_barrier(bar); }

}

__global__ void __launch_bounds__(512, 2) fwd_kernel(Params p_unused) {
    extern __shared__ __attribute__((aligned(16))) unsigned char lds_raw[];
    ldsp lds = (ldsp)lds_raw;
    const int tid0 = threadIdx.x; const int G0 = gridDim.x; const int bx0 = blockIdx.x;
    const int tid = tid0;
    volatile LAS unsigned* MISC = (volatile LAS unsigned*)(lds + MISC_OFF);
    for (int u = tid; u < (LDS_BYTES - MISC_OFF) / 4; u += 512) ((LAS unsigned*)(lds + MISC_OFF))[u] = 0u;
    __syncthreads();
    XcdBarrier bar;
    { LOADP(); bar = xcd_barrier_post((unsigned*)(p.ws + WS_CTL) + CW_BAR, MISC + 8); }


    const int l0 = 0;
#ifndef SKIP_PROLOGUE
    for (int rep_ = 0; rep_ < (DUP_PHASE == 1 ? 2 : 1); ++rep_) { LOADP(); PV(); phase_prologue(p, lds, tid, lane, wave, vcu, G); __syncthreads(); }
#endif

    xcd_barrier(bar);

#ifndef SKIP_MOD0
        for (int rep_ = 0; rep_ < (DUP_PHASE == 12 ? 2 : 1); ++rep_) { LOADP(); PV(); phase_mod0(p, lane, wave, vcu, G); }
#endif

    xcd_barrier(bar);
    layer_body<0>(bar, lds, tid0, G0, bx0, p_unused); layer_body<1>(bar, lds, tid0, G0, bx0, p_unused); layer_body<2>(bar, lds, tid0, G0, bx0, p_unused); layer_body<3>(bar, lds, tid0, G0, bx0, p_unused);
}

extern "C" void kernel_launch(void* const* d_in, const int* in_sizes, int n_in, void* d_out, int out_size, void* d_ws, size_t ws_size, hipStream_t stream) {
    static int grid = 0;
    if (grid == 0) {
        if (n_in != 24 || out_size != TL * DM || ws_size < WS_END) { fprintf(stderr, "kernel_launch: unexpected shapes (n_in %d, out %d, ws %zu < %zu)\n", n_in, out_size, ws_size, (size_t)WS_END); grid = -1; return; }
        int dev = 0, cus = 0, per_cu = 0;
        if (hipGetDevice(&dev) != hipSuccess || hipDeviceGetAttribute(&cus, hipDeviceAttributeMultiprocessorCount, dev) != hipSuccess) { grid = -1; return; }
        if (hipFuncSetAttribute((const void*)fwd_kernel, hipFuncAttributeMaxDynamicSharedMemorySize, LDS_BYTES) != hipSuccess) { fprintf(stderr, "kernel_launch: hipFuncSetAttribute failed\n"); grid = -1; return; }
        if (hipOccupancyMaxActiveBlocksPerMultiprocessor(&per_cu, (const void*)fwd_kernel, 512, LDS_BYTES) != hipSuccess || per_cu < 1) { fprintf(stderr, "kernel_launch: occupancy query reports %d\n", per_cu); }
        (void)hipGetLastError();
        grid = cus;
    }
    if (grid < 0) return;
    (void)hipMemsetAsync((char*)d_ws + WS_CTL, 0, CTL_ZERO_BYTES, stream);
    Params p{};
    const float** pp = (const float**)&p;
    for (int i = 0; i < 24; ++i) pp[i] = (const float*)d_in[i];
    p.out = (float*)d_out; p.ws = (unsigned char*)d_ws;
    hipLaunchKernelGGL(fwd_kernel, dim3(grid), dim3(512), LDS_BYTES, stream, p);
}
```

```cpp
#include <hip/hip_runtime.h>
#include <cstdio>
#include <cstdint>

#define DI __device__ __forceinline__
#ifndef AMP_PHASE
#define AMP_PHASE 0
#endif
#define AMP_K 4
#ifndef DUP_PHASE
#define DUP_PHASE 0
#endif
#define LAS __attribute__((address_space(3)))
#define GAS __attribute__((address_space(1)))
typedef _Float16 f16;
typedef _Float16 f16x8 __attribute__((ext_vector_type(8)));
typedef _Float16 f16x4 __attribute__((ext_vector_type(4)));
typedef _Float16 f16x2 __attribute__((ext_vector_type(2)));
typedef short s16x8 __attribute__((ext_vector_type(8)));
typedef short s16x4 __attribute__((ext_vector_type(4)));
typedef float f32x4 __attribute__((ext_vector_type(4)));
typedef float f32x2 __attribute__((ext_vector_type(2)));
typedef float f32x16 __attribute__((ext_vector_type(16)));
typedef unsigned u32x4 __attribute__((ext_vector_type(4)));
typedef unsigned u32x2 __attribute__((ext_vector_type(2)));
typedef LAS unsigned char* ldsp;

constexpr int DM = 1024, NB = 4, SEQ = 8192, CTXL = 256, DEPTH = 4;
constexpr int TL = NB * SEQ, TC = NB * CTXL, TT = TL + TC;
constexpr int INC = 2304;
constexpr int C_U = 0, C_Q = 256, C_K = 768, C_V = 896, C_HQ = 1024, C_HI = 1280, C_HZF = 1536, C_HZB = 1792, C_HG = 2048;
constexpr int NEXP = 32, EH = 512;
constexpr int NPOS = 132;
constexpr float EPS = 1e-6f;
constexpr float LOG2E = 1.4426950408889634f;
constexpr int MAXBLK = 296;

constexpr size_t MiB = 1u << 20;
constexpr size_t WS_CTL = 0, CTL_ZERO_BYTES = 1 * MiB;
constexpr size_t WS_WIN = 1 * MiB;
constexpr size_t WS_WOUT = WS_WIN + (size_t)DEPTH * INC * DM * 2;
constexpr size_t WS_WGU = WS_WOUT + (size_t)DEPTH * DM * DM * 2;
constexpr size_t WS_WD = WS_WGU + (size_t)DEPTH * NEXP * 1024 * 1024 * 2;
constexpr size_t WS_POOLW = WS_WD + (size_t)DEPTH * NEXP * 1024 * 512 * 2;
constexpr size_t WS_WR = WS_POOLW + (size_t)DEPTH * 4 * 64 * 64 * 2;
constexpr size_t WS_MOD = WS_WR + (size_t)DEPTH * 1024 * 48 * 4;
constexpr size_t WS_LB = WS_MOD + (size_t)DEPTH * 5 * 6144 * 4;
constexpr size_t WS_ROPE = WS_LB + (size_t)DEPTH * 2 * 256 * 4;
constexpr size_t WS_XC = WS_ROPE + (size_t)(2 * 128 * 16 + 2 * 64 * 16) * 4;
constexpr size_t WS_GATES = WS_XC + (size_t)TC * DM * 4;
constexpr size_t WS_SLOT = WS_GATES + (size_t)TT * 2 * 4;
constexpr size_t WS_LIST = WS_SLOT + (size_t)TT * 2 * 4;
constexpr size_t WS_H = WS_LIST + (size_t)NEXP * TT * 4;
constexpr size_t WS_P = WS_H + (size_t)TT * DM * 2;
constexpr size_t WS_Y2 = WS_P;

constexpr size_t WS_QN = WS_P + (size_t)TT * INC * 2;
constexpr size_t WS_KN = WS_QN + (size_t)TT * 512 * 2;
constexpr size_t WS_MIX = WS_KN + (size_t)TT * 128 * 2;
constexpr size_t WS_HS = WS_MIX + (size_t)TT * DM * 2;
constexpr size_t WS_HA = WS_HS + (size_t)2 * NB * NPOS * 4 * 4096 * 4;
constexpr size_t WS_HSB = WS_HA + (size_t)2 * NB * NPOS * 4 * 64 * 4;
constexpr size_t WS_QS = WS_HSB + (size_t)2 * NB * NPOS * 4 * 4096 * 2;
constexpr size_t WS_DELTA = WS_QS + (size_t)TT * 256 * 2;
constexpr size_t WS_END0 = WS_DELTA + (size_t)TT * DM * 2;
constexpr size_t WS_HID = WS_QN;
constexpr size_t WS_DUMMY = WS_END0;
constexpr size_t WS_END = WS_END0 + (DUP_PHASE ? 144 * MiB : 0);
static_assert((size_t)2 * TT * DM * 2 <= (size_t)TT * INC * 2, "Y2 fits in P");
static_assert(WS_HID + (size_t)MAXBLK * 256 * EH * 2 <= WS_END0, "HID fits in its overlay");
static_assert(WS_WIN % 256 == 0 && WS_H % 256 == 0 && WS_P % 256 == 0 && WS_QN % 256 == 0 && WS_KN % 256 == 0 && WS_MIX % 256 == 0 && WS_HS % 256 == 0 && WS_HA % 256 == 0 && WS_XC % 256 == 0 && WS_LIST % 256 == 0 && WS_GATES % 256 == 0, "alignment");
constexpr int CW_BAR = 4096;
constexpr int CW_QUEUE = 12288;
constexpr int CW_CVQ = 13312;
constexpr int CW_CNT = 16384;
constexpr int RING_BYTES = 131072;
constexpr int MISC_OFF = RING_BYTES;
constexpr int BLK_OFF = MISC_OFF + 512;
constexpr int LDS_BYTES = 147456;

struct Params {
    const float *x, *c, *ctx, *c_ctx, *norm1_g, *norm2_g, *ada_w, *ada_b, *w_in, *w_out, *pool_w, *pool_scale, *q_norm_g, *k_norm_g, *attn_sink, *hgrn_lb,
        *hgrn_norm_g, *rgw, *rgb, *rew, *reb, *ewg, *ewu, *ewd;
    float* out; unsigned char* ws;
};

DI unsigned short f2bf(float f) { unsigned u = __builtin_bit_cast(unsigned, f); return (unsigned short)((u + 0x7fffu + ((u >> 16) & 1u)) >> 16); }
DI float wave_sum(float v) {
#pragma unroll
    for (int o = 1; o < 64; o <<= 1) v += __shfl_xor(v, o);
    return v;
}
DI float fast_rcp(float v) { return __builtin_amdgcn_rcpf(v); }
DI float siluf(float v) { return v * fast_rcp(1.f + __expf(-v)); }
DI unsigned cvt_pk_bf16(float lo, float hi) { unsigned r; asm volatile("v_cvt_pk_bf16_f32 %0, %1, %2" : "=v"(r) : "v"(lo), "v"(hi)); return r; }
DI int modb_of_row(int row) { return row < TL ? (row >> 13) : 4; }

#define XB_TMO      128
#define XB_XCNT(j)  (256  + 64 * (j))
#define XB_XSUB(j)  (1280 + 64 * (j))
#define XB_XGEN(j)  (2304 + 64 * (j))
#define XB_TOP      3328
#define XB_TOPGEN   3392
#define XCD_BAR_WORDS 3456
#define XB_SPIN_CAP (1u << 18)
__device__ __forceinline__ unsigned xb_ld(unsigned* p)              { return __hip_atomic_load(p, __ATOMIC_RELAXED, __HIP_MEMORY_SCOPE_AGENT); }
__device__ __forceinline__ unsigned xb_add(unsigned* p, unsigned v) { return __hip_atomic_fetch_add(p, v, __ATOMIC_RELAXED, __HIP_MEMORY_SCOPE_AGENT); }
__device__ __forceinline__ unsigned xb_xcc_id() { return (unsigned)__builtin_amdgcn_s_getreg((3 << 11) | 20) & 0xFu; }
#define XB_SPIN(cond, bar) do { unsigned _sp = 0; while (cond) { __builtin_amdgcn_s_sleep(1); \
    if ((++_sp & 255u) == 0u) { if (xb_ld(&(bar)[XB_TMO])) break; if (_sp > XB_SPIN_CAP) { atomicAdd(&(bar)[XB_TMO], 1u); break; } } } } while (0)
struct XcdBarrier { unsigned* bar; unsigned x; volatile LAS unsigned* st; };
__device__ __forceinline__ XcdBarrier xcd_barrier_post(unsigned* bar, volatile LAS unsigned* st) {
    XcdBarrier b; b.bar = bar; b.x = xb_xcc_id(); b.st = st;
    if (threadIdx.x == 0) (void)xb_add(&bar[XB_XCNT(b.x)], 1u);
    return b;
}
__device__ __forceinline__ void xcd_barrier_complete(unsigned* bar, unsigned x, unsigned& nloc, unsigned& nx) {
    const unsigned G = gridDim.x * gridDim.y * gridDim.z;
    unsigned sum, cnt, mine, sp = 0u;
    for (;;) {
        sum = 0u; cnt = 0u; mine = 0u;
#pragma unroll 1
        for (unsigned j = 0; j < 16; ++j) { const unsigned c = xb_ld(&bar[XB_XCNT(j)]); sum += c; cnt += (c > 0u) ? 1u : 0u; mine = (j == x) ? c : mine; }
        if (sum == G) break;
        __builtin_amdgcn_s_sleep(1);
        if ((++sp & 255u) == 0u) { if (xb_ld(&bar[XB_TMO])) break; if (sp > XB_SPIN_CAP) { atomicAdd(&bar[XB_TMO], 1u); break; } }
    }
    nloc = mine > 0u ? mine : 1u; nx = cnt > 0u ? cnt : 1u;
}
__device__ __forceinline__ void xcd_barrier(const XcdBarrier& b) {
    asm volatile("s_waitcnt vmcnt(0)" ::: "memory");
    __syncthreads();
    if (threadIdx.x == 0) {
        unsigned* bar = b.bar;
        __builtin_amdgcn_s_waitcnt(0);
        unsigned nloc = b.st[0], nx = b.st[1];
        if (nloc == 0u) { xcd_barrier_complete(bar, b.x, nloc, nx); b.st[0] = nloc; b.st[1] = nx; }
        const unsigned old = xb_add(&bar[XB_XSUB(b.x)], 1u);
        const unsigned gen = old / nloc;
        if (old + 1u == (gen + 1u) * nloc) {
            __builtin_amdgcn_fence(__ATOMIC_RELEASE, "agent");
            asm volatile("s_waitcnt vmcnt(0)" ::: "memory");
            const unsigned og = xb_add(&bar[XB_TOP], 1u);
            const unsigned tg = og / nx;
            if (og + 1u == (tg + 1u) * nx) xb_add(&bar[XB_TOPGEN], 1u);
            else XB_SPIN(xb_ld(&bar[XB_TOPGEN]) == tg, bar);
            __builtin_amdgcn_fence(__ATOMIC_ACQUIRE, "agent");
            xb_add(&bar[XB_XGEN(b.x)], 1u);
            asm volatile("s_waitcnt vmcnt(0)" ::: "memory");
        } else {
            XB_SPIN(xb_ld(&bar[XB_XGEN(b.x)]) == gen, bar);
            __builtin_amdgcn_fence(__ATOMIC_ACQUIRE, "agent");
            asm volatile("s_waitcnt vmcnt(0)" ::: "memory");
        }
    }
    __syncthreads();
}

namespace pg8 {
constexpr int BM = 256, BK = 64, HALF = 128, HTB = HALF * BK * 2, STAGE_BYTES = 8 * HTB, NXCD = 8, WGM = 8;
DI int lds_byte(int r, int c) { const int st = (r >> 4) * 2 + (c >> 5), rr = r & 15, cc = c & 31, ob = rr * 64 + cc * 2; return st * 1024 + (ob ^ (((ob >> 9) & 1) << 5)); }
DI void stage_rc(int b, int& R, int& C) { const int st = b / 1024, sb = b % 1024, swz = sb ^ (((sb >> 9) & 1) << 5); R = (st >> 1) * 16 + swz / 64; C = (st & 1) * 32 + (swz % 64) / 2; }
DI int perm32(int rho) { const int n = rho >> 4, i = rho & 15; return 8 * (i >> 2) + 4 * n + (i & 3); }

struct Unit { int pm, pn, e, lrb; };
struct Gemm { const f16* A; const f16* Bt; int K; size_t bstride; };

struct StaticOrder {
    int nM, nN, nwg, G, c;
    DI void init(int M, int N, int G_, int c_) { nM = M / BM; nN = N / BM; nwg = nM * nN; G = G_; c = c_; }
    DI bool next(int i, Unit& u) const {
        const long L = (long)i * G + c; if (L >= nwg) return false;
        int wgid = (int)L; { const int q = nwg / NXCD, r = nwg % NXCD, xcd = wgid % NXCD, off = wgid / NXCD; wgid = (xcd < r ? xcd * (q + 1) : r * (q + 1) + (xcd - r) * q) + off; }
        const int nig = WGM * nN, gid = wgid / nig, fm = gid * WGM, gsz = (nM - fm) < WGM ? (nM - fm) : WGM;
        u.pm = fm + ((wgid % nig) % gsz); u.pn = (wgid % nig) / gsz; u.e = 0; u.lrb = 0; return true;
    }
    DI unsigned arow(const Unit&, int) const { return 0u; }
};
DI int moe_unit(int i, int G, int c, int U) {
    if (G % 8 != 0) { const int L = i * G + c; return L < U ? L : -1; }
    const int x = c & 7, j = c >> 3, W = G >> 3; const int lo = (int)(((long)U * x) >> 3), hi = (int)(((long)U * (x + 1)) >> 3); const int k = lo + i * W + j; return k < hi ? k : -1;
}
struct MoeOrder {
    int G, c, nblk; const LAS int* blk; const LAS int* cnt; const int* list; int rowbytes;
    const LAS int* utab;
    DI bool next(int i, Unit& u) const {
        const int L = moe_unit(i, G, c, nblk * 4); if (L < 0) return false;
        const int rb = L >> 2; u.pn = L & 3; u.pm = rb;
        const int t = utab[i]; u.e = t >> 16; u.lrb = t & 0xffff; return true;
    }
    DI unsigned arow(const Unit& u, int r) const {
        const int pos = u.lrb * 256 + r; const int ent = (pos < cnt[u.e]) ? list[(size_t)u.e * TT + pos] : 0;
        return (unsigned)(ent >> 1) * (unsigned)rowbytes;
    }
};

template <class Epi, class Sched, bool ALIGN_EPI, bool GATHER>
DI void gemm_phase(ldsp lds, const Gemm g, const Sched& S, const Epi& E, const int tid) {
    const int wid = __builtin_amdgcn_readfirstlane(tid >> 6), lane = tid & 63, wr = wid >> 2, wc = wid & 3, fr = lane & 15, fq = lane >> 4;
    const int K = g.K, nt = K / BK;
    int Rr[2], Cc[2]; unsigned voffB[2], voffA[2];
#pragma unroll
    for (int i = 0; i < 2; ++i) { int R, C; stage_rc(tid * 16 + i * 8192, R, C); const int Rb = Epi::PERM ? ((R & ~31) + perm32(R & 31)) : R;
        Rr[i] = R; Cc[i] = C; voffB[i] = (unsigned)(Rb * K + C) * 2u; voffA[i] = (unsigned)(R * K + C) * 2u; }
    const size_t kstep = (size_t)(BK * 2);
    const size_t hstep = (size_t)HALF * K * 2;
    const size_t tstep = 2 * hstep;
    const unsigned ldsw = (unsigned)wid * 1024u;
    const int aoff = lds_byte(wr * 64 + fr, fq * 8), boff = lds_byte(wc * 32 + fr, fq * 8);
    const char* const Ab = (const char*)g.A;
#define PG8_SA(b, h) (((b) * 2 + (h)) * HTB)
#define PG8_SB(b, h) ((4 + (b) * 2 + (h)) * HTB)
#define PG8_STAGE(bufoff, gbase, voff) do { _Pragma("unroll") for (int _i = 0; _i < 2; ++_i) \
        __builtin_amdgcn_global_load_lds((const unsigned*)((const char*)(gbase) + (voff)[_i]), (LAS unsigned*)(lds + (bufoff) + ldsw + _i * 8192), 16, 0, 0); } while (0)
#define PG8_LDA(dst, b, h) do { _Pragma("unroll") for (int m = 0; m < 4; ++m) _Pragma("unroll") for (int k = 0; k < 2; ++k) dst[m][k] = *(const LAS f16x8*)(lds + PG8_SA(b, h) + aoff + m * 2048 + k * 1024); } while (0)
#define PG8_LDB(dst, b, h) do { _Pragma("unroll") for (int n = 0; n < 2; ++n) _Pragma("unroll") for (int k = 0; k < 2; ++k) dst[n][k] = *(const LAS f16x8*)(lds + PG8_SB(b, h) + boff + n * 2048 + k * 1024); } while (0)
#define PG8_MMA(ai, bj, At, Bt) do { __builtin_amdgcn_s_setprio(1); _Pragma("unroll") for (int m = 0; m < 4; ++m) _Pragma("unroll") for (int n = 0; n < 2; ++n) _Pragma("unroll") for (int k = 0; k < 2; ++k) \
        acc[ai][bj][m][n] = __builtin_amdgcn_mfma_f32_16x16x32_f16(Bt[n][k], At[m][k], acc[ai][bj][m][n], 0, 0, 0); __builtin_amdgcn_s_setprio(0); } while (0)
#define PG8_WAIT_V(n) asm volatile("s_waitcnt vmcnt(" #n ")" ::: "memory")
#define PG8_WAIT_L(n) asm volatile("s_waitcnt lgkmcnt(" #n ")" ::: "memory")
#define PG8_BAR __builtin_amdgcn_s_barrier()
#define PG8_SCHED __builtin_amdgcn_sched_barrier(0)
#define PG8_AOFF(dst, U) do { if constexpr (GATHER) { _Pragma("unroll") for (int _h = 0; _h < 2; ++_h) _Pragma("unroll") for (int _i = 0; _i < 2; ++_i) \
        dst[_h][_i] = S.arow(U, _h * HALF + Rr[_i]) + (unsigned)Cc[_i] * 2u; } } while (0)
#define PG8_STAGE_A(bufoff, kb, nx, h) do { if constexpr (GATHER) { if (nx) PG8_STAGE(bufoff, Ab + (kb), aon[h]); else PG8_STAGE(bufoff, Ab + (kb), aoc[h]); } \
        else { PG8_STAGE(bufoff, ((nx) ? nA : cA) + (kb) + (h) * hstep, voffA); } } while (0)
    Unit cur, nxt; int ui = 0;
    if (!S.next(0, cur)) return;
    f32x4 acc[2][2][4][2];
#pragma unroll
    for (int a = 0; a < 2; ++a)
#pragma unroll
        for (int b = 0; b < 2; ++b)
#pragma unroll
            for (int m = 0; m < 4; ++m)
#pragma unroll
                for (int n = 0; n < 2; ++n) acc[a][b][m][n] = (f32x4){0.f, 0.f, 0.f, 0.f};
    f16x8 At[4][2], B0[2][2], B1[2][2];
    unsigned aoc[2][2], aon[2][2];
    PG8_AOFF(aoc, cur);
    const char* cA = Ab + (GATHER ? (size_t)0 : (size_t)cur.pm * tstep); const char* nA = cA;
    const char* cB = (const char*)g.Bt + ((size_t)cur.e * g.bstride) * 2 + (size_t)cur.pn * tstep;
    PG8_STAGE(PG8_SB(0, 0), cB, voffB); PG8_STAGE(PG8_SB(0, 1), cB + hstep, voffB); PG8_STAGE_A(PG8_SA(0, 0), 0, 0, 0); PG8_STAGE_A(PG8_SA(0, 1), 0, 0, 1);
    if (wr == 1) PG8_BAR;
    PG8_WAIT_V(2); PG8_BAR;
    PG8_STAGE(PG8_SB(1, 0), cB + kstep, voffB); PG8_STAGE_A(PG8_SA(1, 0), kstep, 0, 0); PG8_STAGE(PG8_SB(1, 1), cB + hstep + kstep, voffB);
    PG8_WAIT_V(6); PG8_BAR;
    for (;;) {
        const bool has_next = S.next(ui + 1, nxt);
        if constexpr (GATHER) { if (has_next) { PG8_AOFF(aon, nxt); } else {
#pragma unroll
            for (int _h = 0; _h < 2; ++_h)
#pragma unroll
                for (int _i = 0; _i < 2; ++_i) aon[_h][_i] = aoc[_h][_i]; } }
        else { nA = has_next ? Ab + (size_t)nxt.pm * tstep : cA; }
        const char* nB = has_next ? (const char*)g.Bt + ((size_t)nxt.e * g.bstride) * 2 + (size_t)nxt.pn * tstep : cB;
        for (int t = 0; t < nt; t += 2) {
            const bool last = (t == nt - 2);
            const size_t k1 = (size_t)(t + 1) * kstep, k2 = last ? (size_t)0 : (size_t)(t + 2) * kstep, k3 = k2 + kstep;
            const char* b2 = last ? nB : cB + (size_t)(t + 2) * kstep; const char* b3 = b2 + kstep;
            PG8_LDB(B0, 0, 0); PG8_LDB(B1, 0, 1); PG8_SCHED; PG8_LDA(At, 0, 0); PG8_STAGE_A(PG8_SA(1, 1), k1, 0, 1);
            PG8_WAIT_V(8); PG8_WAIT_L(0); PG8_BAR; PG8_MMA(0, 0, At, B0); PG8_MMA(0, 1, At, B1); PG8_BAR; PG8_SCHED;
            PG8_LDA(At, 0, 1); PG8_STAGE(PG8_SB(0, 0), b2, voffB); PG8_STAGE(PG8_SB(0, 1), b2 + hstep, voffB); PG8_STAGE_A(PG8_SA(0, 0), k2, last, 0);
            PG8_WAIT_V(8); PG8_WAIT_L(0); PG8_BAR; PG8_MMA(1, 0, At, B0); PG8_MMA(1, 1, At, B1); PG8_BAR; PG8_SCHED;
            PG8_LDB(B0, 1, 0); PG8_LDB(B1, 1, 1); PG8_SCHED; PG8_LDA(At, 1, 0); PG8_STAGE_A(PG8_SA(0, 1), k2, last, 1);
            PG8_WAIT_V(8); PG8_WAIT_L(0); PG8_BAR; PG8_MMA(0, 0, At, B0); PG8_MMA(0, 1, At, B1); PG8_BAR; PG8_SCHED;
            PG8_LDA(At, 1, 1); PG8_STAGE(PG8_SB(1, 0), b3, voffB); PG8_STAGE(PG8_SB(1, 1), b3 + hstep, voffB); PG8_STAGE_A(PG8_SA(1, 0), k3, last, 0);
            PG8_WAIT_V(8); PG8_WAIT_L(0); PG8_BAR; PG8_MMA(1, 0, At, B0); PG8_MMA(1, 1, At, B1); PG8_BAR; PG8_SCHED;
        }
        if constexpr (ALIGN_EPI) { if (wr == 0) PG8_BAR; }
        E(acc, cur, wr, wc, fr, fq);
        if (!has_next) break;
#pragma unroll
        for (int a = 0; a < 2; ++a)
#pragma unroll
            for (int b = 0; b < 2; ++b)
#pragma unroll
                for (int m = 0; m < 4; ++m)
#pragma unroll
                    for (int n = 0; n < 2; ++n) acc[a][b][m][n] = (f32x4){0.f, 0.f, 0.f, 0.f};
        cur = nxt; cB = nB; cA = nA; ++ui;
        if constexpr (GATHER) {
#pragma unroll
        for (int _h = 0; _h < 2; ++_h)
#pragma unroll
            for (int _i = 0; _i < 2; ++_i) aoc[_h][_i] = aon[_h][_i]; }
        if constexpr (ALIGN_EPI) { if (wr == 1) PG8_BAR; }
    }
    PG8_WAIT_V(0);
    if constexpr (!ALIGN_EPI) { if (wr == 0) PG8_BAR; }
    PG8_BAR;
#undef PG8_SA
#undef PG8_SB
#undef PG8_STAGE
#undef PG8_LDA
#undef PG8_LDB
#undef PG8_MMA
#undef PG8_WAIT_V
#undef PG8_WAIT_L
#undef PG8_BAR
#undef PG8_SCHED
#undef PG8_AOFF
#undef PG8_STAGE_A
}
}

typedef f32x4 AccT[2][2][4][2];
DI u32x4 pack8_f16(f32x4 a, f32x4 b) {
    f16x8 h; h[0] = (f16)a[0]; h[1] = (f16)a[1]; h[2] = (f16)a[2]; h[3] = (f16)a[3]; h[4] = (f16)b[0]; h[5] = (f16)b[1]; h[6] = (f16)b[2]; h[7] = (f16)b[3];
    return __builtin_bit_cast(u32x4, h);
}
struct EpiP { static constexpr bool PERM = true; f16* O; int ldc;
    DI void operator()(const AccT& acc, const pg8::Unit& u, int wr, int wc, int fr, int fq) const {
        char* base = (char*)(O + (size_t)u.pm * 256 * ldc + u.pn * 256);
        unsigned loff = (unsigned)((wr * 64 + fr) * ldc + wc * 32 + 8 * fq) * 2u;
        asm volatile("" : "+v"(loff));
#pragma unroll
        for (int ai = 0; ai < 2; ++ai)
#pragma unroll
            for (int m = 0; m < 4; ++m) {
#pragma unroll
                for (int bj = 0; bj < 2; ++bj) *(u32x4*)(base + (size_t)((ai * 128 + m * 16) * ldc + bj * 128) * 2 + loff) = pack8_f16(acc[ai][bj][m][0], acc[ai][bj][m][1]); }
    }
};
struct EpiOut { static constexpr bool PERM = true; f16* D; const float* modl;
    DI void operator()(const AccT& acc, const pg8::Unit& u, int wr, int wc, int fr, int fq) const {
        char* base = (char*)(D + (size_t)u.pm * 256 * DM + u.pn * 256);
        const float* g1 = modl + (u.pm < 128 ? (u.pm >> 5) : 4) * 6144 + 2 * 1024 + u.pn * 256;
        unsigned loff = (unsigned)((wr * 64 + fr) * DM + wc * 32 + 8 * fq) * 2u, goff = (unsigned)(wc * 32 + 8 * fq);
        asm volatile("" : "+v"(loff), "+v"(goff));
#pragma unroll
        for (int bj = 0; bj < 2; ++bj) { const f32x4 g0 = *(const f32x4*)(g1 + goff + bj * 128), g4 = *(const f32x4*)(g1 + goff + bj * 128 + 4);
#pragma unroll
            for (int ai = 0; ai < 2; ++ai)
#pragma unroll
                for (int m = 0; m < 4; ++m) *(u32x4*)(base + (size_t)((ai * 128 + m * 16) * DM + bj * 128) * 2 + loff) = pack8_f16(acc[ai][bj][m][0] * g0, acc[ai][bj][m][1] * g4); }
    }
};
struct EpiMoe1 { static constexpr bool PERM = true; f16* HID;
    DI void operator()(const AccT& acc, const pg8::Unit& u, int wr, int wc, int fr, int fq) const {
        char* base = (char*)(HID + (size_t)u.pm * 256 * EH + u.pn * 128);
        unsigned loff = (unsigned)((wr * 64 + fr) * EH + wc * 32 + 8 * fq) * 2u;
        asm volatile("" : "+v"(loff));
#pragma unroll
        for (int ai = 0; ai < 2; ++ai)
#pragma unroll
            for (int m = 0; m < 4; ++m) { f32x4 h0, h1;
#pragma unroll
                for (int i = 0; i < 4; ++i) { h0[i] = siluf(acc[ai][0][m][0][i]) * acc[ai][1][m][0][i]; h1[i] = siluf(acc[ai][0][m][1][i]) * acc[ai][1][m][1][i]; }
                *(u32x4*)(base + (size_t)((ai * 128 + m * 16) * EH) * 2 + loff) = pack8_f16(h0, h1); }
    }
};
struct EpiMoe2 { static constexpr bool PERM = true; f16* Y2;
    DI void operator()(const AccT& acc, const pg8::Unit& u, int wr, int wc, int fr, int fq) const {
        char* base = (char*)(Y2 + (size_t)u.pm * 256 * DM + u.pn * 256);
        unsigned loff = (unsigned)((wr * 64 + fr) * DM + wc * 32 + 8 * fq) * 2u;
        asm volatile("" : "+v"(loff));
#pragma unroll
        for (int ai = 0; ai < 2; ++ai)
#pragma unroll
            for (int m = 0; m < 4; ++m) {
#pragma unroll
                for (int bj = 0; bj < 2; ++bj) *(u32x4*)(base + (size_t)((ai * 128 + m * 16) * DM + bj * 128) * 2 + loff) = pack8_f16(acc[ai][bj][m][0], acc[ai][bj][m][1]); }
    }
};

DI void p0_transpose_item(const float* W, int K, int N, f16* WT, int mode, LAS float* scr, int item, int lane) {
    const int nblk = N / 32, kb = item / nblk, nb = item % nblk, k0 = 64 * kb, n0 = 32 * nb;
    const int rbase = (mode == 0) ? n0 : (256 * (n0 >> 7) + (n0 & 127) + (mode == 2 ? 128 : 0));
#pragma unroll 8
    for (int i = 0; i < 32; ++i) { const int kk = 2 * i + (lane >> 5); scr[kk * 33 + (lane & 31)] = W[(size_t)(k0 + kk) * N + n0 + (lane & 31)]; }
    asm volatile("s_waitcnt lgkmcnt(0)" ::: "memory");
    const int c = lane & 7;
#pragma unroll
    for (int j = 0; j < 4; ++j) { const int n = (lane >> 3) + 8 * j; const LAS float* s = scr + (8 * c) * 33 + n;
        f16x8 o;
#pragma unroll
        for (int q = 0; q < 8; ++q) o[q] = (f16)s[q * 33];
        *(f16x8*)(WT + (size_t)(rbase + n) * K + k0 + 8 * c) = o; }
    asm volatile("s_waitcnt lgkmcnt(0)" ::: "memory");
}

constexpr int CV_CHUNKS = 768;
DI void expert_item(const Params& p, int l, int r, LAS float* scr, int lane) {
    unsigned char* ws = p.ws; const int e = r / 768, q = r % 768, which = q >> 8, item = q & 255; const size_t le = (size_t)l * NEXP + e;
    if (which == 0) p0_transpose_item(p.ewg + le * DM * EH, DM, EH, (f16*)(ws + WS_WGU) + le * 1024 * 1024, 1, scr, item, lane);
    else if (which == 1) p0_transpose_item(p.ewu + le * DM * EH, DM, EH, (f16*)(ws + WS_WGU) + le * 1024 * 1024, 2, scr, item, lane);
    else p0_transpose_item(p.ewd + le * EH * DM, EH, DM, (f16*)(ws + WS_WD) + le * 1024 * 512, 0, scr, item, lane);
}
DI void convert_steal(const Params& p, int l, int maxpull, ldsp lds, int tid, int lane, int wave) {
    unsigned* qh = (unsigned*)(p.ws + WS_CTL) + CW_CVQ + l * 64; volatile LAS unsigned* slot = (volatile LAS unsigned*)(lds + MISC_OFF) + 24;
    LAS float* scr = (LAS float*)(lds + wave * 16384);
    for (int k = 0; k < maxpull; ++k) {
        __syncthreads();
        if (tid == 0) slot[0] = atomicAdd(qh, 1u);
        __syncthreads();
        const unsigned c = slot[0];
        if (c >= (unsigned)CV_CHUNKS) break;
#pragma unroll 1
        for (int j = 0; j < 4; ++j) expert_item(p, l, (int)c * 32 + wave * 4 + j, scr, lane);
    }
    __syncthreads();
}

DI void phase_prologue(const Params& p, ldsp lds, int tid, int lane, int wave, int vcu, int G) {
    unsigned char* ws = p.ws;
    LAS float* scr = (LAS float*)(lds + wave * 16384);
    const int gw = vcu * 8 + wave, NGW = G * 8;
    constexpr int PER_L = 1152 + 512;
    constexpr int NW_ITEMS = DEPTH * PER_L;
    for (int it = gw; it < NW_ITEMS + 32; it += NGW) {
        if (it >= NW_ITEMS) { const int j = it - NW_ITEMS, mat = j >> 1;
            p0_transpose_item(p.pool_w + (size_t)mat * 4096, 64, 64, (f16*)(ws + WS_POOLW) + (size_t)mat * 4096, 0, scr, j & 1, lane); continue; }
        const int l = it / PER_L; int r = it % PER_L;
        if (r < 1152) { p0_transpose_item(p.w_in + (size_t)l * DM * INC, DM, INC, (f16*)(ws + WS_WIN) + (size_t)l * INC * DM, 0, scr, r, lane); continue; } r -= 1152;
        p0_transpose_item(p.w_out + (size_t)l * DM * DM, DM, DM, (f16*)(ws + WS_WOUT) + (size_t)l * DM * DM, 0, scr, r, lane);
    }
    for (int it = gw; it < 32 * 768; it += NGW) expert_item(p, 0, it, scr, lane);
    { f16* WRH = (f16*)(ws + WS_WR); f16* WRL = WRH + (size_t)DEPTH * 48 * 1024;
      for (int i = vcu * 512 + tid; i < DEPTH * 48 * 1024; i += G * 512) { const int k = i & 1023, o = (i >> 10) % 48, l = i / (48 * 1024);
          float v = 0.f; if (o < 4) v = p.rgw[((size_t)l * 1024 + k) * 4 + o]; else if (o < 36) v = p.rew[((size_t)l * 1024 + k) * 32 + (o - 4)];
          v *= 1024.f; const f16 hi = (f16)v; WRH[i] = hi; WRL[i] = (f16)(v - (float)hi); } }
    { float* RT = (float*)(ws + WS_ROPE);
      for (int i = vcu * 512 + tid; i < (128 + 64) * 16; i += G * 512) { const int m = i & 15, pos = i >> 4;
          const float inv = powf(10000.f, -(float)m / 16.f); const float ang = (float)(pos < 128 ? pos : pos - 128) * inv; float s, c; sincosf(ang, &s, &c);
          if (pos < 128) { RT[pos * 16 + m] = c; RT[2048 + pos * 16 + m] = s; } else { RT[4096 + (pos - 128) * 16 + m] = c; RT[4096 + 1024 + (pos - 128) * 16 + m] = s; } } }
    if (vcu == 0) { float* LB = (float*)(ws + WS_LB);
        const float a0 = p.hgrn_lb[tid], a1 = p.hgrn_lb[512 + tid], a2 = p.hgrn_lb[1024 + tid], a3 = p.hgrn_lb[1536 + tid];
        const float mx = fmaxf(fmaxf(a0, a1), fmaxf(a2, a3)); const float e0 = expf(a0 - mx), e1 = expf(a1 - mx), e2 = expf(a2 - mx), e3 = expf(a3 - mx); const float inv = 1.f / (e0 + e1 + e2 + e3);
        LB[tid] = 0.f; LB[512 + tid] = e1 * inv; LB[1024 + tid] = (e1 + e2) * inv; LB[1536 + tid] = (e1 + e2 + e3) * inv; }
    __syncthreads();
    { LAS float* sl = (LAS float*)lds;
      LAS float* red = (LAS float*)(lds + 32768);
      for (int i = tid; i < 5 * 1024; i += 512) { const int b = i >> 10, k = i & 1023; const float v = (b < 4) ? p.c[b * 1024 + k] : p.c_ctx[k]; sl[i] = siluf(v); }
      __syncthreads();
      float* MOD = (float*)(ws + WS_MOD);
      for (int it = vcu; it < DEPTH * 96; it += G) { const int l = it / 96, col = (it % 96) * 64 + lane;
          const float* W = p.ada_w + (size_t)l * 1024 * 6144 + col; float a[5] = {0.f, 0.f, 0.f, 0.f, 0.f};
#pragma unroll 8
          for (int k = wave * 128; k < wave * 128 + 128; ++k) { const float w = W[(size_t)k * 6144];
#pragma unroll
              for (int b = 0; b < 5; ++b) a[b] += sl[b * 1024 + k] * w; }
#pragma unroll
          for (int b = 0; b < 5; ++b) red[(wave * 5 + b) * 64 + lane] = a[b];
          __syncthreads();
          if (tid < 320) { const int b = tid >> 6, cc = tid & 63; float s = 0.f;
#pragma unroll
              for (int w = 0; w < 8; ++w) s += red[(w * 5 + b) * 64 + cc];
              const int c2 = (it % 96) * 64 + cc; MOD[((size_t)l * 5 + b) * 6144 + c2] = s + p.ada_b[l * 6144 + c2]; }
          __syncthreads(); } }
}

DI void modulate_row_store(const f32x4 (&v)[4], float r, const float* gn, const float* sh, const float* sc, f16* hrow, int lane) {
#pragma unroll
    for (int j = 0; j < 4; ++j) { const int c = 256 * j + 4 * lane; const f32x4 g = *(const f32x4*)(gn + c), s = *(const f32x4*)(sh + c), k = *(const f32x4*)(sc + c);
        f16x4 o;
#pragma unroll
        for (int i = 0; i < 4; ++i) o[i] = (f16)(v[j][i] * r * g[i] * (1.f + k[i]) + s[i]);
        *(f16x4*)(hrow + c) = o; }
}
DI void phase_mod0(const Params& p, int lane, int wave, int vcu, int G) {
    const float* MOD = (const float*)(p.ws + WS_MOD); f16* H = (f16*)(p.ws + WS_H);
    for (int row = vcu * 8 + wave; row < TT; row += G * 8) {
        const float* xr = (row < TL) ? p.x + (size_t)row * DM : p.ctx + (size_t)(row - TL) * DM; const int b = modb_of_row(row);
        f32x4 v[4]; float s = 0.f;
#pragma unroll
        for (int j = 0; j < 4; ++j) { v[j] = *(const f32x4*)(xr + 256 * j + 4 * lane); s += v[j][0] * v[j][0] + v[j][1] * v[j][1] + v[j][2] * v[j][2] + v[j][3] * v[j][3]; }
        const float r = __builtin_amdgcn_rsqf(wave_sum(s) * (1.f / DM) + EPS);
        modulate_row_store(v, r, p.norm1_g, MOD + (size_t)b * 6144, MOD + (size_t)b * 6144 + 1024, H + (size_t)row * DM, lane);
    }
}
DI void phase_combine(const Params& p, int l, ldsp lds, int lane, int wave, int vcu, int G, int dry) {
    const LAS int* blk = (const LAS int*)(lds + BLK_OFF); const int* SLOT = (const int*)(p.ws + WS_SLOT);
    const float* MOD = (const float*)(p.ws + WS_MOD); f16* H = (f16*)(p.ws + (dry ? WS_DUMMY + 64 * MiB : WS_H)); const f16* Y2 = (const f16*)(p.ws + WS_Y2); const float* GT = (const float*)(p.ws + WS_GATES);
    float* XC = (float*)(p.ws + WS_XC);
    const int nrows = (l == DEPTH - 1) ? TL : TT; const int NGW = G * 8;
    for (int row0 = vcu * 8 + wave; row0 < nrows; row0 += 2 * NGW) {
        f32x4 v[2][4]; f16x4 ya[2][4], yb[2][4], dv[2][4]; float ga[2], gb[2]; int rows[2]; bool ok[2];
#pragma unroll
        for (int q = 0; q < 2; ++q) { const int rr = row0 + q * NGW; ok[q] = rr < nrows; const int row = ok[q] ? rr : row0; rows[q] = row;
            const float* xr = (row < TL) ? (l == 0 ? p.x : p.out) + (size_t)row * DM : (l == 0 ? p.ctx : XC) + (size_t)(row - TL) * DM; const f16* dl = (const f16*)(p.ws + WS_DELTA) + (size_t)row * DM;
            const int s0 = SLOT[row * 2], s1 = SLOT[row * 2 + 1]; const f16* y0 = Y2 + ((size_t)blk[s0 >> 20] * 256 + (s0 & 0xfffff)) * DM; const f16* y1 = Y2 + ((size_t)blk[s1 >> 20] * 256 + (s1 & 0xfffff)) * DM;
            ga[q] = GT[row * 2]; gb[q] = GT[row * 2 + 1];
#pragma unroll
            for (int j = 0; j < 4; ++j) { const int c = 256 * j + 4 * lane; v[q][j] = *(const f32x4*)(xr + c); dv[q][j] = *(const f16x4*)(dl + c); ya[q][j] = *(const f16x4*)(y0 + c); yb[q][j] = *(const f16x4*)(y1 + c); } }
        float ssum[2];
#pragma unroll
        for (int q = 0; q < 2; ++q) { const int row = rows[q]; const int b = modb_of_row(row); const float* g2 = MOD + ((size_t)l * 5 + b) * 6144 + 5 * 1024;
            float* xr = (row < TL) ? p.out + (size_t)row * DM : XC + (size_t)(row - TL) * DM; float* xw = dry ? (float*)(p.ws + WS_DUMMY) + (size_t)(row & 8191) * DM : xr; float s = 0.f;
#pragma unroll
            for (int j = 0; j < 4; ++j) { const int c = 256 * j + 4 * lane; const f32x4 g = *(const f32x4*)(g2 + c);
#pragma unroll
                for (int i = 0; i < 4; ++i) v[q][j][i] = (v[q][j][i] + (float)dv[q][j][i]) + g[i] * (ga[q] * (float)ya[q][j][i] + gb[q] * (float)yb[q][j][i]);
                if (ok[q]) *(f32x4*)(xw + c) = v[q][j];
                s += v[q][j][0] * v[q][j][0] + v[q][j][1] * v[q][j][1] + v[q][j][2] * v[q][j][2] + v[q][j][3] * v[q][j][3]; }
            ssum[q] = s; }
        if (l < DEPTH - 1) {
#pragma unroll
            for (int o = 1; o < 64; o <<= 1) { ssum[0] += __shfl_xor(ssum[0], o); ssum[1] += __shfl_xor(ssum[1], o); }
#pragma unroll
            for (int q = 0; q < 2; ++q) if (ok[q]) { const int row = rows[q]; const int b = modb_of_row(row); const float r = __builtin_amdgcn_rsqf(ssum[q] * (1.f / DM) + EPS); const float* m1 = MOD + ((size_t)(l + 1) * 5 + b) * 6144;
                modulate_row_store(v[q], r, p.norm1_g + (l + 1) * DM, m1, m1 + 1024, H + (size_t)row * DM, lane); } }
    }
}

DI f32x4 mma_f16(f16x8 a, f16x8 b, f32x4 c) { return __builtin_amdgcn_mfma_f32_16x16x32_f16(a, b, c, 0, 0, 0); }
DI f32x4 mma_bf16(s16x8 a, s16x8 b, f32x4 c) { return __builtin_amdgcn_mfma_f32_16x16x32_bf16(a, b, c, 0, 0, 0); }

constexpr int TP = 72;
struct TileInfo { int row0, t0, seqrow0, len, b, isctx, chunkpos_f, chunkpos_b; };
DI TileInfo tile_info(int tt) {
    TileInfo ti;
    if (tt < 512) { ti.b = tt >> 7; ti.t0 = (tt & 127) * 64; ti.seqrow0 = ti.b * SEQ; ti.len = SEQ; ti.isctx = 0; ti.chunkpos_f = 4 + (tt & 127); ti.chunkpos_b = 4 + 127 - (tt & 127); }
    else { const int j = tt - 512; ti.b = j >> 2; ti.t0 = (j & 3) * 64; ti.seqrow0 = TL + ti.b * CTXL; ti.len = CTXL; ti.isctx = 1; ti.chunkpos_f = (j & 3); ti.chunkpos_b = 3 - (j & 3); }
    ti.row0 = ti.seqrow0 + ti.t0; return ti;
}

typedef short v4i16_t __attribute__((ext_vector_type(4)));
DI int crow(int r, int hi) { return (r & 3) + 8 * (r >> 2) + 4 * hi; }
DI int swz(int row, int col) { return row * 64 + ((((col >> 3) ^ (row & 7)) << 3) | (col & 7)); }
DI s16x4 tr_read(const LAS unsigned short* p) { return __builtin_bit_cast(s16x4, __builtin_amdgcn_ds_read_tr16_b64_v4i16((LAS v4i16_t*)p)); }
#define LGKM0() asm volatile("s_waitcnt lgkmcnt(0)" ::: "memory")
DI void wave_load_tile64(LAS unsigned short* T, const f16* src, int pitch, int lane) {
    const int c = lane & 7;
    unsigned lo = (unsigned)((lane >> 3) * pitch + 8 * c) * 2u;
    asm volatile("" : "+v"(lo));
    const char* base = (const char*)src;
#pragma unroll
    for (int it = 0; it < 8; ++it) { const int row = 8 * it + (lane >> 3); const u32x4 v = *(const u32x4*)(base + (size_t)it * 8 * pitch * 2 + lo); *(LAS u32x4*)(T + row * 64 + ((c ^ (row & 7)) << 3)) = v; }
}
DI s16x8 tr_frag16(const LAS unsigned short* T, int k0, int n0, int lane) {
    const int g = lane >> 4, i = lane & 15, q = i >> 2, pp = i & 3; const int r0 = k0 + 8 * g + q;
    const s16x4 a = tr_read(T + swz(r0, n0 + 4 * pp)), b = tr_read(T + swz(r0 + 4, n0 + 4 * pp));
    return (s16x8){a[0], a[1], a[2], a[3], b[0], b[1], b[2], b[3]};
}

template <int CTRL, int RMASK> DI float dpp_add0(float v) { return __builtin_bit_cast(float, __builtin_amdgcn_update_dpp(0, __builtin_bit_cast(int, v), CTRL, RMASK, 0xf, true)); }
DI float bcast_lane(float v, int srclane) { return __builtin_bit_cast(float, __builtin_amdgcn_readlane(__builtin_bit_cast(int, v), srclane)); }
template <int CTRL, int RMASK> DI float dpp_mul1(float v) { return __builtin_bit_cast(float, __builtin_amdgcn_update_dpp(0x3f800000, __builtin_bit_cast(int, v), CTRL, RMASK, 0xf, false)); }
DI float wave_scan_mul(float v) {
    v *= dpp_mul1<0x111, 0xf>(v); v *= dpp_mul1<0x112, 0xf>(v); v *= dpp_mul1<0x114, 0xf>(v); v *= dpp_mul1<0x118, 0xf>(v);
    v *= dpp_mul1<0x142, 0xa>(v); v *= dpp_mul1<0x143, 0xc>(v);
    return v;
}
#define SCAN8_STEP(ctrl) \
    "v_mul_f32_dpp %0, %0, %0 " ctrl "\n\tv_mul_f32_dpp %1, %1, %1 " ctrl "\n\tv_mul_f32_dpp %2, %2, %2 " ctrl "\n\tv_mul_f32_dpp %3, %3, %3 " ctrl "\n\t" \
    "v_mul_f32_dpp %4, %4, %4 " ctrl "\n\tv_mul_f32_dpp %5, %5, %5 " ctrl "\n\tv_mul_f32_dpp %6, %6, %6 " ctrl "\n\tv_mul_f32_dpp %7, %7, %7 " ctrl "\n\t"
DI void wave_scan_mul8(float (&g)[8]) {
    asm volatile("s_nop 1\n\t"
        SCAN8_STEP("row_shr:1 row_mask:0xf bank_mask:0xf") SCAN8_STEP("row_shr:2 row_mask:0xf bank_mask:0xf") SCAN8_STEP("row_shr:4 row_mask:0xf bank_mask:0xf")
        SCAN8_STEP("row_shr:8 row_mask:0xf bank_mask:0xf") SCAN8_STEP("row_bcast:15 row_mask:0xa bank_mask:0xf") SCAN8_STEP("row_bcast:31 row_mask:0xc bank_mask:0xf")
        "s_nop 1"
        : "+v"(g[0]), "+v"(g[1]), "+v"(g[2]), "+v"(g[3]), "+v"(g[4]), "+v"(g[5]), "+v"(g[6]), "+v"(g[7]));
}
DI void hgrn_state_wave(const Params& p, int l, int item, LAS unsigned short* wl, int lane) {
    const int dir = item & 1, h = (item >> 1) & 3; const TileInfo ti = tile_info(item >> 3);
    const f16* P = (const f16*)(p.ws + WS_P); float* HS = (float*)(p.ws + WS_HS); float* HA = (float*)(p.ws + WS_HA);
    LAS unsigned short* Z = wl; LAS unsigned short* V = wl + 4096;
    const f16* prow = P + (size_t)ti.row0 * INC + h * 64;
    wave_load_tile64(Z, prow + (dir ? C_HZB : C_HZF), INC, lane); wave_load_tile64(V, prow + C_HI, INC, lane);
    const float* lbp = (const float*)(p.ws + WS_LB) + l * 512 + dir * 256 + h * 64;
    const int pos = dir ? ti.chunkpos_b : ti.chunkpos_f; const size_t slot = (size_t)((dir * NB + ti.b) * NPOS + pos) * 4 + h;
    float amine = 0.f;
    const int s_ = dir ? 63 - lane : lane;
    LGKM0();
#pragma unroll 1
    for (int c = 0; c < 8; ++c) { float g[8], kk[8]; LAS f16x8* zp = (LAS f16x8*)(Z + s_ * 64 + ((c ^ (s_ & 7)) << 3)); const f16x8 zv = *zp;
#pragma unroll
        for (int j = 0; j < 8; ++j) { const float lb = lbp[8 * c + j]; const float z = (float)zv[j]; const float sg = fast_rcp(1.f + __expf(-z)); g[j] = lb + (1.f - lb) * sg; kk[j] = (1.f - lb) * (1.f - sg); }
        wave_scan_mul8(g);
#pragma unroll
        for (int j = 0; j < 8; ++j) g[j] = fmaxf(g[j], 1e-37f);
        f16x8 ko;
#pragma unroll
        for (int j = 0; j < 8; ++j) { const float pend = bcast_lane(g[j], 63); ko[j] = (f16)(kk[j] * pend * fast_rcp(g[j])); amine = (lane == 8 * c + j) ? pend : amine; }
        *zp = ko; }
    HA[slot * 64 + lane] = amine;
    LGKM0();
    f32x4 acc[4][4];
#pragma unroll
    for (int m = 0; m < 4; ++m)
#pragma unroll
        for (int n = 0; n < 4; ++n) acc[m][n] = (f32x4){0.f, 0.f, 0.f, 0.f};
#pragma unroll
    for (int ks = 0; ks < 2; ++ks) { s16x8 a[4], b[4];
#pragma unroll
        for (int m = 0; m < 4; ++m) { a[m] = tr_frag16(V, 32 * ks, 16 * m, lane); b[m] = tr_frag16(Z, 32 * ks, 16 * m, lane); }
#pragma unroll
        for (int m = 0; m < 4; ++m)
#pragma unroll
            for (int n = 0; n < 4; ++n) acc[m][n] = mma_f16(__builtin_bit_cast(f16x8, a[m]), __builtin_bit_cast(f16x8, b[n]), acc[m][n]); }
    float* dst = HS + slot * 4096; const int fr = lane & 15, fq = lane >> 4;
#pragma unroll
    for (int m = 0; m < 4; ++m)
#pragma unroll
        for (int n = 0; n < 4; ++n)
#pragma unroll
            for (int i = 0; i < 4; ++i) dst[(16 * m + 4 * fq + i) * 64 + 16 * n + fr] = acc[m][n][i];
    LGKM0();
}

DI void qk_wave(const Params& p, int l, int pair8, int lane) {
    const f16* P = (const f16*)(p.ws + WS_P); f16* QN = (f16*)(p.ws + WS_QN); f16* KN = (f16*)(p.ws + WS_KN); const float* RT = (const float*)(p.ws + WS_ROPE);
    const int j8 = lane & 7; const int pidx = pair8 * 8 + (lane >> 3); const int row = pidx / 10, hh = pidx % 10;
    const f16x8 raw = *(const f16x8*)(P + (size_t)row * INC + C_Q + hh * 64 + 8 * j8);
    const bool lat = row < TL; const int t = lat ? (row & (SEQ - 1)) : 0; const int prow = t >> 6, pcol = t & 63; const int a0 = (8 * j8) & 31;
    const float* ct = (a0 < 16) ? RT + prow * 16 + a0 : RT + 4096 + pcol * 16 + (a0 - 16);
    const float* st = (a0 < 16) ? RT + 2048 + prow * 16 + a0 : RT + 4096 + 1024 + pcol * 16 + (a0 - 16);
    const float* gn = (hh < 8 ? p.q_norm_g : p.k_norm_g) + l * 64 + 8 * j8;
    const f32x4 c0 = *(const f32x4*)ct, c1 = *(const f32x4*)(ct + 4), s0 = *(const f32x4*)st, s1 = *(const f32x4*)(st + 4), g0 = *(const f32x4*)gn, g1 = *(const f32x4*)(gn + 4);
    float v[8]; float s = 0.f;
#pragma unroll
    for (int i = 0; i < 8; ++i) { v[i] = (float)raw[i]; s += v[i] * v[i]; }
    s += __shfl_xor(s, 1); s += __shfl_xor(s, 2); s += __shfl_xor(s, 4);
    const float r = __builtin_amdgcn_rsqf(s * (1.f / 64.f) + EPS) * ((hh < 8) ? 0.125f * LOG2E : 1.f);
    const float sgn = (j8 < 4) ? -1.f : 1.f;
    f16x8 o;
#pragma unroll
    for (int i = 0; i < 8; ++i) { const float gi = (i < 4) ? g0[i & 3] : g1[i & 3]; const float ci = lat ? ((i < 4) ? c0[i & 3] : c1[i & 3]) : 1.f, si = lat ? ((i < 4) ? s0[i & 3] : s1[i & 3]) * sgn : 0.f;
        v[i] = v[i] * r * gi; const float ot = __shfl_xor(v[i], 4); o[i] = (f16)(v[i] * ci + ot * si); }
    if (hh < 8) *(f16x8*)(QN + (size_t)row * 512 + hh * 64 + 8 * j8) = o; else *(f16x8*)(KN + (size_t)row * 128 + (hh - 8) * 64 + 8 * j8) = o;
}

DI void pool_wave(const Params& p, int l, int item, LAS unsigned short* wl, int lane) {
    const int g = item & 3; const TileInfo ti = tile_info(item >> 2); const int w = 2 << g;
    const f16* P = (const f16*)(p.ws + WS_P); f16* MIX = (f16*)(p.ws + WS_MIX); const f16* PW = (const f16*)(p.ws + WS_POOLW) + ((size_t)l * 4 + g) * 4096;
    { const int c = lane & 7;
#pragma unroll
      for (int it = 0; it < 10; ++it) { const int row = 8 * it + (lane >> 3); const int t = ti.t0 - 8 + row; u32x4 v = (u32x4){0u, 0u, 0u, 0u};
          if (t >= 0 && t < ti.len) v = *(const u32x4*)(P + (size_t)(ti.seqrow0 + t) * INC + C_U + g * 64 + 8 * c);
          *(LAS u32x4*)(wl + row * 64 + ((c ^ (row & 7)) << 3)) = v; } }
    LGKM0();
    const int fr = lane & 15, fq = lane >> 4;
    f32x4 acc[4][4];
#pragma unroll
    for (int m = 0; m < 4; ++m)
#pragma unroll
        for (int n = 0; n < 4; ++n) acc[m][n] = (f32x4){0.f, 0.f, 0.f, 0.f};
#pragma unroll
    for (int ks = 0; ks < 2; ++ks) { f16x8 bfr[4];
#pragma unroll
        for (int n = 0; n < 4; ++n) bfr[n] = *(const f16x8*)(PW + (n * 16 + fr) * 64 + 32 * ks + 8 * fq);
#pragma unroll
        for (int m = 0; m < 4; ++m) { const int tk = 16 * m + fr, t = ti.t0 + tk; const int ch = 4 * ks + fq;
            float sum[8] = {0.f, 0.f, 0.f, 0.f, 0.f, 0.f, 0.f, 0.f}; int cnt = 0;
            for (int off = -((w - 1) / 2); off <= w / 2; ++off) { const int q = t + off; const int row = tk + off + 8;
                const f16x8 v = *(const LAS f16x8*)(wl + row * 64 + ((ch ^ (row & 7)) << 3)); const bool ok = (q >= 0 && q < ti.len); cnt += ok ? 1 : 0;
#pragma unroll
                for (int i = 0; i < 8; ++i) sum[i] += (float)v[i]; }
            const int row = tk + 8; const f16x8 cv = *(const LAS f16x8*)(wl + row * 64 + ((ch ^ (row & 7)) << 3)); const float ic = 1.f / (float)cnt;
            f16x8 a;
#pragma unroll
            for (int i = 0; i < 8; ++i) a[i] = (f16)(sum[i] * ic - (float)cv[i]);
#pragma unroll
            for (int n = 0; n < 4; ++n) acc[m][n] = mma_f16(a, bfr[n], acc[m][n]); } }
#pragma unroll
    for (int n = 0; n < 4; ++n) { const int d = g * 64 + n * 16 + fr; const float ps = p.pool_scale[l * 256 + d];
#pragma unroll
        for (int m = 0; m < 4; ++m)
#pragma unroll
            for (int i = 0; i < 4; ++i) MIX[(size_t)(ti.row0 + 16 * m + 4 * fq + i) * DM + d] = (f16)(acc[m][n][i] * ps); }
    LGKM0();
}

DI void qs_wave(const Params& p, int item, int lane) {
    const int h = item & 3; const TileInfo ti = tile_info(item >> 2);
    const f16* prow = (const f16*)(p.ws + WS_P) + (size_t)ti.row0 * INC + C_HQ + h * 64; f16* QS = (f16*)(p.ws + WS_QS) + (size_t)ti.row0 * 256 + h * 64; const int c = lane & 7;
    f16x8 qv[8];
#pragma unroll
    for (int it = 0; it < 8; ++it) qv[it] = *(const f16x8*)(prow + (size_t)(8 * it + (lane >> 3)) * INC + 8 * c);
#pragma unroll
    for (int it = 0; it < 8; ++it) { f16x8 o;
#pragma unroll
        for (int j = 0; j < 8; ++j) o[j] = (f16)siluf((float)qv[it][j]);
        *(f16x8*)(QS + (size_t)(8 * it + (lane >> 3)) * 256 + 8 * c) = o; }
}

DI void phase_prep_w(const Params& p, int l, ldsp lds, int lane, int wave, int vcu, int G) {
    LAS unsigned short* wl = (LAS unsigned short*)(lds + wave * 16384);
    LAS unsigned* ctr = (LAS unsigned*)(lds + MISC_OFF) + 20;
    __syncthreads();
    if (threadIdx.x < 4) ctr[threadIdx.x] = 0u;
    __syncthreads();
    const int nH = (528 * 8 - vcu + G - 1) / G, nP = (528 * 4 - vcu + G - 1) / G;
    const int nQ8 = TT * 10 / 8; const int nQ = (nQ8 - vcu + G - 1) / G; const int nQc = (nQ + 4) / 5;
#define PULL(k) ({ unsigned t_ = 0; if (lane == 0) t_ = __hip_atomic_fetch_add(ctr + (k), 1u, __ATOMIC_RELAXED, __HIP_MEMORY_SCOPE_WORKGROUP); __builtin_amdgcn_readfirstlane((int)t_); })
    for (int idx = PULL(0); idx < nH; idx = PULL(0)) hgrn_state_wave(p, l, vcu + idx * G, wl, lane);
    for (int idx = PULL(1); idx < nP; idx = PULL(1)) pool_wave(p, l, vcu + idx * G, wl, lane);
    for (int idx = PULL(3); idx < nP; idx = PULL(3)) qs_wave(p, vcu + idx * G, lane);
    for (int idx = PULL(2); idx < nQc; idx = PULL(2)) { const int c0 = idx * 5;
#pragma unroll
        for (int k = c0; k < c0 + 5; ++k) qk_wave(p, l, vcu + (k < nQ ? k : nQ - 1) * G, lane); }
#undef PULL
}

DI void hgrn_out_wave(const Params& p, int l, int item, LAS unsigned short* wl, LAS float* wx, int lane) {
    const int h = item & 3; const TileInfo ti = tile_info(item >> 2);
    const f16* P = (const f16*)(p.ws + WS_P); const unsigned short* HS = (const unsigned short*)(p.ws + WS_HSB); f16* MIX = (f16*)(p.ws + WS_MIX);
    LAS unsigned short* BA = wl; LAS unsigned short* BB = wl + 4096;
    const f16* prow = P + (size_t)ti.row0 * INC + h * 64;
    const int r32 = lane & 31, hi = lane >> 5;
    f32x16 o[2][2];
#pragma unroll
    for (int a = 0; a < 2; ++a)
#pragma unroll
        for (int b = 0; b < 2; ++b)
#pragma unroll
            for (int r = 0; r < 16; ++r) o[a][b][r] = 0.f;
#pragma unroll 1
    for (int dir = 0; dir < 2; ++dir) {
        wave_load_tile64(BA, prow + (dir ? C_HZB : C_HZF), INC, lane); wave_load_tile64(BB, (const f16*)(p.ws + WS_QS) + (size_t)ti.row0 * 256 + h * 64, 256, lane);
        u32x4 vreg[8], sreg[8];
        { const int pos = dir ? ti.chunkpos_b : ti.chunkpos_f; const char* hs = (const char*)(HS + ((size_t)((dir * NB + ti.b) * NPOS + pos) * 4 + h) * 4096); const char* vb = (const char*)(prow + C_HI);
          unsigned lov = (unsigned)((lane >> 3) * INC + 8 * (lane & 7)) * 2u, los = (unsigned)((lane >> 3) * 64 + 8 * (lane & 7)) * 2u; asm volatile("" : "+v"(lov), "+v"(los));
#pragma unroll
          for (int it = 0; it < 8; ++it) { vreg[it] = *(const u32x4*)(vb + (size_t)it * 8 * INC * 2 + lov); sreg[it] = *(const u32x4*)(hs + (size_t)it * 8 * 64 * 2 + los); } }
        const float* lbp = (const float*)(p.ws + WS_LB) + l * 512 + dir * 256 + h * 64;
        float er_mine = 0.f;
        LGKM0();
        const int s_ = dir ? 63 - lane : lane;
#pragma unroll 1
        for (int c = 0; c < 8; ++c) { float g[8], kk[8]; LAS f16x8* zp = (LAS f16x8*)(BA + s_ * 64 + ((c ^ (s_ & 7)) << 3)); LAS f16x8* qp = (LAS f16x8*)(BB + s_ * 64 + ((c ^ (s_ & 7)) << 3));
            const f16x8 zv = *zp, qv = *qp;
#pragma unroll
            for (int j = 0; j < 8; ++j) { const float lb = lbp[8 * c + j]; const float z = (float)zv[j]; const float sg = fast_rcp(1.f + __expf(-z)); g[j] = lb + (1.f - lb) * sg; kk[j] = (1.f - lb) * (1.f - sg); }
            wave_scan_mul8(g);
#pragma unroll
            for (int j = 0; j < 8; ++j) g[j] = fmaxf(g[j], 1e-37f);
            float kf_[8], qf_[8];
#pragma unroll
            for (int j = 0; j < 8; ++j) { const float r = fast_rcp(g[j]); const float pref = bcast_lane(g[j], 31), rpref = bcast_lane(r, 31);
                kf_[j] = kk[j] * pref * r; qf_[j] = (float)qv[j] * g[j] * rpref; er_mine = (lane == 8 * c + j) ? pref : er_mine; }
            u32x4 ko, qo;
#pragma unroll
            for (int j = 0; j < 4; ++j) { ko[j] = cvt_pk_bf16(kf_[2 * j], kf_[2 * j + 1]); qo[j] = cvt_pk_bf16(qf_[2 * j], qf_[2 * j + 1]); }
            *(LAS u32x4*)zp = ko; *(LAS u32x4*)qp = qo; }
        wx[lane] = er_mine;
        LGKM0();
        s16x8 qf[2][4];
#pragma unroll
        for (int b = 0; b < 2; ++b)
#pragma unroll
            for (int d0 = 0; d0 < 4; ++d0) { const int row = 32 * b + r32, ch = 2 * d0 + hi; qf[b][d0] = *(const LAS s16x8*)(BB + row * 64 + ((ch ^ (row & 7)) << 3)); }
        LGKM0();
        { const int c = lane & 7;
#pragma unroll
          for (int it = 0; it < 8; ++it) { const int row = 8 * it + (lane >> 3); *(LAS u32x4*)(BB + row * 64 + ((c ^ (row & 7)) << 3)) = vreg[it]; } }
        LGKM0();
#pragma unroll
        for (int tb = 0; tb < 2; ++tb)
#pragma unroll
            for (int sb = 0; sb < 2; ++sb) {
                const bool diag = (sb == tb); const bool full = dir ? (sb > tb) : (sb < tb);
                if (!diag && !full) continue;
                f32x16 pt;
#pragma unroll
                for (int r = 0; r < 16; ++r) pt[r] = 0.f;
#pragma unroll
                for (int d0 = 0; d0 < 4; ++d0) { const int row = 32 * sb + r32, ch = 2 * d0 + hi; const s16x8 kf = *(const LAS s16x8*)(BA + row * 64 + ((ch ^ (row & 7)) << 3));
                    pt = __builtin_amdgcn_mfma_f32_32x32x16_bf16(kf, qf[tb][d0], pt, 0, 0, 0); }
                if (diag) {
#pragma unroll
                    for (int r = 0; r < 16; ++r) { const int sl = crow(r, hi); const bool keep = dir ? (sl >= r32) : (sl <= r32); pt[r] = keep ? pt[r] : 0.f; } }
                f16x8 pw[2];
#pragma unroll
                for (int j = 0; j < 8; ++j) { pw[0][j] = (f16)pt[j]; pw[1][j] = (f16)pt[8 + j]; }
#pragma unroll
                for (int dvb = 0; dvb < 2; ++dvb)
#pragma unroll
                    for (int ss = 0; ss < 2; ++ss) { const int i16 = lane & 15, g1 = (lane >> 4) & 1; const int r0 = 32 * sb + 16 * ss + 4 * hi + (i16 >> 2), c0 = 32 * dvb + 16 * g1 + 4 * (i16 & 3);
                        const s16x4 a = tr_read(BB + swz(r0, c0)), b = tr_read(BB + swz(r0 + 8, c0));
                        const s16x8 vf = (s16x8){a[0], a[1], a[2], a[3], b[0], b[1], b[2], b[3]};
                        o[dvb][tb] = __builtin_amdgcn_mfma_f32_32x32x16_f16(__builtin_bit_cast(f16x8, vf), pw[ss], o[dvb][tb], 0, 0, 0); }
            }
        LGKM0();
        { const int c8 = lane & 7; const f32x4 er0 = *(const LAS f32x4*)(wx + 8 * c8), er1 = *(const LAS f32x4*)(wx + 8 * c8 + 4);
#pragma unroll
          for (int it = 0; it < 8; ++it) { const int row = 8 * it + (lane >> 3); const u32x4 sv = sreg[it];
              u32x4 w4;
#pragma unroll
              for (int q = 0; q < 4; ++q) { const float lo = __builtin_bit_cast(float, sv[q] << 16), hi2 = __builtin_bit_cast(float, sv[q] & 0xffff0000u);
                  const float e0 = (q < 2) ? er0[2 * q] : er1[2 * q - 4], e1 = (q < 2) ? er0[2 * q + 1] : er1[2 * q - 3]; w4[q] = cvt_pk_bf16(lo * e0, hi2 * e1); }
              *(LAS u32x4*)(BA + row * 64 + ((c8 ^ (row & 7)) << 3)) = w4; } }
        LGKM0();
#pragma unroll
        for (int dvb = 0; dvb < 2; ++dvb)
#pragma unroll
            for (int d0 = 0; d0 < 4; ++d0) { const int row = 32 * dvb + r32, ch = 2 * d0 + hi; const s16x8 sf = *(const LAS s16x8*)(BA + row * 64 + ((ch ^ (row & 7)) << 3));
#pragma unroll
                for (int tb = 0; tb < 2; ++tb) o[dvb][tb] = __builtin_amdgcn_mfma_f32_32x32x16_bf16(sf, qf[tb][d0], o[dvb][tb], 0, 0, 0); }
        LGKM0();
    }
    const float* gn = p.hgrn_norm_g + l * 64;
#pragma unroll
    for (int tb = 0; tb < 2; ++tb) { float ss = 0.f;
#pragma unroll
        for (int dvb = 0; dvb < 2; ++dvb)
#pragma unroll
            for (int r = 0; r < 16; ++r) ss += o[dvb][tb][r] * o[dvb][tb][r];
        ss += __shfl_xor(ss, 32); const float rn = __builtin_amdgcn_rsqf(ss * (1.f / 64.f) + EPS);
        const size_t row = (size_t)ti.row0 + 32 * tb + r32;
#pragma unroll
        for (int dvb = 0; dvb < 2; ++dvb)
#pragma unroll
            for (int g4 = 0; g4 < 4; ++g4) { const int dv0 = 32 * dvb + 8 * g4 + 4 * hi; const f16x4 gt = *(const f16x4*)(P + row * INC + C_HG + h * 64 + dv0); const f32x4 gg = *(const f32x4*)(gn + dv0);
                f16x4 ov;
#pragma unroll
                for (int i = 0; i < 4; ++i) ov[i] = (f16)(o[dvb][tb][4 * g4 + i] * rn * gg[i] * siluf((float)gt[i]));
                *(f16x4*)(MIX + row * DM + 768 + h * 64 + dv0) = ov; } }
}
DI void phase_hgrn_out_w(const Params& p, int l, ldsp lds, int lane, int wave, int vcu, int G) {
    LAS unsigned short* wl = (LAS unsigned short*)(lds + wave * 16384); LAS float* wx = (LAS float*)(lds + BLK_OFF + 1024 + wave * 512);
    const int gw = vcu * 8 + wave, NGW = G * 8;
    const int nit = (l == DEPTH - 1) ? 512 * 4 : 528 * 4;
    for (int it = gw; it < nit; it += NGW) hgrn_out_wave(p, l, it, wl, wx, lane);
}

DI void phase_scan(const Params& p, int tid, int vcu, int G, int dry) {
    const float* HS = (const float*)(p.ws + WS_HS); const float* HA = (const float*)(p.ws + WS_HA); unsigned short* HSB = (unsigned short*)(p.ws + (dry ? WS_DUMMY : WS_HSB));
    for (int gid = vcu * 512 + tid; gid < 2 * NB * 4 * 4096; gid += G * 512) {
        const int el = gid & 4095, h = (gid >> 12) & 3, db = gid >> 14;
        const size_t hoff = ((size_t)db * NPOS * 4 + h) * 4096 + el; const float* hs = HS + hoff; unsigned short* hso = HSB + hoff; const float* ha = HA + ((size_t)db * NPOS * 4 + h) * 64 + (el & 63);
        float S = 0.f;
        for (int pos = 0; pos < NPOS; pos += 12) { float u[12], a[12];
#pragma unroll
            for (int j = 0; j < 12; ++j) { u[j] = hs[(size_t)(pos + j) * 4 * 4096]; a[j] = ha[(size_t)(pos + j) * 4 * 64]; }
#pragma unroll
            for (int j = 0; j < 12; ++j) { hso[(size_t)(pos + j) * 4 * 4096] = f2bf(S); S = a[j] * S + u[j]; } }
    }
}

DI void attn_item(const Params& p, int l, int idx, ldsp lds, int tid, int lane, int wave) {
    const f16* P = (const f16*)(p.ws + WS_P); const f16* QN = (const f16*)(p.ws + WS_QN); const f16* KN = (const f16*)(p.ws + WS_KN); f16* MIX = (f16*)(p.ws + WS_MIX);
    int b, kvh, qb, isctx;
    if (idx < 1024) { b = idx >> 8; kvh = (idx >> 7) & 1; qb = idx & 127; isctx = 0; } else { const int j = idx - 1024; b = j >> 3; kvh = (j >> 2) & 1; qb = j & 3; isctx = 1; }
    const int q0 = qb * 64; const int qrowbase = isctx ? TL + b * CTXL : b * SEQ;
    const int r32 = lane & 31, hi = lane >> 5; const int hq = kvh * 4 + (wave >> 1); const int qpos = q0 + (wave & 1) * 32 + r32; const size_t qrow = (size_t)qrowbase + qpos;
    LAS f16* KB = (LAS f16*)lds;
    LAS f16* VTB = KB + 2 * 64 * TP;
    f16x8 qr[4];
#pragma unroll
    for (int d0 = 0; d0 < 4; ++d0) qr[d0] = *(const f16x8*)(QN + qrow * 512 + hq * 64 + 16 * d0 + 8 * hi);
    float m = p.attn_sink[l * 8 + hq] * LOG2E, lsum = hi ? 0.f : 1.f;
    f32x16 o[2];
#pragma unroll
    for (int r = 0; r < 16; ++r) { o[0][r] = 0.f; o[1][r] = 0.f; }
    const int srow = tid >> 3, sc8 = tid & 7;
    const int ntile = isctx ? 4 : 9;
    int cur = 0; bool have = false; f16x8 kreg, vreg;
    int tix = 0;
#define TILE_VALID(t) (isctx || (t) >= 5 || ((q0 - 128 + 64 * (t)) >= 0 && (q0 - 128 + 64 * (t)) < SEQ))
#define TILE_ROW(t) ((isctx || (t) >= 5) ? (TL + b * CTXL + 64 * (isctx ? (t) : (t) - 5)) : (b * SEQ + q0 - 128 + 64 * (t)))
    while (tix < ntile && !TILE_VALID(tix)) ++tix;
    { const size_t kr = (size_t)TILE_ROW(tix) + srow; kreg = *(const f16x8*)(KN + kr * 128 + kvh * 64 + 8 * sc8); vreg = *(const f16x8*)(P + kr * INC + C_V + kvh * 64 + 8 * sc8); }
    __syncthreads();
    { *(LAS f16x8*)(KB + srow * TP + 8 * sc8) = kreg;
#pragma unroll
      for (int i = 0; i < 8; ++i) VTB[(8 * sc8 + i) * TP + srow] = vreg[i]; }
    __syncthreads();
    while (tix < ntile) {
        int nx = tix + 1; while (nx < ntile && !TILE_VALID(nx)) ++nx;
        have = nx < ntile;
        if (have) { const size_t kr = (size_t)TILE_ROW(nx) + srow; kreg = *(const f16x8*)(KN + kr * 128 + kvh * 64 + 8 * sc8); vreg = *(const f16x8*)(P + kr * INC + C_V + kvh * 64 + 8 * sc8); }
        const LAS f16* Kc = KB + cur * 64 * TP; const LAS f16* Vc = VTB + cur * 64 * TP;
        f32x16 p0, p1;
#pragma unroll
        for (int r = 0; r < 16; ++r) { p0[r] = -m; p1[r] = -m; }
#pragma unroll
        for (int d0 = 0; d0 < 4; ++d0) { const f16x8 k0 = *(const LAS f16x8*)(Kc + r32 * TP + 16 * d0 + 8 * hi); const f16x8 k1 = *(const LAS f16x8*)(Kc + (32 + r32) * TP + 16 * d0 + 8 * hi);
            p0 = __builtin_amdgcn_mfma_f32_32x32x16_f16(k0, qr[d0], p0, 0, 0, 0); p1 = __builtin_amdgcn_mfma_f32_32x32x16_f16(k1, qr[d0], p1, 0, 0, 0); }
        if (!isctx && (tix == 0 || tix == 4)) { const int kstart = q0 - 128 + 64 * tix;
#pragma unroll
            for (int r = 0; r < 16; ++r) { const int d0_ = qpos - (kstart + crow(r, hi)); if (d0_ > 128 || d0_ < -128) p0[r] = -INFINITY; const int d1_ = d0_ - 32; if (d1_ > 128 || d1_ < -128) p1[r] = -INFINITY; } }
        float mx = fmaxf(p0[0], p1[0]);
#pragma unroll
        for (int r = 1; r < 16; ++r) mx = fmaxf(mx, fmaxf(p0[r], p1[r]));
        mx = fmaxf(mx, __shfl_xor(mx, 32));
        if (__any(mx > 4.f)) {
            const float dl = fmaxf(mx, 0.f); const float f = __builtin_amdgcn_exp2f(-dl); m += dl; lsum *= f;
#pragma unroll
            for (int r = 0; r < 16; ++r) { o[0][r] *= f; o[1][r] *= f; p0[r] -= dl; p1[r] -= dl; } }
        float ps = 0.f;
#pragma unroll
        for (int r = 0; r < 16; ++r) { p0[r] = __builtin_amdgcn_exp2f(p0[r]); p1[r] = __builtin_amdgcn_exp2f(p1[r]); ps += p0[r] + p1[r]; }
        lsum += ps;
        f16x8 pw[4];
#pragma unroll
        for (int j = 0; j < 8; ++j) { pw[0][j] = (f16)p0[j]; pw[1][j] = (f16)p0[8 + j]; pw[2][j] = (f16)p1[j]; pw[3][j] = (f16)p1[8 + j]; }
#pragma unroll
        for (int d1 = 0; d1 < 2; ++d1)
#pragma unroll
            for (int s = 0; s < 4; ++s) { const LAS f16* vp = Vc + (32 * d1 + r32) * TP + 16 * s + 4 * hi; const f16x4 lo = *(const LAS f16x4*)vp, hv = *(const LAS f16x4*)(vp + 8);
                const f16x8 vf = (f16x8){lo[0], lo[1], lo[2], lo[3], hv[0], hv[1], hv[2], hv[3]};
                o[d1] = __builtin_amdgcn_mfma_f32_32x32x16_f16(vf, pw[s], o[d1], 0, 0, 0); }
        if (have) { LAS f16* Kn = KB + (cur ^ 1) * 64 * TP; LAS f16* Vn = VTB + (cur ^ 1) * 64 * TP;
            *(LAS f16x8*)(Kn + srow * TP + 8 * sc8) = kreg;
#pragma unroll
            for (int i = 0; i < 8; ++i) Vn[(8 * sc8 + i) * TP + srow] = vreg[i]; }
        __syncthreads();
        cur ^= 1; tix = nx;
    }
#undef TILE_VALID
#undef TILE_ROW
    const float lt = lsum + __shfl_xor(lsum, 32); const float il = 1.f / lt;
    f16* orow = MIX + qrow * DM + 256 + hq * 64;
#pragma unroll
    for (int d1 = 0; d1 < 2; ++d1)
#pragma unroll
        for (int g = 0; g < 4; ++g) { f16x4 v;
#pragma unroll
            for (int i = 0; i < 4; ++i) v[i] = (f16)(o[d1][4 * g + i] * il);
            *(f16x4*)(orow + 32 * d1 + 8 * g + 4 * hi) = v; }
}
DI void phase_attn(const Params& p, int l, ldsp lds, int tid, int lane, int wave, int vcu, int G, int rep) {
    unsigned* qc = (unsigned*)(p.ws + WS_CTL) + CW_QUEUE + (l * 2 + rep) * 64; volatile LAS unsigned* slot = (volatile LAS unsigned*)(lds + MISC_OFF) + 16;
    const int nitems = (l == DEPTH - 1) ? 1024 : 1056;
    __syncthreads();
    if (tid == 0) slot[0] = atomicAdd(qc, 1u);
    __syncthreads();
    unsigned it = slot[0];
    while (it < (unsigned)nitems) {
        __syncthreads();
        if (tid == 0) slot[0] = atomicAdd(qc, 1u);
        attn_item(p, l, (int)it, lds, tid, lane, wave);
        __syncthreads();
        it = slot[0];
    }
    __syncthreads();
}

DI void phase_outproj_ctx(const Params& p, int l, int lane, int wave, int vcu, int G, int dry) {
    const f16* MIX = (const f16*)(p.ws + WS_MIX) + (size_t)TL * DM; const f16* W = (const f16*)(p.ws + WS_WOUT) + (size_t)l * DM * DM;
    f16* xd = (f16*)(p.ws + (dry ? WS_DUMMY + 136 * MiB : WS_DELTA)) + (dry ? 0 : (size_t)TL * DM);
    const float* g1 = (const float*)(p.ws + WS_MOD) + ((size_t)l * 5 + 4) * 6144 + 2 * 1024;
    const int fr = lane & 15, fq = lane >> 4;
    for (int it = vcu; it < 256; it += G) { const int r0 = (it >> 4) * 64 + 16 * (wave & 3), c0 = (it & 15) * 64 + 32 * (wave >> 2);
        f32x4 acc[2] = {(f32x4){0.f, 0.f, 0.f, 0.f}, (f32x4){0.f, 0.f, 0.f, 0.f}};
        const f16* ap = MIX + (size_t)(r0 + fr) * DM + 8 * fq; const f16* bp = W + (size_t)(c0 + fr) * DM + 8 * fq;
#pragma unroll 8
        for (int ks = 0; ks < 32; ++ks) { const f16x8 a = *(const f16x8*)(ap + 32 * ks); const f16x8 b0 = *(const f16x8*)(bp + 32 * ks), b1 = *(const f16x8*)(bp + 16 * DM + 32 * ks);
            acc[0] = mma_f16(a, b0, acc[0]); acc[1] = mma_f16(a, b1, acc[1]); }
#pragma unroll
        for (int n = 0; n < 2; ++n) { const int col = c0 + 16 * n + fr; const float gv = g1[col];
#pragma unroll
            for (int i = 0; i < 4; ++i) xd[(size_t)(r0 + 4 * fq + i) * DM + col] = (f16)(gv * acc[n][i]); } }
}

DI void phase_router(const Params& p, int l, ldsp lds, int tid, int lane, int wave, int vcu, int G, int dry) {
    const float* MOD = (const float*)(p.ws + WS_MOD); f16* H = (f16*)(p.ws + (dry ? WS_DUMMY : WS_H)); const float* XC = (const float*)(p.ws + WS_XC); const f16* WRH = (const f16*)(p.ws + WS_WR) + (size_t)l * 48 * 1024; const f16* WRL = WRH + (size_t)DEPTH * 48 * 1024;
    int* SLOT = (int*)(p.ws + (dry ? WS_DUMMY + 88 * MiB : WS_SLOT)); float* GT = (float*)(p.ws + (dry ? WS_DUMMY + 80 * MiB : WS_GATES)); int* LIST = (int*)(p.ws + (dry ? WS_DUMMY + 96 * MiB : WS_LIST)); unsigned* CNT = (unsigned*)(p.ws + WS_CTL) + CW_CNT + l * 32 * 16 + (dry ? 4096 : 0);
    constexpr int XP = 1028;
    LAS float* XT = (LAS float*)lds;
    LAS float* PART = XT + 16 * XP;
    LAS float* LG = PART + 8 * 16 * 48;
    const int fr = lane & 15, fq = lane >> 4;
    f16x8 wh[4][3], wl_[4][3];
#pragma unroll
    for (int ks = 0; ks < 4; ++ks)
#pragma unroll
        for (int n = 0; n < 3; ++n) { const size_t o = (size_t)(16 * n + fr) * 1024 + wave * 128 + 32 * ks + 8 * fq; wh[ks][n] = *(const f16x8*)(WRH + o); wl_[ks][n] = *(const f16x8*)(WRL + o); }
    const int ntiles = (l == DEPTH - 1 ? TL : TT) / 16;
    LAS int* SEL = (LAS int*)(LG + 16 * 48);
    LAS int* BASE = SEL + 64;
    f32x4 v[2][4];
    const float* xsl = (l == 0) ? p.x : p.out; const float* xsc = (l == 0) ? p.ctx : XC; const f16* DL = (const f16*)(p.ws + WS_DELTA);
    float* xwl = dry ? (float*)(p.ws + WS_DUMMY + 8 * MiB) : p.out; float* xwc = dry ? (float*)(p.ws + WS_DUMMY + 8 * MiB) : (float*)(p.ws + WS_XC);
    f16x4 dv[2][4];
#define RT_LOAD(tile_) do { _Pragma("unroll") for (int q = 0; q < 2; ++q) { const int row = (tile_) * 16 + wave + 8 * q; const float* xr_ = (row < TL) ? xsl + (size_t)row * DM : xsc + (size_t)(row - TL) * DM; \
        _Pragma("unroll") for (int j = 0; j < 4; ++j) { v[q][j] = *(const f32x4*)(xr_ + 256 * j + 4 * lane); dv[q][j] = *(const f16x4*)(DL + (size_t)row * DM + 256 * j + 4 * lane); } } } while (0)
#define RT_FLUSH(buf_, row0_) do { if (tid < 32) { const int e = SEL[(buf_) * 32 + tid]; int rank = 0; \
        _Pragma("unroll") for (int j = 0; j < 32; ++j) rank += (j < tid && SEL[(buf_) * 32 + j] == e) ? 1 : 0; \
        const int pos_ = BASE[(buf_) * 32 + e] + rank; const int ent_ = ((row0_) + (tid >> 1)) * 2 + (tid & 1); LIST[(size_t)e * TT + pos_] = ent_; SLOT[ent_] = (e << 20) | pos_; } } while (0)
    int tile = vcu; int cur = 0; int prev_row0 = -1; unsigned pend = 0u; bool pend_valid = false;
    if (tile < ntiles) RT_LOAD(tile);
    for (; tile < ntiles; tile += G, cur ^= 1) {
        const int row0 = tile * 16;
        { float ssum[2];
#pragma unroll
          for (int q = 0; q < 2; ++q) { float s = 0.f; const int row = row0 + wave + 8 * q; float* xw_ = (row < TL) ? xwl + (size_t)(dry ? (row & 1023) : row) * DM : xwc + (size_t)(row - TL) * DM;
#pragma unroll
              for (int j = 0; j < 4; ++j) {
#pragma unroll
                  for (int i = 0; i < 4; ++i) v[q][j][i] += (float)dv[q][j][i];
                  s += v[q][j][0] * v[q][j][0] + v[q][j][1] * v[q][j][1] + v[q][j][2] * v[q][j][2] + v[q][j][3] * v[q][j][3]; }
              ssum[q] = s; }
#pragma unroll
          for (int o = 1; o < 64; o <<= 1) { ssum[0] += __shfl_xor(ssum[0], o); ssum[1] += __shfl_xor(ssum[1], o); }
          const int b = modb_of_row(row0); const float* m2 = MOD + ((size_t)l * 5 + b) * 6144; const float* gn = p.norm2_g + l * DM;
#pragma unroll
          for (int j = 0; j < 4; ++j) { const int c = 256 * j + 4 * lane; const f32x4 g = *(const f32x4*)(gn + c), sh = *(const f32x4*)(m2 + 3 * 1024 + c), sc = *(const f32x4*)(m2 + 4 * 1024 + c);
#pragma unroll
              for (int q = 0; q < 2; ++q) { const int rr = wave + 8 * q; const float r = __builtin_amdgcn_rsqf(ssum[q] * (1.f / DM) + EPS); f32x4 hv; f16x4 o;
#pragma unroll
                  for (int i = 0; i < 4; ++i) { hv[i] = v[q][j][i] * r * g[i] * (1.f + sc[i]) + sh[i]; o[i] = (f16)hv[i]; }
                  *(f16x4*)(H + (size_t)(row0 + rr) * DM + c) = o; *(LAS f32x4*)(XT + rr * XP + c) = hv; } } }
        if (pend_valid) BASE[(cur ^ 1) * 32 + tid] = (int)pend;
        __syncthreads();
        if (tile + G < ntiles) RT_LOAD(tile + G);
        if (prev_row0 >= 0) RT_FLUSH(cur ^ 1, prev_row0);
        { f32x4 acc[3];
#pragma unroll
          for (int n = 0; n < 3; ++n) acc[n] = (f32x4){0.f, 0.f, 0.f, 0.f};
#pragma unroll
          for (int ks = 0; ks < 4; ++ks) { const LAS float* xp = XT + fr * XP + wave * 128 + 32 * ks + 8 * fq; const f32x4 x0 = *(const LAS f32x4*)xp, x1 = *(const LAS f32x4*)(xp + 4);
              f16x8 ah, al;
#pragma unroll
              for (int j = 0; j < 4; ++j) { ah[j] = (f16)x0[j]; al[j] = (f16)(x0[j] - (float)ah[j]); ah[4 + j] = (f16)x1[j]; al[4 + j] = (f16)(x1[j] - (float)ah[4 + j]); }
#pragma unroll
              for (int n = 0; n < 3; ++n) { acc[n] = mma_f16(ah, wh[ks][n], acc[n]); acc[n] = mma_f16(ah, wl_[ks][n], acc[n]); acc[n] = mma_f16(al, wh[ks][n], acc[n]); } }
#pragma unroll
          for (int n = 0; n < 3; ++n)
#pragma unroll
              for (int i = 0; i < 4; ++i) PART[(wave * 16 + 4 * fq + i) * 48 + 16 * n + fr] = acc[n][i] * (1.f / 1024.f); }
        __syncthreads();
        for (int i = tid; i < 16 * 36; i += 512) { const int tk = i / 36, o = i % 36; float s = 0.f;
#pragma unroll
            for (int w = 0; w < 8; ++w) s += PART[(w * 16 + tk) * 48 + o];
            LG[tk * 48 + o] = s + (o < 4 ? p.rgb[l * 4 + o] : p.reb[l * 32 + (o - 4)]); }
        __syncthreads();
        if (tid < 16) { const int row = row0 + tid; const LAS float* lg = LG + tid * 48;
            int g = 0; float gm = lg[0];
#pragma unroll
            for (int j = 1; j < 4; ++j) if (lg[j] > gm) { gm = lg[j]; g = j; }
            float den = 0.f;
#pragma unroll
            for (int j = 0; j < 4; ++j) den += expf(lg[j] - gm);
            const float pg = 1.f / den;
            const LAS float* le = lg + 4 + 8 * g; int e0 = 0; float m0 = le[0];
#pragma unroll
            for (int j = 1; j < 8; ++j) if (le[j] > m0) { m0 = le[j]; e0 = j; }
            int e1 = -1; float m1 = -INFINITY;
#pragma unroll
            for (int j = 0; j < 8; ++j) if (j != e0 && le[j] > m1) { m1 = le[j]; e1 = j; }
            const float w0 = 1.f / (1.f + expf(m1 - m0)), w1 = 1.f - w0;
            *(f32x2*)(GT + row * 2) = (f32x2){pg * w0, pg * w1};
            SEL[cur * 32 + tid * 2] = 8 * g + e0; SEL[cur * 32 + tid * 2 + 1] = 8 * g + e1; }
        __syncthreads();
        pend_valid = false;
        if (tid < 32) { int c = 0;
#pragma unroll
            for (int j = 0; j < 32; ++j) c += (SEL[cur * 32 + j] == tid) ? 1 : 0;
            if (c > 0) { pend = atomicAdd(CNT + tid * 16, (unsigned)c); pend_valid = true; } }
        prev_row0 = row0;
    }
    if (pend_valid) BASE[(cur ^ 1) * 32 + tid] = (int)pend;
    __syncthreads();
    if (prev_row0 >= 0) RT_FLUSH(cur ^ 1, prev_row0);
    __syncthreads();
#undef RT_LOAD
#undef RT_FLUSH
}

DI int moe_setup(const Params& p, int l, ldsp lds, int tid, int G, int bx) {
    LAS int* blk = (LAS int*)(lds + BLK_OFF); LAS int* cnt = blk + 40; LAS int* utab = blk + 80;
    const unsigned* CNT = (const unsigned*)(p.ws + WS_CTL) + CW_CNT + l * 32 * 16;
    if (tid < 32) cnt[tid] = (int)__hip_atomic_load(CNT + tid * 16, __ATOMIC_RELAXED, __HIP_MEMORY_SCOPE_AGENT);
    __syncthreads();
    if (tid == 0) { int a = 0; for (int e = 0; e < 32; ++e) { blk[e] = a; a += (cnt[e] + 255) >> 8; } blk[32] = a; }
    __syncthreads();
    if (tid < 16) { const int Lq = pg8::moe_unit(tid, G, bx, blk[32] * 4); const int L = Lq < 0 ? 0 : Lq; const int rb = L >> 2; int e = 0;
        for (int j = 1; j < NEXP; ++j) e = (blk[j] <= rb) ? j : e;
        utab[tid] = (e << 16) | ((rb - blk[e]) & 0xffff); }
    __syncthreads();
    return blk[32];
}


#if defined(__HIP_DEVICE_COMPILE__)
#define LOADP() Params p; { const __attribute__((address_space(4))) Params* kp_ = (const __attribute__((address_space(4))) Params*)__builtin_amdgcn_kernarg_segment_ptr(); asm volatile("" : "+s"(kp_)); \
    __builtin_memcpy(&p, (const Params*)kp_, sizeof(Params)); }
#else
#define LOADP() Params p = p_unused;
#endif
#define PV() int tid = tid0; asm volatile("" : "+v"(tid)); const int lane = tid & 63, wave = __builtin_amdgcn_readfirstlane(tid >> 6); int G = G0, bx = bx0; asm volatile("" : "+s"(G), "+s"(bx)); \
    const int vcu = (G % 8 == 0) ? (bx % 8) * (G / 8) + bx / 8 : bx; int l = l0; asm volatile("" : "+s"(l)); (void)lane; (void)wave; (void)vcu; (void)l;
#define AMP_T0(n) unsigned long long amp_t0_ = 0; if (AMP_PHASE == (n)) amp_t0_ = __builtin_amdgcn_s_memrealtime();
#define AMP_WAIT(n) if (AMP_PHASE == (n)) { const unsigned long long t1_ = __builtin_amdgcn_s_memrealtime(); const unsigned long long w_ = (t1_ - amp_t0_) * AMP_K; while (__builtin_amdgcn_s_memrealtime() - t1_ < w_) __builtin_amdgcn_s_sleep(8); }
template <int L0> DI void layer_body(const XcdBarrier& bar, ldsp lds, const int tid0, const int G0, const int bx0, const Params& p_unused) {
    constexpr int l0 = L0;


{ AMP_T0(2)
#ifndef SKIP_INPROJ
        for (int rep_ = 0; rep_ < (DUP_PHASE == 2 ? 2 : 1); ++rep_) { LOADP(); PV(); unsigned char* ws = p.ws; pg8::Gemm g{(const f16*)(ws + WS_H), (const f16*)(ws + WS_WIN) + (size_t)l * INC * DM, DM, 0}; pg8::StaticOrder S; S.init(TT, INC, G, bx);
          EpiP E{(f16*)(ws + WS_P), INC};
          pg8::gemm_phase<EpiP, pg8::StaticOrder, true, false>(lds, g, S, E, tid);
          if (l < DEPTH - 1 && rep_ == 0) { const int nu = (TT / 256) * (INC / 256); if ((nu - bx + G - 1) / G < (nu + G - 1) / G) convert_steal(p, l + 1, 2, lds, tid, lane, wave); } }
#endif

        xcd_barrier(bar); AMP_WAIT(2) }

{ AMP_T0(3)
#ifndef SKIP_PREP
        for (int rep_ = 0; rep_ < (DUP_PHASE == 3 ? 2 : 1); ++rep_) { LOADP(); PV(); phase_prep_w(p, l, lds, lane, wave, vcu, G); }
#endif

        xcd_barrier(bar); AMP_WAIT(3) }

{ AMP_T0(5)
#ifndef SKIP_SCAN
        for (int rep_ = (DUP_PHASE == 4 ? 1 : 0); rep_ >= 0; --rep_) { LOADP(); PV(); phase_scan(p, tid, vcu, G, rep_); }
#endif
        xcd_barrier(bar); AMP_WAIT(5) }
{ AMP_T0(6)
#ifndef SKIP_HOUT
        for (int rep_ = 0; rep_ < (DUP_PHASE == 6 ? 2 : 1); ++rep_) { LOADP(); PV(); phase_hgrn_out_w(p, l, lds, lane, wave, vcu, G); }
#endif
#ifndef SKIP_ATTN
        for (int rep_ = 0; rep_ < (DUP_PHASE == 5 ? 2 : 1); ++rep_) { LOADP(); PV(); phase_attn(p, l, lds, tid, lane, wave, vcu, G, rep_); }
#endif
        xcd_barrier(bar); AMP_WAIT(6) }

{ AMP_T0(7)
#ifndef SKIP_OUTPROJ
        for (int rep_ = (DUP_PHASE == 7 ? 1 : 0); rep_ >= 0; --rep_) { LOADP(); PV(); unsigned char* ws = p.ws; pg8::Gemm g{(const f16*)(ws + WS_MIX), (const f16*)(ws + WS_WOUT) + (size_t)l * DM * DM, DM, 0}; pg8::StaticOrder S; S.init(TL, DM, G, bx);
          EpiOut E{(f16*)(ws + (rep_ ? WS_DUMMY : WS_DELTA)), (const float*)(ws + WS_MOD) + (size_t)l * 5 * 6144};
          pg8::gemm_phase<EpiOut, pg8::StaticOrder, true, false>(lds, g, S, E, tid);
          if (l < DEPTH - 1) phase_outproj_ctx(p, l, lane, wave, vcu, G, rep_); }
#endif

        xcd_barrier(bar); AMP_WAIT(7) }

{ AMP_T0(8)
#ifndef SKIP_ROUTER
        for (int rep_ = (DUP_PHASE == 8 ? 1 : 0); rep_ >= 0; --rep_) { LOADP(); PV(); if (l > 0 && rep_ == 0) convert_steal(p, l, 1 << 20, lds, tid, lane, wave); phase_router(p, l, lds, tid, lane, wave, vcu, G, rep_); }
#endif

        xcd_barrier(bar); AMP_WAIT(8) }

{ AMP_T0(9)
#ifndef SKIP_MOE1
        for (int rep_ = 0; rep_ < (DUP_PHASE == 9 ? 2 : 1); ++rep_) { LOADP(); PV(); unsigned char* ws = p.ws; const int nblk = moe_setup(p, l, lds, tid, G, bx);
          pg8::Gemm g{(const f16*)(ws + WS_H), (const f16*)(ws + WS_WGU) + (size_t)l * NEXP * 1024 * 1024, DM, (size_t)1024 * 1024};
          pg8::MoeOrder S{G, bx, nblk, (const LAS int*)(lds + BLK_OFF), (const LAS int*)(lds + BLK_OFF) + 40, (const int*)(ws + WS_LIST), DM * 2, (const LAS int*)(lds + BLK_OFF) + 80};
          EpiMoe1 E{(f16*)(ws + WS_HID)};
          pg8::gemm_phase<EpiMoe1, pg8::MoeOrder, true, true>(lds, g, S, E, tid);
          if (l < DEPTH - 1 && rep_ == 0) { const int nu = nblk * 4; if (pg8::moe_unit((nu + G - 1) / G - 1, G, bx, nu) < 0) convert_steal(p, l + 1, 2, lds, tid, lane, wave); } }
#endif

        xcd_barrier(bar); AMP_WAIT(9) }

{ AMP_T0(10)
#ifndef SKIP_MOE2
        for (int rep_ = 0; rep_ < (DUP_PHASE == 10 ? 2 : 1); ++rep_) { LOADP(); PV(); unsigned char* ws = p.ws; const int nblk = ((const LAS int*)(lds + BLK_OFF))[32];
          pg8::Gemm g{(const f16*)(ws + WS_HID), (const f16*)(ws + WS_WD) + (size_t)l * NEXP * 1024 * 512, EH, (size_t)1024 * 512};
          pg8::MoeOrder S{G, bx, nblk, (const LAS int*)(lds + BLK_OFF), (const LAS int*)(lds + BLK_OFF) + 40, (const int*)(ws + WS_LIST), EH * 2, (const LAS int*)(lds + BLK_OFF) + 80};
          EpiMoe2 E{(f16*)(ws + WS_Y2)};
          pg8::gemm_phase<EpiMoe2, pg8::MoeOrder, true, false>(lds, g, S, E, tid);
          if (l < DEPTH - 1 && rep_ == 0) { const int nu = nblk * 4; if (pg8::moe_unit((nu + G - 1) / G - 1, G, bx, nu) < 0) convert_steal(p, l + 1, 1, lds, tid, lane, wave); } }
#endif

        xcd_barrier(bar); AMP_WAIT(10) }

{ AMP_T0(11)
#ifndef SKIP_COMBINE
        for (int rep_ = (DUP_PHASE == 11 ? 1 : 0); rep_ >= 0; --rep_) { LOADP(); PV(); phase_combine(p, l, lds, lane, wave, vcu, G, rep_); }
#endif

        if (l0 < DEPTH - 1) xcd_barrier(bar); AMP_WAIT(11) }
        if (DUP_PHASE == 13) { for (int q_ = 0; q_ < 8; ++q_) xcd_barrier(bar); }

}

__global__ void __launch_bounds__(512, 2) fwd_kernel(Params p_unused) {
    extern __shared__ __attribute__((aligned(16))) unsigned char lds_raw[];
    ldsp lds = (ldsp)lds_raw;
    const int tid0 = threadIdx.x; const int G0 = gridDim.x; const int bx0 = blockIdx.x;
    const int tid = tid0;
    volatile LAS unsigned* MISC = (volatile LAS unsigned*)(lds + MISC_OFF);
    for (int u = tid; u < (LDS_BYTES - MISC_OFF) / 4; u += 512) ((LAS unsigned*)(lds + MISC_OFF))[u] = 0u;
    __syncthreads();
    XcdBarrier bar;
    { LOADP(); bar = xcd_barrier_post((unsigned*)(p.ws + WS_CTL) + CW_BAR, MISC + 8); }


    const int l0 = 0;
#ifndef SKIP_PROLOGUE
    for (int rep_ = 0; rep_ < (DUP_PHASE == 1 ? 2 : 1); ++rep_) { LOADP(); PV(); phase_prologue(p, lds, tid, lane, wave, vcu, G); __syncthreads(); }
#endif

    xcd_barrier(bar);

#ifndef SKIP_MOD0
        for (int rep_ = 0; rep_ < (DUP_PHASE == 12 ? 2 : 1); ++rep_) { LOADP(); PV(); phase_mod0(p, lane, wave, vcu, G); }
#endif

    xcd_barrier(bar);
    layer_body<0>(bar, lds, tid0, G0, bx0, p_unused); layer_body<1>(bar, lds, tid0, G0, bx0, p_unused); layer_body<2>(bar, lds, tid0, G0, bx0, p_unused); layer_body<3>(bar, lds, tid0, G0, bx0, p_unused);
}

extern "C" void kernel_launch(void* const* d_in, const int* in_sizes, int n_in, void* d_out, int out_size, void* d_ws, size_t ws_size, hipStream_t stream) {
    static int grid = 0;
    if (grid == 0) {
        if (n_in != 24 || out_size != TL * DM || ws_size < WS_END) { fprintf(stderr, "kernel_launch: unexpected shapes (n_in %d, out %d, ws %zu < %zu)\n", n_in, out_size, ws_size, (size_t)WS_END); grid = -1; return; }
        int dev = 0, cus = 0, per_cu = 0;
        if (hipGetDevice(&dev) != hipSuccess || hipDeviceGetAttribute(&cus, hipDeviceAttributeMultiprocessorCount, dev) != hipSuccess) { grid = -1; return; }
        if (hipFuncSetAttribute((const void*)fwd_kernel, hipFuncAttributeMaxDynamicSharedMemorySize, LDS_BYTES) != hipSuccess) { fprintf(stderr, "kernel_launch: hipFuncSetAttribute failed\n"); grid = -1; return; }
        if (hipOccupancyMaxActiveBlocksPerMultiprocessor(&per_cu, (const void*)fwd_kernel, 512, LDS_BYTES) != hipSuccess || per_cu < 1) { fprintf(stderr, "kernel_launch: occupancy query reports %d\n", per_cu); }
        (void)hipGetLastError();
        grid = cus;
    }
    if (grid < 0) return;
    (void)hipMemsetAsync((char*)d_ws + WS_CTL, 0, CTL_ZERO_BYTES, stream);
    Params p{};
    const float** pp = (const float**)&p;
    for (int i = 0; i < 24; ++i) pp[i] = (const float*)d_in[i];
    p.out = (float*)d_out; p.ws = (unsigned char*)d_ws;
    hipLaunchKernelGGL(fwd_kernel, dim3(grid), dim3(512), LDS_BYTES, stream, p);
}
```

```cpp
#include <hip/hip_runtime.h>
#include <cstdio>
#include <cstdint>

#define DI __device__ __forceinline__
#ifndef AMP_PHASE
#define AMP_PHASE 0
#endif
#define AMP_K 4
#ifndef DUP_PHASE
#define DUP_PHASE 0
#endif
#define LAS __attribute__((address_space(3)))
#define GAS __attribute__((address_space(1)))
typedef _Float16 f16;
typedef _Float16 f16x8 __attribute__((ext_vector_type(8)));
typedef _Float16 f16x4 __attribute__((ext_vector_type(4)));
typedef _Float16 f16x2 __attribute__((ext_vector_type(2)));
typedef short s16x8 __attribute__((ext_vector_type(8)));
typedef short s16x4 __attribute__((ext_vector_type(4)));
typedef float f32x4 __attribute__((ext_vector_type(4)));
typedef float f32x2 __attribute__((ext_vector_type(2)));
typedef float f32x16 __attribute__((ext_vector_type(16)));
typedef unsigned u32x4 __attribute__((ext_vector_type(4)));
typedef unsigned u32x2 __attribute__((ext_vector_type(2)));
typedef LAS unsigned char* ldsp;

constexpr int DM = 1024, NB = 4, SEQ = 8192, CTXL = 256, DEPTH = 4;
constexpr int TL = NB * SEQ, TC = NB * CTXL, TT = TL + TC;
constexpr int INC = 2304;
constexpr int C_U = 0, C_Q = 256, C_K = 768, C_V = 896, C_HQ = 1024, C_HI = 1280, C_HZF = 1536, C_HZB = 1792, C_HG = 2048;
constexpr int NEXP = 32, EH = 512;
constexpr int NPOS = 132;
constexpr float EPS = 1e-6f;
constexpr float LOG2E = 1.4426950408889634f;
constexpr int MAXBLK = 296;

constexpr size_t MiB = 1u << 20;
constexpr size_t WS_CTL = 0, CTL_ZERO_BYTES = 1 * MiB;
constexpr size_t WS_WIN = 1 * MiB;
constexpr size_t WS_WOUT = WS_WIN + (size_t)DEPTH * INC * DM * 2;
constexpr size_t WS_WGU = WS_WOUT + (size_t)DEPTH * DM * DM * 2;
constexpr size_t WS_WD = WS_WGU + (size_t)DEPTH * NEXP * 1024 * 1024 * 2;
constexpr size_t WS_POOLW = WS_WD + (size_t)DEPTH * NEXP * 1024 * 512 * 2;
constexpr size_t WS_WR = WS_POOLW + (size_t)DEPTH * 4 * 64 * 64 * 2;
constexpr size_t WS_MOD = WS_WR + (size_t)DEPTH * 1024 * 48 * 4;
constexpr size_t WS_LB = WS_MOD + (size_t)DEPTH * 5 * 6144 * 4;
constexpr size_t WS_ROPE = WS_LB + (size_t)DEPTH * 2 * 256 * 4;
constexpr size_t WS_XC = WS_ROPE + (size_t)(2 * 128 * 16 + 2 * 64 * 16) * 4;
constexpr size_t WS_GATES = WS_XC + (size_t)TC * DM * 4;
constexpr size_t WS_SLOT = WS_GATES + (size_t)TT * 2 * 4;
constexpr size_t WS_LIST = WS_SLOT + (size_t)TT * 2 * 4;
constexpr size_t WS_H = WS_LIST + (size_t)NEXP * TT * 4;
constexpr size_t WS_P = WS_H + (size_t)TT * DM * 2;
constexpr size_t WS_Y2 = WS_P;

constexpr size_t WS_QN = WS_P + (size_t)TT * INC * 2;
constexpr size_t WS_KN = WS_QN + (size_t)TT * 512 * 2;
constexpr size_t WS_MIX = WS_KN + (size_t)TT * 128 * 2;
constexpr size_t WS_HS = WS_MIX + (size_t)TT * DM * 2;
constexpr size_t WS_HA = WS_HS + (size_t)2 * NB * NPOS * 4 * 4096 * 4;
constexpr size_t WS_HSB = WS_HA + (size_t)2 * NB * NPOS * 4 * 64 * 4;
constexpr size_t WS_QS = WS_HSB + (size_t)2 * NB * NPOS * 4 * 4096 * 2;
constexpr size_t WS_DELTA = WS_QS + (size_t)TT * 256 * 2;
constexpr size_t WS_END0 = WS_DELTA + (size_t)TT * DM * 2;
constexpr size_t WS_HID = WS_QN;
constexpr size_t WS_DUMMY = WS_END0;
constexpr size_t WS_END = WS_END0 + (DUP_PHASE ? 144 * MiB : 0);
static_assert((size_t)2 * TT * DM * 2 <= (size_t)TT * INC * 2, "Y2 fits in P");
static_assert(WS_HID + (size_t)MAXBLK * 256 * EH * 2 <= WS_END0, "HID fits in its overlay");
static_assert(WS_WIN % 256 == 0 && WS_H % 256 == 0 && WS_P % 256 == 0 && WS_QN % 256 == 0 && WS_KN % 256 == 0 && WS_MIX % 256 == 0 && WS_HS % 256 == 0 && WS_HA % 256 == 0 && WS_XC % 256 == 0 && WS_LIST % 256 == 0 && WS_GATES % 256 == 0, "alignment");
constexpr int CW_BAR = 4096;
constexpr int CW_QUEUE = 12288;
constexpr int CW_CVQ = 13312;
constexpr int CW_CNT = 16384;
constexpr int RING_BYTES = 131072;
constexpr int MISC_OFF = RING_BYTES;
constexpr int BLK_OFF = MISC_OFF + 512;
constexpr int LDS_BYTES = 147456;

struct Params {
    const float *x, *c, *ctx, *c_ctx, *norm1_g, *norm2_g, *ada_w, *ada_b, *w_in, *w_out, *pool_w, *pool_scale, *q_norm_g, *k_norm_g, *attn_sink, *hgrn_lb,
        *hgrn_norm_g, *rgw, *rgb, *rew, *reb, *ewg, *ewu, *ewd;
    float* out; unsigned char* ws;
};

DI unsigned short f2bf(float f) { unsigned u = __builtin_bit_cast(unsigned, f); return (unsigned short)((u + 0x7fffu + ((u >> 16) & 1u)) >> 16); }
DI float wave_sum(float v) {
#pragma unroll
    for (int o = 1; o < 64; o <<= 1) v += __shfl_xor(v, o);
    return v;
}
DI float fast_rcp(float v) { return __builtin_amdgcn_rcpf(v); }
DI float siluf(float v) { return v * fast_rcp(1.f + __expf(-v)); }
DI unsigned cvt_pk_bf16(float lo, float hi) { unsigned r; asm volatile("v_cvt_pk_bf16_f32 %0, %1, %2" : "=v"(r) : "v"(lo), "v"(hi)); return r; }
DI int modb_of_row(int row) { return row < TL ? (row >> 13) : 4; }

#define XB_TMO      128
#define XB_XCNT(j)  (256  + 64 * (j))
#define XB_XSUB(j)  (1280 + 64 * (j))
#define XB_XGEN(j)  (2304 + 64 * (j))
#define XB_TOP      3328
#define XB_TOPGEN   3392
#define XCD_BAR_WORDS 3456
#define XB_SPIN_CAP (1u << 18)
__device__ __forceinline__ unsigned xb_ld(unsigned* p)              { return __hip_atomic_load(p, __ATOMIC_RELAXED, __HIP_MEMORY_SCOPE_AGENT); }
__device__ __forceinline__ unsigned xb_add(unsigned* p, unsigned v) { return __hip_atomic_fetch_add(p, v, __ATOMIC_RELAXED, __HIP_MEMORY_SCOPE_AGENT); }
__device__ __forceinline__ unsigned xb_xcc_id() { return (unsigned)__builtin_amdgcn_s_getreg((3 << 11) | 20) & 0xFu; }
#define XB_SPIN(cond, bar) do { unsigned _sp = 0; while (cond) { __builtin_amdgcn_s_sleep(1); \
    if ((++_sp & 255u) == 0u) { if (xb_ld(&(bar)[XB_TMO])) break; if (_sp > XB_SPIN_CAP) { atomicAdd(&(bar)[XB_TMO], 1u); break; } } } } while (0)
struct XcdBarrier { unsigned* bar; unsigned x; volatile LAS unsigned* st; };
__device__ __forceinline__ XcdBarrier xcd_barrier_post(unsigned* bar, volatile LAS unsigned* st) {
    XcdBarrier b; b.bar = bar; b.x = xb_xcc_id(); b.st = st;
    if (threadIdx.x == 0) (void)xb_add(&bar[XB_XCNT(b.x)], 1u);
    return b;
}
__device__ __forceinline__ void xcd_barrier_complete(unsigned* bar, unsigned x, unsigned& nloc, unsigned& nx) {
    const unsigned G = gridDim.x * gridDim.y * gridDim.z;
    unsigned sum, cnt, mine, sp = 0u;
    for (;;) {
        sum = 0u; cnt = 0u; mine = 0u;
#pragma unroll 1
        for (unsigned j = 0; j < 16; ++j) { const unsigned c = xb_ld(&bar[XB_XCNT(j)]); sum += c; cnt += (c > 0u) ? 1u : 0u; mine = (j == x) ? c : mine; }
        if (sum == G) break;
        __builtin_amdgcn_s_sleep(1);
        if ((++sp & 255u) == 0u) { if (xb_ld(&bar[XB_TMO])) break; if (sp > XB_SPIN_CAP) { atomicAdd(&bar[XB_TMO], 1u); break; } }
    }
    nloc = mine > 0u ? mine : 1u; nx = cnt > 0u ? cnt : 1u;
}
__device__ __forceinline__ void xcd_barrier(const XcdBarrier& b) {
    asm volatile("s_waitcnt vmcnt(0)" ::: "memory");
    __syncthreads();
    if (threadIdx.x == 0) {
        unsigned* bar = b.bar;
        __builtin_amdgcn_s_waitcnt(0);
        unsigned nloc = b.st[0], nx = b.st[1];
        if (nloc == 0u) { xcd_barrier_complete(bar, b.x, nloc, nx); b.st[0] = nloc; b.st[1] = nx; }
        const unsigned old = xb_add(&bar[XB_XSUB(b.x)], 1u);
        const unsigned gen = old / nloc;
        if (old + 1u == (gen + 1u) * nloc) {
            __builtin_amdgcn_fence(__ATOMIC_RELEASE, "agent");
            asm volatile("s_waitcnt vmcnt(0)" ::: "memory");
            const unsigned og = xb_add(&bar[XB_TOP], 1u);
            const unsigned tg = og / nx;
            if (og + 1u == (tg + 1u) * nx) xb_add(&bar[XB_TOPGEN], 1u);
            else XB_SPIN(xb_ld(&bar[XB_TOPGEN]) == tg, bar);
            __builtin_amdgcn_fence(__ATOMIC_ACQUIRE, "agent");
            xb_add(&bar[XB_XGEN(b.x)], 1u);
            asm volatile("s_waitcnt vmcnt(0)" ::: "memory");
        } else {
            XB_SPIN(xb_ld(&bar[XB_XGEN(b.x)]) == gen, bar);
            __builtin_amdgcn_fence(__ATOMIC_ACQUIRE, "agent");
            asm volatile("s_waitcnt vmcnt(0)" ::: "memory");
        }
    }
    __syncthreads();
}

namespace pg8 {
constexpr int BM = 256, BK = 64, HALF = 128, HTB = HALF * BK * 2, STAGE_BYTES = 8 * HTB, NXCD = 8, WGM = 8;
DI int lds_byte(int r, int c) { const int st = (r >> 4) * 2 + (c >> 5), rr = r & 15, cc = c & 31, ob = rr * 64 + cc * 2; return st * 1024 + (ob ^ (((ob >> 9) & 1) << 5)); }
DI void stage_rc(int b, int& R, int& C) { const int st = b / 1024, sb = b % 1024, swz = sb ^ (((sb >> 9) & 1) << 5); R = (st >> 1) * 16 + swz / 64; C = (st & 1) * 32 + (swz % 64) / 2; }
DI int perm32(int rho) { const int n = rho >> 4, i = rho & 15; return 8 * (i >> 2) + 4 * n + (i & 3); }

struct Unit { int pm, pn, e, lrb; };
struct Gemm { const f16* A; const f16* Bt; int K; size_t bstride; };

struct StaticOrder {
    int nM, nN, nwg, G, c;
    DI void init(int M, int N, int G_, int c_) { nM = M / BM; nN = N / BM; nwg = nM * nN; G = G_; c = c_; }
    DI bool next(int i, Unit& u) const {
        const long L = (long)i * G + c; if (L >= nwg) return false;
        int wgid = (int)L; { const int q = nwg / NXCD, r = nwg % NXCD, xcd = wgid % NXCD, off = wgid / NXCD; wgid = (xcd < r ? xcd * (q + 1) : r * (q + 1) + (xcd - r) * q) + off; }
        const int nig = WGM * nN, gid = wgid / nig, fm = gid * WGM, gsz = (nM - fm) < WGM ? (nM - fm) : WGM;
        u.pm = fm + ((wgid % nig) % gsz); u.pn = (wgid % nig) / gsz; u.e = 0; u.lrb = 0; return true;
    }
    DI unsigned arow(const Unit&, int) const { return 0u; }
};
DI int moe_unit(int i, int G, int c, int U) {
    if (G % 8 != 0) { const int L = i * G + c; return L < U ? L : -1; }
    const int x = c & 7, j = c >> 3, W = G >> 3; const int lo = (int)(((long)U * x) >> 3), hi = (int)(((long)U * (x + 1)) >> 3); const int k = lo + i * W + j; return k < hi ? k : -1;
}
struct MoeOrder {
    int G, c, nblk; const LAS int* blk; const LAS int* cnt; const int* list; int rowbytes;
    const LAS int* utab;
    DI bool next(int i, Unit& u) const {
        const int L = moe_unit(i, G, c, nblk * 4); if (L < 0) return false;
        const int rb = L >> 2; u.pn = L & 3; u.pm = rb;
        const int t = utab[i]; u.e = t >> 16; u.lrb = t & 0xffff; return true;
    }
    DI unsigned arow(const Unit& u, int r) const {
        const int pos = u.lrb * 256 + r; const int ent = (pos < cnt[u.e]) ? list[(size_t)u.e * TT + pos] : 0;
        return (unsigned)(ent >> 1) * (unsigned)rowbytes;
    }
};

template <class Epi, class Sched, bool ALIGN_EPI, bool GATHER>
DI void gemm_phase(ldsp lds, const Gemm g, const Sched& S, const Epi& E, const int tid) {
    const int wid = __builtin_amdgcn_readfirstlane(tid >> 6), lane = tid & 63, wr = wid >> 2, wc = wid & 3, fr = lane & 15, fq = lane >> 4;
    const int K = g.K, nt = K / BK;
    int Rr[2], Cc[2]; unsigned voffB[2], voffA[2];
#pragma unroll
    for (int i = 0; i < 2; ++i) { int R, C; stage_rc(tid * 16 + i * 8192, R, C); const int Rb = Epi::PERM ? ((R & ~31) + perm32(R & 31)) : R;
        Rr[i] = R; Cc[i] = C; voffB[i] = (unsigned)(Rb * K + C) * 2u; voffA[i] = (unsigned)(R * K + C) * 2u; }
    const size_t kstep = (size_t)(BK * 2);
    const size_t hstep = (size_t)HALF * K * 2;
    const size_t tstep = 2 * hstep;
    const unsigned ldsw = (unsigned)wid * 1024u;
    const int aoff = lds_byte(wr * 64 + fr, fq * 8), boff = lds_byte(wc * 32 + fr, fq * 8);
    const char* const Ab = (const char*)g.A;
#define PG8_SA(b, h) (((b) * 2 + (h)) * HTB)
#define PG8_SB(b, h) ((4 + (b) * 2 + (h)) * HTB)
#define PG8_STAGE(bufoff, gbase, voff) do { _Pragma("unroll") for (int _i = 0; _i < 2; ++_i) \
        __builtin_amdgcn_global_load_lds((const unsigned*)((const char*)(gbase) + (voff)[_i]), (LAS unsigned*)(lds + (bufoff) + ldsw + _i * 8192), 16, 0, 0); } while (0)
#define PG8_LDA(dst, b, h) do { _Pragma("unroll") for (int m = 0; m < 4; ++m) _Pragma("unroll") for (int k = 0; k < 2; ++k) dst[m][k] = *(const LAS f16x8*)(lds + PG8_SA(b, h) + aoff + m * 2048 + k * 1024); } while (0)
#define PG8_LDB(dst, b, h) do { _Pragma("unroll") for (int n = 0; n < 2; ++n) _Pragma("unroll") for (int k = 0; k < 2; ++k) dst[n][k] = *(const LAS f16x8*)(lds + PG8_SB(b, h) + boff + n * 2048 + k * 1024); } while (0)
#define PG8_MMA(ai, bj, At, Bt) do { __builtin_amdgcn_s_setprio(1); _Pragma("unroll") for (int m = 0; m < 4; ++m) _Pragma("unroll") for (int n = 0; n < 2; ++n) _Pragma("unroll") for (int k = 0; k < 2; ++k) \
        acc[ai][bj][m][n] = __builtin_amdgcn_mfma_f32_16x16x32_f16(Bt[n][k], At[m][k], acc[ai][bj][m][n], 0, 0, 0); __builtin_amdgcn_s_setprio(0); } while (0)
#define PG8_WAIT_V(n) asm volatile("s_waitcnt vmcnt(" #n ")" ::: "memory")
#define PG8_WAIT_L(n) asm volatile("s_waitcnt lgkmcnt(" #n ")" ::: "memory")
#define PG8_BAR __builtin_amdgcn_s_barrier()
#define PG8_SCHED __builtin_amdgcn_sched_barrier(0)
#define PG8_AOFF(dst, U) do { if constexpr (GATHER) { _Pragma("unroll") for (int _h = 0; _h < 2; ++_h) _Pragma("unroll") for (int _i = 0; _i < 2; ++_i) \
        dst[_h][_i] = S.arow(U, _h * HALF + Rr[_i]) + (unsigned)Cc[_i] * 2u; } } while (0)
#define PG8_STAGE_A(bufoff, kb, nx, h) do { if constexpr (GATHER) { if (nx) PG8_STAGE(bufoff, Ab + (kb), aon[h]); else PG8_STAGE(bufoff, Ab + (kb), aoc[h]); } \
        else { PG8_STAGE(bufoff, ((nx) ? nA : cA) + (kb) + (h) * hstep, voffA); } } while (0)
    Unit cur, nxt; int ui = 0;
    if (!S.next(0, cur)) return;
    f32x4 acc[2][2][4][2];
#pragma unroll
    for (int a = 0; a < 2; ++a)
#pragma unroll
        for (int b = 0; b < 2; ++b)
#pragma unroll
            for (int m = 0; m < 4; ++m)
#pragma unroll
                for (int n = 0; n < 2; ++n) acc[a][b][m][n] = (f32x4){0.f, 0.f, 0.f, 0.f};
    f16x8 At[4][2], B0[2][2], B1[2][2];
    unsigned aoc[2][2], aon[2][2];
    PG8_AOFF(aoc, cur);
    const char* cA = Ab + (GATHER ? (size_t)0 : (size_t)cur.pm * tstep); const char* nA = cA;
    const char* cB = (const char*)g.Bt + ((size_t)cur.e * g.bstride) * 2 + (size_t)cur.pn * tstep;
    PG8_STAGE(PG8_SB(0, 0), cB, voffB); PG8_STAGE(PG8_SB(0, 1), cB + hstep, voffB); PG8_STAGE_A(PG8_SA(0, 0), 0, 0, 0); PG8_STAGE_A(PG8_SA(0, 1), 0, 0, 1);
    if (wr == 1) PG8_BAR;
    PG8_WAIT_V(2); PG8_BAR;
    PG8_STAGE(PG8_SB(1, 0), cB + kstep, voffB); PG8_STAGE_A(PG8_SA(1, 0), kstep, 0, 0); PG8_STAGE(PG8_SB(1, 1), cB + hstep + kstep, voffB);
    PG8_WAIT_V(6); PG8_BAR;
    for (;;) {
        const bool has_next = S.next(ui + 1, nxt);
        if constexpr (GATHER) { if (has_next) { PG8_AOFF(aon, nxt); } else {
#pragma unroll
            for (int _h = 0; _h < 2; ++_h)
#pragma unroll
                for (int _i = 0; _i < 2; ++_i) aon[_h][_i] = aoc[_h][_i]; } }
        else { nA = has_next ? Ab + (size_t)nxt.pm * tstep : cA; }
        const char* nB = has_next ? (const char*)g.Bt + ((size_t)nxt.e * g.bstride) * 2 + (size_t)nxt.pn * tstep : cB;
        for (int t = 0; t < nt; t += 2) {
            const bool last = (t == nt - 2);
            const size_t k1 = (size_t)(t + 1) * kstep, k2 = last ? (size_t)0 : (size_t)(t + 2) * kstep, k3 = k2 + kstep;
            const char* b2 = last ? nB : cB + (size_t)(t + 2) * kstep; const char* b3 = b2 + kstep;
            PG8_LDB(B0, 0, 0); PG8_LDB(B1, 0, 1); PG8_SCHED; PG8_LDA(At, 0, 0); PG8_STAGE_A(PG8_SA(1, 1), k1, 0, 1);
            PG8_WAIT_V(8); PG8_WAIT_L(0); PG8_BAR; PG8_MMA(0, 0, At, B0); PG8_MMA(0, 1, At, B1); PG8_BAR; PG8_SCHED;
            PG8_LDA(At, 0, 1); PG8_STAGE(PG8_SB(0, 0), b2, voffB); PG8_STAGE(PG8_SB(0, 1), b2 + hstep, voffB); PG8_STAGE_A(PG8_SA(0, 0), k2, last, 0);
            PG8_WAIT_V(8); PG8_WAIT_L(0); PG8_BAR; PG8_MMA(1, 0, At, B0); PG8_MMA(1, 1, At, B1); PG8_BAR; PG8_SCHED;
            PG8_LDB(B0, 1, 0); PG8_LDB(B1, 1, 1); PG8_SCHED; PG8_LDA(At, 1, 0); PG8_STAGE_A(PG8_SA(0, 1), k2, last, 1);
            PG8_WAIT_V(8); PG8_WAIT_L(0); PG8_BAR; PG8_MMA(0, 0, At, B0); PG8_MMA(0, 1, At, B1); PG8_BAR; PG8_SCHED;
            PG8_LDA(At, 1, 1); PG8_STAGE(PG8_SB(1, 0), b3, voffB); PG8_STAGE(PG8_SB(1, 1), b3 + hstep, voffB); PG8_STAGE_A(PG8_SA(1, 0), k3, last, 0);
            PG8_WAIT_V(8); PG8_WAIT_L(0); PG8_BAR; PG8_MMA(1, 0, At, B0); PG8_MMA(1, 1, At, B1); PG8_BAR; PG8_SCHED;
        }
        if constexpr (ALIGN_EPI) { if (wr == 0) PG8_BAR; }
        E(acc, cur, wr, wc, fr, fq);
        if (!has_next) break;
#pragma unroll
        for (int a = 0; a < 2; ++a)
#pragma unroll
            for (int b = 0; b < 2; ++b)
#pragma unroll
                for (int m = 0; m < 4; ++m)
#pragma unroll
                    for (int n = 0; n < 2; ++n) acc[a][b][m][n] = (f32x4){0.f, 0.f, 0.f, 0.f};
        cur = nxt; cB = nB; cA = nA; ++ui;
        if constexpr (GATHER) {
#pragma unroll
        for (int _h = 0; _h < 2; ++_h)
#pragma unroll
            for (int _i = 0; _i < 2; ++_i) aoc[_h][_i] = aon[_h][_i]; }
        if constexpr (ALIGN_EPI) { if (wr == 1) PG8_BAR; }
    }
    PG8_WAIT_V(0);
    if constexpr (!ALIGN_EPI) { if (wr == 0) PG8_BAR; }
    PG8_BAR;
#undef PG8_SA
#undef PG8_SB
#undef PG8_STAGE
#undef PG8_LDA
#undef PG8_LDB
#undef PG8_MMA
#undef PG8_WAIT_V
#undef PG8_WAIT_L
#undef PG8_BAR
#undef PG8_SCHED
#undef PG8_AOFF
#undef PG8_STAGE_A
}
}

typedef f32x4 AccT[2][2][4][2];
DI u32x4 pack8_f16(f32x4 a, f32x4 b) {
    f16x8 h; h[0] = (f16)a[0]; h[1] = (f16)a[1]; h[2] = (f16)a[2]; h[3] = (f16)a[3]; h[4] = (f16)b[0]; h[5] = (f16)b[1]; h[6] = (f16)b[2]; h[7] = (f16)b[3];
    return __builtin_bit_cast(u32x4, h);
}
struct EpiP { static constexpr bool PERM = true; f16* O; int ldc;
    DI void operator()(const AccT& acc, const pg8::Unit& u, int wr, int wc, int fr, int fq) const {
        char* base = (char*)(O + (size_t)u.pm * 256 * ldc + u.pn * 256);
        unsigned loff = (unsigned)((wr * 64 + fr) * ldc + wc * 32 + 8 * fq) * 2u;
        asm volatile("" : "+v"(loff));
#pragma unroll
        for (int ai = 0; ai < 2; ++ai)
#pragma unroll
            for (int m = 0; m < 4; ++m) {
#pragma unroll
                for (int bj = 0; bj < 2; ++bj) *(u32x4*)(base + (size_t)((ai * 128 + m * 16) * ldc + bj * 128) * 2 + loff) = pack8_f16(acc[ai][bj][m][0], acc[ai][bj][m][1]); }
    }
};
struct EpiOut { static constexpr bool PERM = true; f16* D; const float* modl;
    DI void operator()(const AccT& acc, const pg8::Unit& u, int wr, int wc, int fr, int fq) const {
        char* base = (char*)(D + (size_t)u.pm * 256 * DM + u.pn * 256);
        const float* g1 = modl + (u.pm < 128 ? (u.pm >> 5) : 4) * 6144 + 2 * 1024 + u.pn * 256;
        unsigned loff = (unsigned)((wr * 64 + fr) * DM + wc * 32 + 8 * fq) * 2u, goff = (unsigned)(wc * 32 + 8 * fq);
        asm volatile("" : "+v"(loff), "+v"(goff));
#pragma unroll
        for (int bj = 0; bj < 2; ++bj) { const f32x4 g0 = *(const f32x4*)(g1 + goff + bj * 128), g4 = *(const f32x4*)(g1 + goff + bj * 128 + 4);
#pragma unroll
            for (int ai = 0; ai < 2; ++ai)
#pragma unroll
                for (int m = 0; m < 4; ++m) *(u32x4*)(base + (size_t)((ai * 128 + m * 16) * DM + bj * 128) * 2 + loff) = pack8_f16(acc[ai][bj][m][0] * g0, acc[ai][bj][m][1] * g4); }
    }
};
struct EpiMoe1 { static constexpr bool PERM = true; f16* HID;
    DI void operator()(const AccT& acc, const pg8::Unit& u, int wr, int wc, int fr, int fq) const {
        char* base = (char*)(HID + (size_t)u.pm * 256 * EH + u.pn * 128);
        unsigned loff = (unsigned)((wr * 64 + fr) * EH + wc * 32 + 8 * fq) * 2u;
        asm volatile("" : "+v"(loff));
#pragma unroll
        for (int ai = 0; ai < 2; ++ai)
#pragma unroll
            for (int m = 0; m < 4; ++m) { f32x4 h0, h1;
#pragma unroll
                for (int i = 0; i < 4; ++i) { h0[i] = siluf(acc[ai][0][m][0][i]) * acc[ai][1][m][0][i]; h1[i] = siluf(acc[ai][0][m][1][i]) * acc[ai][1][m][1][i]; }
                *(u32x4*)(base + (size_t)((ai * 128 + m * 16) * EH) * 2 + loff) = pack8_f16(h0, h1); }
    }
};
struct EpiMoe2 { static constexpr bool PERM = true; f16* Y2;
    DI void operator()(const AccT& acc, const pg8::Unit& u, int wr, int wc, int fr, int fq) const {
        char* base = (char*)(Y2 + (size_t)u.pm * 256 * DM + u.pn * 256);
        unsigned loff = (unsigned)((wr * 64 + fr) * DM + wc * 32 + 8 * fq) * 2u;
        asm volatile("" : "+v"(loff));
#pragma unroll
        for (int ai = 0; ai < 2; ++ai)
#pragma unroll
            for (int m = 0; m < 4; ++m) {
#pragma unroll
                for (int bj = 0; bj < 2; ++bj) *(u32x4*)(base + (size_t)((ai * 128 + m * 16) * DM + bj * 128) * 2 + loff) = pack8_f16(acc[ai][bj][m][0], acc[ai][bj][m][1]); }
    }
};

DI void p0_transpose_item(const float* W, int K, int N, f16* WT, int mode, LAS float* scr, int item, int lane) {
    const int nblk = N / 32, kb = item / nblk, nb = item % nblk, k0 = 64 * kb, n0 = 32 * nb;
    const int rbase = (mode == 0) ? n0 : (256 * (n0 >> 7) + (n0 & 127) + (mode == 2 ? 128 : 0));
#pragma unroll 8
    for (int i = 0; i < 32; ++i) { const int kk = 2 * i + (lane >> 5); scr[kk * 33 + (lane & 31)] = W[(size_t)(k0 + kk) * N + n0 + (lane & 31)]; }
    asm volatile("s_waitcnt lgkmcnt(0)" ::: "memory");
    const int c = lane & 7;
#pragma unroll
    for (int j = 0; j < 4; ++j) { const int n = (lane >> 3) + 8 * j; const LAS float* s = scr + (8 * c) * 33 + n;
        f16x8 o;
#pragma unroll
        for (int q = 0; q < 8; ++q) o[q] = (f16)s[q * 33];
        *(f16x8*)(WT + (size_t)(rbase + n) * K + k0 + 8 * c) = o; }
    asm volatile("s_waitcnt lgkmcnt(0)" ::: "memory");
}

constexpr int CV_CHUNKS = 768;
DI void expert_item(const Params& p, int l, int r, LAS float* scr, int lane) {
    unsigned char* ws = p.ws; const int e = r / 768, q = r % 768, which = q >> 8, item = q & 255; const size_t le = (size_t)l * NEXP + e;
    if (which == 0) p0_transpose_item(p.ewg + le * DM * EH, DM, EH, (f16*)(ws + WS_WGU) + le * 1024 * 1024, 1, scr, item, lane);
    else if (which == 1) p0_transpose_item(p.ewu + le * DM * EH, DM, EH, (f16*)(ws + WS_WGU) + le * 1024 * 1024, 2, scr, item, lane);
    else p0_transpose_item(p.ewd + le * EH * DM, EH, DM, (f16*)(ws + WS_WD) + le * 1024 * 512, 0, scr, item, lane);
}
DI void convert_steal(const Params& p, int l, int maxpull, ldsp lds, int tid, int lane, int wave) {
    unsigned* qh = (unsigned*)(p.ws + WS_CTL) + CW_CVQ + l * 64; volatile LAS unsigned* slot = (volatile LAS unsigned*)(lds + MISC_OFF) + 24;
    LAS float* scr = (LAS float*)(lds + wave * 16384);
    for (int k = 0; k < maxpull; ++k) {
        __syncthreads();
        if (tid == 0) slot[0] = atomicAdd(qh, 1u);
        __syncthreads();
        const unsigned c = slot[0];
        if (c >= (unsigned)CV_CHUNKS) break;
#pragma unroll 1
        for (int j = 0; j < 4; ++j) expert_item(p, l, (int)c * 32 + wave * 4 + j, scr, lane);
    }
    __syncthreads();
}

DI void phase_prologue(const Params& p, ldsp lds, int tid, int lane, int wave, int vcu, int G) {
    unsigned char* ws = p.ws;
    LAS float* scr = (LAS float*)(lds + wave * 16384);
    const int gw = vcu * 8 + wave, NGW = G * 8;
    constexpr int PER_L = 1152 + 512;
    constexpr int NW_ITEMS = DEPTH * PER_L;
    for (int it = gw; it < NW_ITEMS + 32; it += NGW) {
        if (it >= NW_ITEMS) { const int j = it - NW_ITEMS, mat = j >> 1;
            p0_transpose_item(p.pool_w + (size_t)mat * 4096, 64, 64, (f16*)(ws + WS_POOLW) + (size_t)mat * 4096, 0, scr, j & 1, lane); continue; }
        const int l = it / PER_L; int r = it % PER_L;
        if (r < 1152) { p0_transpose_item(p.w_in + (size_t)l * DM * INC, DM, INC, (f16*)(ws + WS_WIN) + (size_t)l * INC * DM, 0, scr, r, lane); continue; } r -= 1152;
        p0_transpose_item(p.w_out + (size_t)l * DM * DM, DM, DM, (f16*)(ws + WS_WOUT) + (size_t)l * DM * DM, 0, scr, r, lane);
    }
    for (int it = gw; it < 32 * 768; it += NGW) expert_item(p, 0, it, scr, lane);
    { f16* WRH = (f16*)(ws + WS_WR); f16* WRL = WRH + (size_t)DEPTH * 48 * 1024;
      for (int i = vcu * 512 + tid; i < DEPTH * 48 * 1024; i += G * 512) { const int k = i & 1023, o = (i >> 10) % 48, l = i / (48 * 1024);
          float v = 0.f; if (o < 4) v = p.rgw[((size_t)l * 1024 + k) * 4 + o]; else if (o < 36) v = p.rew[((size_t)l * 1024 + k) * 32 + (o - 4)];
          v *= 1024.f; const f16 hi = (f16)v; WRH[i] = hi; WRL[i] = (f16)(v - (float)hi); } }
    { float* RT = (float*)(ws + WS_ROPE);
      for (int i = vcu * 512 + tid; i < (128 + 64) * 16; i += G * 512) { const int m = i & 15, pos = i >> 4;
          const float inv = powf(10000.f, -(float)m / 16.f); const float ang = (float)(pos < 128 ? pos : pos - 128) * inv; float s, c; sincosf(ang, &s, &c);
          if (pos < 128) { RT[pos * 16 + m] = c; RT[2048 + pos * 16 + m] = s; } else { RT[4096 + (pos - 128) * 16 + m] = c; RT[4096 + 1024 + (pos - 128) * 16 + m] = s; } } }
    if (vcu == 0) { float* LB = (float*)(ws + WS_LB);
        const float a0 = p.hgrn_lb[tid], a1 = p.hgrn_lb[512 + tid], a2 = p.hgrn_lb[1024 + tid], a3 = p.hgrn_lb[1536 + tid];
        const float mx = fmaxf(fmaxf(a0, a1), fmaxf(a2, a3)); const float e0 = expf(a0 - mx), e1 = expf(a1 - mx), e2 = expf(a2 - mx), e3 = expf(a3 - mx); const float inv = 1.f / (e0 + e1 + e2 + e3);
        LB[tid] = 0.f; LB[512 + tid] = e1 * inv; LB[1024 + tid] = (e1 + e2) * inv; LB[1536 + tid] = (e1 + e2 + e3) * inv; }
    __syncthreads();
    { LAS float* sl = (LAS float*)lds;
      LAS float* red = (LAS float*)(lds + 32768);
      for (int i = tid; i < 5 * 1024; i += 512) { const int b = i >> 10, k = i & 1023; const float v = (b < 4) ? p.c[b * 1024 + k] : p.c_ctx[k]; sl[i] = siluf(v); }
      __syncthreads();
      float* MOD = (float*)(ws + WS_MOD);
      for (int it = vcu; it < DEPTH * 96; it += G) { const int l = it / 96, col = (it % 96) * 64 + lane;
          const float* W = p.ada_w + (size_t)l * 1024 * 6144 + col; float a[5] = {0.f, 0.f, 0.f, 0.f, 0.f};
#pragma unroll 8
          for (int k = wave * 128; k < wave * 128 + 128; ++k) { const float w = W[(size_t)k * 6144];
#pragma unroll
              for (int b = 0; b < 5; ++b) a[b] += sl[b * 1024 + k] * w; }
#pragma unroll
          for (int b = 0; b < 5; ++b) red[(wave * 5 + b) * 64 + lane] = a[b];
          __syncthreads();
          if (tid < 320) { const int b = tid >> 6, cc = tid & 63; float s = 0.f;
#pragma unroll
              for (int w = 0; w < 8; ++w) s += red[(w * 5 + b) * 64 + cc];
              const int c2 = (it % 96) * 64 + cc; MOD[((size_t)l * 5 + b) * 6144 + c2] = s + p.ada_b[l * 6144 + c2]; }
          __syncthreads(); } }
}

DI void modulate_row_store(const f32x4 (&v)[4], float r, const float* gn, const float* sh, const float* sc, f16* hrow, int lane) {
#pragma unroll
    for (int j = 0; j < 4; ++j) { const int c = 256 * j + 4 * lane; const f32x4 g = *(const f32x4*)(gn + c), s = *(const f32x4*)(sh + c), k = *(const f32x4*)(sc + c);
        f16x4 o;
#pragma unroll
        for (int i = 0; i < 4; ++i) o[i] = (f16)(v[j][i] * r * g[i] * (1.f + k[i]) + s[i]);
        *(f16x4*)(hrow + c) = o; }
}
DI void phase_mod0(const Params& p, int lane, int wave, int vcu, int G) {
    const float* MOD = (const float*)(p.ws + WS_MOD); f16* H = (f16*)(p.ws + WS_H);
    for (int row = vcu * 8 + wave; row < TT; row += G * 8) {
        const float* xr = (row < TL) ? p.x + (size_t)row * DM : p.ctx + (size_t)(row - TL) * DM; const int b = modb_of_row(row);
        f32x4 v[4]; float s = 0.f;
#pragma unroll
        for (int j = 0; j < 4; ++j) { v[j] = *(const f32x4*)(xr + 256 * j + 4 * lane); s += v[j][0] * v[j][0] + v[j][1] * v[j][1] + v[j][2] * v[j][2] + v[j][3] * v[j][3]; }
        const float r = __builtin_amdgcn_rsqf(wave_sum(s) * (1.f / DM) + EPS);
        modulate_row_store(v, r, p.norm1_g, MOD + (size_t)b * 6144, MOD + (size_t)b * 6144 + 1024, H + (size_t)row * DM, lane);
    }
}
DI void phase_combine(const Params& p, int l, ldsp lds, int lane, int wave, int vcu, int G, int dry) {
    const LAS int* blk = (const LAS int*)(lds + BLK_OFF); const int* SLOT = (const int*)(p.ws + WS_SLOT);
    const float* MOD = (const float*)(p.ws + WS_MOD); f16* H = (f16*)(p.ws + (dry ? WS_DUMMY + 64 * MiB : WS_H)); const f16* Y2 = (const f16*)(p.ws + WS_Y2); const float* GT = (const float*)(p.ws + WS_GATES);
    float* XC = (float*)(p.ws + WS_XC);
    const int nrows = (l == DEPTH - 1) ? TL : TT; const int NGW = G * 8;
    for (int row0 = vcu * 8 + wave; row0 < nrows; row0 += 2 * NGW) {
        f32x4 v[2][4]; f16x4 ya[2][4], yb[2][4], dv[2][4]; float ga[2], gb[2]; int rows[2]; bool ok[2];
#pragma unroll
        for (int q = 0; q < 2; ++q) { const int rr = row0 + q * NGW; ok[q] = rr < nrows; const int row = ok[q] ? rr : row0; rows[q] = row;
            const float* xr = (row < TL) ? (l == 0 ? p.x : p.out) + (size_t)row * DM : (l == 0 ? p.ctx : XC) + (size_t)(row - TL) * DM; const f16* dl = (const f16*)(p.ws + WS_DELTA) + (size_t)row * DM;
            const int s0 = SLOT[row * 2], s1 = SLOT[row * 2 + 1]; const f16* y0 = Y2 + ((size_t)blk[s0 >> 20] * 256 + (s0 & 0xfffff)) * DM; const f16* y1 = Y2 + ((size_t)blk[s1 >> 20] * 256 + (s1 & 0xfffff)) * DM;
            ga[q] = GT[row * 2]; gb[q] = GT[row * 2 + 1];
#pragma unroll
            for (int j = 0; j < 4; ++j) { const int c = 256 * j + 4 * lane; v[q][j] = *(const f32x4*)(xr + c); dv[q][j] = *(const f16x4*)(dl + c); ya[q][j] = *(const f16x4*)(y0 + c); yb[q][j] = *(const f16x4*)(y1 + c); } }
        float ssum[2];
#pragma unroll
        for (int q = 0; q < 2; ++q) { const int row = rows[q]; const int b = modb_of_row(row); const float* g2 = MOD + ((size_t)l * 5 + b) * 6144 + 5 * 1024;
            float* xr = (row < TL) ? p.out + (size_t)row * DM : XC + (size_t)(row - TL) * DM; float* xw = dry ? (float*)(p.ws + WS_DUMMY) + (size_t)(row & 8191) * DM : xr; float s = 0.f;
#pragma unroll
            for (int j = 0; j < 4; ++j) { const int c = 256 * j + 4 * lane; const f32x4 g = *(const f32x4*)(g2 + c);
#pragma unroll
                for (int i = 0; i < 4; ++i) v[q][j][i] = (v[q][j][i] + (float)dv[q][j][i]) + g[i] * (ga[q] * (float)ya[q][j][i] + gb[q] * (float)yb[q][j][i]);
                if (ok[q]) *(f32x4*)(xw + c) = v[q][j];
                s += v[q][j][0] * v[q][j][0] + v[q][j][1] * v[q][j][1] + v[q][j][2] * v[q][j][2] + v[q][j][3] * v[q][j][3]; }
            ssum[q] = s; }
        if (l < DEPTH - 1) {
#pragma unroll
            for (int o = 1; o < 64; o <<= 1) { ssum[0] += __shfl_xor(ssum[0], o); ssum[1] += __shfl_xor(ssum[1], o); }
#pragma unroll
            for (int q = 0; q < 2; ++q) if (ok[q]) { const int row = rows[q]; const int b = modb_of_row(row); const float r = __builtin_amdgcn_rsqf(ssum[q] * (1.f / DM) + EPS); const float* m1 = MOD + ((size_t)(l + 1) * 5 + b) * 6144;
                modulate_row_store(v[q], r, p.norm1_g + (l + 1) * DM, m1, m1 + 1024, H + (size_t)row * DM, lane); } }
    }
}

DI f32x4 mma_f16(f16x8 a, f16x8 b, f32x4 c) { return __builtin_amdgcn_mfma_f32_16x16x32_f16(a, b, c, 0, 0, 0); }
DI f32x4 mma_bf16(s16x8 a, s16x8 b, f32x4 c) { return __builtin_amdgcn_mfma_f32_16x16x32_bf16(a, b, c, 0, 0, 0); }

constexpr int TP = 72;
struct TileInfo { int row0, t0, seqrow0, len, b, isctx, chunkpos_f, chunkpos_b; };
DI TileInfo tile_info(int tt) {
    TileInfo ti;
    if (tt < 512) { ti.b = tt >> 7; ti.t0 = (tt & 127) * 64; ti.seqrow0 = ti.b * SEQ; ti.len = SEQ; ti.isctx = 0; ti.chunkpos_f = 4 + (tt & 127); ti.chunkpos_b = 4 + 127 - (tt & 127); }
    else { const int j = tt - 512; ti.b = j >> 2; ti.t0 = (j & 3) * 64; ti.seqrow0 = TL + ti.b * CTXL; ti.len = CTXL; ti.isctx = 1; ti.chunkpos_f = (j & 3); ti.chunkpos_b = 3 - (j & 3); }
    ti.row0 = ti.seqrow0 + ti.t0; return ti;
}

typedef short v4i16_t __attribute__((ext_vector_type(4)));
DI int crow(int r, int hi) { return (r & 3) + 8 * (r >> 2) + 4 * hi; }
DI int swz(int row, int col) { return row * 64 + ((((col >> 3) ^ (row & 7)) << 3) | (col & 7)); }
DI s16x4 tr_read(const LAS unsigned short* p) { return __builtin_bit_cast(s16x4, __builtin_amdgcn_ds_read_tr16_b64_v4i16((LAS v4i16_t*)p)); }
#define LGKM0() asm volatile("s_waitcnt lgkmcnt(0)" ::: "memory")
DI void wave_load_tile64(LAS unsigned short* T, const f16* src, int pitch, int lane) {
    const int c = lane & 7;
    unsigned lo = (unsigned)((lane >> 3) * pitch + 8 * c) * 2u;
    asm volatile("" : "+v"(lo));
    const char* base = (const char*)src;
#pragma unroll
    for (int it = 0; it < 8; ++it) { const int row = 8 * it + (lane >> 3); const u32x4 v = *(const u32x4*)(base + (size_t)it * 8 * pitch * 2 + lo); *(LAS u32x4*)(T + row * 64 + ((c ^ (row & 7)) << 3)) = v; }
}
DI s16x8 tr_frag16(const LAS unsigned short* T, int k0, int n0, int lane) {
    const int g = lane >> 4, i = lane & 15, q = i >> 2, pp = i & 3; const int r0 = k0 + 8 * g + q;
    const s16x4 a = tr_read(T + swz(r0, n0 + 4 * pp)), b = tr_read(T + swz(r0 + 4, n0 + 4 * pp));
    return (s16x8){a[0], a[1], a[2], a[3], b[0], b[1], b[2], b[3]};
}

template <int CTRL, int RMASK> DI float dpp_add0(float v) { return __builtin_bit_cast(float, __builtin_amdgcn_update_dpp(0, __builtin_bit_cast(int, v), CTRL, RMASK, 0xf, true)); }
DI float bcast_lane(float v, int srclane) { return __builtin_bit_cast(float, __builtin_amdgcn_readlane(__builtin_bit_cast(int, v), srclane)); }
template <int CTRL, int RMASK> DI float dpp_mul1(float v) { return __builtin_bit_cast(float, __builtin_amdgcn_update_dpp(0x3f800000, __builtin_bit_cast(int, v), CTRL, RMASK, 0xf, false)); }
DI float wave_scan_mul(float v) {
    v *= dpp_mul1<0x111, 0xf>(v); v *= dpp_mul1<0x112, 0xf>(v); v *= dpp_mul1<0x114, 0xf>(v); v *= dpp_mul1<0x118, 0xf>(v);
    v *= dpp_mul1<0x142, 0xa>(v); v *= dpp_mul1<0x143, 0xc>(v);
    return v;
}
#define SCAN8_STEP(ctrl) \
    "v_mul_f32_dpp %0, %0, %0 " ctrl "\n\tv_mul_f32_dpp %1, %1, %1 " ctrl "\n\tv_mul_f32_dpp %2, %2, %2 " ctrl "\n\tv_mul_f32_dpp %3, %3, %3 " ctrl "\n\t" \
    "v_mul_f32_dpp %4, %4, %4 " ctrl "\n\tv_mul_f32_dpp %5, %5, %5 " ctrl "\n\tv_mul_f32_dpp %6, %6, %6 " ctrl "\n\tv_mul_f32_dpp %7, %7, %7 " ctrl "\n\t"
DI void wave_scan_mul8(float (&g)[8]) {
    asm volatile("s_nop 1\n\t"
        SCAN8_STEP("row_shr:1 row_mask:0xf bank_mask:0xf") SCAN8_STEP("row_shr:2 row_mask:0xf bank_mask:0xf") SCAN8_STEP("row_shr:4 row_mask:0xf bank_mask:0xf")
        SCAN8_STEP("row_shr:8 row_mask:0xf bank_mask:0xf") SCAN8_STEP("row_bcast:15 row_mask:0xa bank_mask:0xf") SCAN8_STEP("row_bcast:31 row_mask:0xc bank_mask:0xf")
        "s_nop 1"
        : "+v"(g[0]), "+v"(g[1]), "+v"(g[2]), "+v"(g[3]), "+v"(g[4]), "+v"(g[5]), "+v"(g[6]), "+v"(g[7]));
}
DI void hgrn_state_wave(const Params& p, int l, int item, LAS unsigned short* wl, int lane) {
    const int dir = item & 1, h = (item >> 1) & 3; const TileInfo ti = tile_info(item >> 3);
    const f16* P = (const f16*)(p.ws + WS_P); float* HS = (float*)(p.ws + WS_HS); float* HA = (float*)(p.ws + WS_HA);
    LAS unsigned short* Z = wl; LAS unsigned short* V = wl + 4096;
    const f16* prow = P + (size_t)ti.row0 * INC + h * 64;
    wave_load_tile64(Z, prow + (dir ? C_HZB : C_HZF), INC, lane); wave_load_tile64(V, prow + C_HI, INC, lane);
    const float* lbp = (const float*)(p.ws + WS_LB) + l * 512 + dir * 256 + h * 64;
    const int pos = dir ? ti.chunkpos_b : ti.chunkpos_f; const size_t slot = (size_t)((dir * NB + ti.b) * NPOS + pos) * 4 + h;
    float amine = 0.f;
    const int s_ = dir ? 63 - lane : lane;
    LGKM0();
#pragma unroll 1
    for (int c = 0; c < 8; ++c) { float g[8], kk[8]; LAS f16x8* zp = (LAS f16x8*)(Z + s_ * 64 + ((c ^ (s_ & 7)) << 3)); const f16x8 zv = *zp;
#pragma unroll
        for (int j = 0; j < 8; ++j) { const float lb = lbp[8 * c + j]; const float z = (float)zv[j]; const float sg = fast_rcp(1.f + __expf(-z)); g[j] = lb + (1.f - lb) * sg; kk[j] = (1.f - lb) * (1.f - sg); }
        wave_scan_mul8(g);
#pragma unroll
        for (int j = 0; j < 8; ++j) g[j] = fmaxf(g[j], 1e-37f);
        f16x8 ko;
#pragma unroll
        for (int j = 0; j < 8; ++j) { const float pend = bcast_lane(g[j], 63); ko[j] = (f16)(kk[j] * pend * fast_rcp(g[j])); amine = (lane == 8 * c + j) ? pend : amine; }
        *zp = ko; }
    HA[slot * 64 + lane] = amine;
    LGKM0();
    f32x4 acc[4][4];
#pragma unroll
    for (int m = 0; m < 4; ++m)
#pragma unroll
        for (int n = 0; n < 4; ++n) acc[m][n] = (f32x4){0.f, 0.f, 0.f, 0.f};
#pragma unroll
    for (int ks = 0; ks < 2; ++ks) { s16x8 a[4], b[4];
#pragma unroll
        for (int m = 0; m < 4; ++m) { a[m] = tr_frag16(V, 32 * ks, 16 * m, lane); b[m] = tr_frag16(Z, 32 * ks, 16 * m, lane); }
#pragma unroll
        for (int m = 0; m < 4; ++m)
#pragma unroll
            for (int n = 0; n < 4; ++n) acc[m][n] = mma_f16(__builtin_bit_cast(f16x8, a[m]), __builtin_bit_cast(f16x8, b[n]), acc[m][n]); }
    float* dst = HS + slot * 4096; const int fr = lane & 15, fq = lane >> 4;
#pragma unroll
    for (int m = 0; m < 4; ++m)
#pragma unroll
        for (int n = 0; n < 4; ++n)
#pragma unroll
            for (int i = 0; i < 4; ++i) dst[(16 * m + 4 * fq + i) * 64 + 16 * n + fr] = acc[m][n][i];
    LGKM0();
}

DI void qk_wave(const Params& p, int l, int pair8, int lane) {
    const f16* P = (const f16*)(p.ws + WS_P); f16* QN = (f16*)(p.ws + WS_QN); f16* KN = (f16*)(p.ws + WS_KN); const float* RT = (const float*)(p.ws + WS_ROPE);
    const int j8 = lane & 7; const int pidx = pair8 * 8 + (lane >> 3); const int row = pidx / 10, hh = pidx % 10;
    const f16x8 raw = *(const f16x8*)(P + (size_t)row * INC + C_Q + hh * 64 + 8 * j8);
    const bool lat = row < TL; const int t = lat ? (row & (SEQ - 1)) : 0; const int prow = t >> 6, pcol = t & 63; const int a0 = (8 * j8) & 31;
    const float* ct = (a0 < 16) ? RT + prow * 16 + a0 : RT + 4096 + pcol * 16 + (a0 - 16);
    const float* st = (a0 < 16) ? RT + 2048 + prow * 16 + a0 : RT + 4096 + 1024 + pcol * 16 + (a0 - 16);
    const float* gn = (hh < 8 ? p.q_norm_g : p.k_norm_g) + l * 64 + 8 * j8;
    const f32x4 c0 = *(const f32x4*)ct, c1 = *(const f32x4*)(ct + 4), s0 = *(const f32x4*)st, s1 = *(const f32x4*)(st + 4), g0 = *(const f32x4*)gn, g1 = *(const f32x4*)(gn + 4);
    float v[8]; float s = 0.f;
#pragma unroll
    for (int i = 0; i < 8; ++i) { v[i] = (float)raw[i]; s += v[i] * v[i]; }
    s += __shfl_xor(s, 1); s += __shfl_xor(s, 2); s += __shfl_xor(s, 4);
    const float r = __builtin_amdgcn_rsqf(s * (1.f / 64.f) + EPS) * ((hh < 8) ? 0.125f * LOG2E : 1.f);
    const float sgn = (j8 < 4) ? -1.f : 1.f;
    f16x8 o;
#pragma unroll
    for (int i = 0; i < 8; ++i) { const float gi = (i < 4) ? g0[i & 3] : g1[i & 3]; const float ci = lat ? ((i < 4) ? c0[i & 3] : c1[i & 3]) : 1.f, si = lat ? ((i < 4) ? s0[i & 3] : s1[i & 3]) * sgn : 0.f;
        v[i] = v[i] * r * gi; const float ot = __shfl_xor(v[i], 4); o[i] = (f16)(v[i] * ci + ot * si); }
    if (hh < 8) *(f16x8*)(QN + (size_t)row * 512 + hh * 64 + 8 * j8) = o; else *(f16x8*)(KN + (size_t)row * 128 + (hh - 8) * 64 + 8 * j8) = o;
}

DI void pool_wave(const Params& p, int l, int item, LAS unsigned short* wl, int lane) {
    const int g = item & 3; const TileInfo ti = tile_info(item >> 2); const int w = 2 << g;
    const f16* P = (const f16*)(p.ws + WS_P); f16* MIX = (f16*)(p.ws + WS_MIX); const f16* PW = (const f16*)(p.ws + WS_POOLW) + ((size_t)l * 4 + g) * 4096;
    { const int c = lane & 7;
#pragma unroll
      for (int it = 0; it < 10; ++it) { const int row = 8 * it + (lane >> 3); const int t = ti.t0 - 8 + row; u32x4 v = (u32x4){0u, 0u, 0u, 0u};
          if (t >= 0 && t < ti.len) v = *(const u32x4*)(P + (size_t)(ti.seqrow0 + t) * INC + C_U + g * 64 + 8 * c);
          *(LAS u32x4*)(wl + row * 64 + ((c ^ (row & 7)) << 3)) = v; } }
    LGKM0();
    const int fr = lane & 15, fq = lane >> 4;
    f32x4 acc[4][4];
#pragma unroll
    for (int m = 0; m < 4; ++m)
#pragma unroll
        for (int n = 0; n < 4; ++n) acc[m][n] = (f32x4){0.f, 0.f, 0.f, 0.f};
#pragma unroll
    for (int ks = 0; ks < 2; ++ks) { f16x8 bfr[4];
#pragma unroll
        for (int n = 0; n < 4; ++n) bfr[n] = *(const f16x8*)(PW + (n * 16 + fr) * 64 + 32 * ks + 8 * fq);
#pragma unroll
        for (int m = 0; m < 4; ++m) { const int tk = 16 * m + fr, t = ti.t0 + tk; const int ch = 4 * ks + fq;
            float sum[8] = {0.f, 0.f, 0.f, 0.f, 0.f, 0.f, 0.f, 0.f}; int cnt = 0;
            for (int off = -((w - 1) / 2); off <= w / 2; ++off) { const int q = t + off; const int row = tk + off + 8;
                const f16x8 v = *(const LAS f16x8*)(wl + row * 64 + ((ch ^ (row & 7)) << 3)); const bool ok = (q >= 0 && q < ti.len); cnt += ok ? 1 : 0;
#pragma unroll
                for (int i = 0; i < 8; ++i) sum[i] += (float)v[i]; }
            const int row = tk + 8; const f16x8 cv = *(const LAS f16x8*)(wl + row * 64 + ((ch ^ (row & 7)) << 3)); const float ic = 1.f / (float)cnt;
            f16x8 a;
#pragma unroll
            for (int i = 0; i < 8; ++i) a[i] = (f16)(sum[i] * ic - (float)cv[i]);
#pragma unroll
            for (int n = 0; n < 4; ++n) acc[m][n] = mma_f16(a, bfr[n], acc[m][n]); } }
#pragma unroll
    for (int n = 0; n < 4; ++n) { const int d = g * 64 + n * 16 + fr; const float ps = p.pool_scale[l * 256 + d];
#pragma unroll
        for (int m = 0; m < 4; ++m)
#pragma unroll
            for (int i = 0; i < 4; ++i) MIX[(size_t)(ti.row0 + 16 * m + 4 * fq + i) * DM + d] = (f16)(acc[m][n][i] * ps); }
    LGKM0();
}

DI void qs_wave(const Params& p, int item, int lane) {
    const int h = item & 3; const TileInfo ti = tile_info(item >> 2);
    const f16* prow = (const f16*)(p.ws + WS_P) + (size_t)ti.row0 * INC + C_HQ + h * 64; f16* QS = (f16*)(p.ws + WS_QS) + (size_t)ti.row0 * 256 + h * 64; const int c = lane & 7;
    f16x8 qv[8];
#pragma unroll
    for (int it = 0; it < 8; ++it) qv[it] = *(const f16x8*)(prow + (size_t)(8 * it + (lane >> 3)) * INC + 8 * c);
#pragma unroll
    for (int it = 0; it < 8; ++it) { f16x8 o;
#pragma unroll
        for (int j = 0; j < 8; ++j) o[j] = (f16)siluf((float)qv[it][j]);
        *(f16x8*)(QS + (size_t)(8 * it + (lane >> 3)) * 256 + 8 * c) = o; }
}

DI void phase_prep_w(const Params& p, int l, ldsp lds, int lane, int wave, int vcu, int G) {
    LAS unsigned short* wl = (LAS unsigned short*)(lds + wave * 16384);
    LAS unsigned* ctr = (LAS unsigned*)(lds + MISC_OFF) + 20;
    __syncthreads();
    if (threadIdx.x < 4) ctr[threadIdx.x] = 0u;
    __syncthreads();
    const int nH = (528 * 8 - vcu + G - 1) / G, nP = (528 * 4 - vcu + G - 1) / G;
    const int nQ8 = TT * 10 / 8; const int nQ = (nQ8 - vcu + G - 1) / G; const int nQc = (nQ + 4) / 5;
#define PULL(k) ({ unsigned t_ = 0; if (lane == 0) t_ = __hip_atomic_fetch_add(ctr + (k), 1u, __ATOMIC_RELAXED, __HIP_MEMORY_SCOPE_WORKGROUP); __builtin_amdgcn_readfirstlane((int)t_); })
    for (int idx = PULL(0); idx < nH; idx = PULL(0)) hgrn_state_wave(p, l, vcu + idx * G, wl, lane);
    for (int idx = PULL(1); idx < nP; idx = PULL(1)) pool_wave(p, l, vcu + idx * G, wl, lane);
    for (int idx = PULL(3); idx < nP; idx = PULL(3)) qs_wave(p, vcu + idx * G, lane);
    for (int idx = PULL(2); idx < nQc; idx = PULL(2)) { const int c0 = idx * 5;
#pragma unroll
        for (int k = c0; k < c0 + 5; ++k) qk_wave(p, l, vcu + (k < nQ ? k : nQ - 1) * G, lane); }
#undef PULL
}

DI void hgrn_out_wave(const Params& p, int l, int item, LAS unsigned short* wl, LAS float* wx, int lane) {
    const int h = item & 3; const TileInfo ti = tile_info(item >> 2);
    const f16* P = (const f16*)(p.ws + WS_P); const unsigned short* HS = (const unsigned short*)(p.ws + WS_HSB); f16* MIX = (f16*)(p.ws + WS_MIX);
    LAS unsigned short* BA = wl; LAS unsigned short* BB = wl + 4096;
    const f16* prow = P + (size_t)ti.row0 * INC + h * 64;
    const int r32 = lane & 31, hi = lane >> 5;
    f32x16 o[2][2];
#pragma unroll
    for (int a = 0; a < 2; ++a)
#pragma unroll
        for (int b = 0; b < 2; ++b)
#pragma unroll
            for (int r = 0; r < 16; ++r) o[a][b][r] = 0.f;
#pragma unroll 1
    for (int dir = 0; dir < 2; ++dir) {
        wave_load_tile64(BA, prow + (dir ? C_HZB : C_HZF), INC, lane); wave_load_tile64(BB, (const f16*)(p.ws + WS_QS) + (size_t)ti.row0 * 256 + h * 64, 256, lane);
        u32x4 vreg[8], sreg[8];
        { const int pos = dir ? ti.chunkpos_b : ti.chunkpos_f; const char* hs = (const char*)(HS + ((size_t)((dir * NB + ti.b) * NPOS + pos) * 4 + h) * 4096); const char* vb = (const char*)(prow + C_HI);
          unsigned lov = (unsigned)((lane >> 3) * INC + 8 * (lane & 7)) * 2u, los = (unsigned)((lane >> 3) * 64 + 8 * (lane & 7)) * 2u; asm volatile("" : "+v"(lov), "+v"(los));
#pragma unroll
          for (int it = 0; it < 8; ++it) { vreg[it] = *(const u32x4*)(vb + (size_t)it * 8 * INC * 2 + lov); sreg[it] = *(const u32x4*)(hs + (size_t)it * 8 * 64 * 2 + los); } }
        const float* lbp = (const float*)(p.ws + WS_LB) + l * 512 + dir * 256 + h * 64;
        float er_mine = 0.f;
        LGKM0();
        const int s_ = dir ? 63 - lane : lane;
#pragma unroll 1
        for (int c = 0; c < 8; ++c) { float g[8], kk[8]; LAS f16x8* zp = (LAS f16x8*)(BA + s_ * 64 + ((c ^ (s_ & 7)) << 3)); LAS f16x8* qp = (LAS f16x8*)(BB + s_ * 64 + ((c ^ (s_ & 7)) << 3));
            const f16x8 zv = *zp, qv = *qp;
#pragma unroll
            for (int j = 0; j < 8; ++j) { const float lb = lbp[8 * c + j]; const float z = (float)zv[j]; const float sg = fast_rcp(1.f + __expf(-z)); g[j] = lb + (1.f - lb) * sg; kk[j] = (1.f - lb) * (1.f - sg); }
            wave_scan_mul8(g);
#pragma unroll
            for (int j = 0; j < 8; ++j) g[j] = fmaxf(g[j], 1e-37f);
            float kf_[8], qf_[8];
#pragma unroll
            for (int j = 0; j < 8; ++j) { const float r = fast_rcp(g[j]); const float pref = bcast_lane(g[j], 31), rpref = bcast_lane(r, 31);
                kf_[j] = kk[j] * pref * r; qf_[j] = (float)qv[j] * g[j] * rpref; er_mine = (lane == 8 * c + j) ? pref : er_mine; }
            u32x4 ko, qo;
#pragma unroll
            for (int j = 0; j < 4; ++j) { ko[j] = cvt_pk_bf16(kf_[2 * j], kf_[2 * j + 1]); qo[j] = cvt_pk_bf16(qf_[2 * j], qf_[2 * j + 1]); }
            *(LAS u32x4*)zp = ko; *(LAS u32x4*)qp = qo; }
        wx[lane] = er_mine;
        LGKM0();
        s16x8 qf[2][4];
#pragma unroll
        for (int b = 0; b < 2; ++b)
#pragma unroll
            for (int d0 = 0; d0 < 4; ++d0) { const int row = 32 * b + r32, ch = 2 * d0 + hi; qf[b][d0] = *(const LAS s16x8*)(BB + row * 64 + ((ch ^ (row & 7)) << 3)); }
        LGKM0();
        { const int c = lane & 7;
#pragma unroll
          for (int it = 0; it < 8; ++it) { const int row = 8 * it + (lane >> 3); *(LAS u32x4*)(BB + row * 64 + ((c ^ (row & 7)) << 3)) = vreg[it]; } }
        LGKM0();
#pragma unroll
        for (int tb = 0; tb < 2; ++tb)
#pragma unroll
            for (int sb = 0; sb < 2; ++sb) {
                const bool diag = (sb == tb); const bool full = dir ? (sb > tb) : (sb < tb);
                if (!diag && !full) continue;
                f32x16 pt;
#pragma unroll
                for (int r = 0; r < 16; ++r) pt[r] = 0.f;
#pragma unroll
                for (int d0 = 0; d0 < 4; ++d0) { const int row = 32 * sb + r32, ch = 2 * d0 + hi; const s16x8 kf = *(const LAS s16x8*)(BA + row * 64 + ((ch ^ (row & 7)) << 3));
                    pt = __builtin_amdgcn_mfma_f32_32x32x16_bf16(kf, qf[tb][d0], pt, 0, 0, 0); }
                if (diag) {
#pragma unroll
                    for (int r = 0; r < 16; ++r) { const int sl = crow(r, hi); const bool keep = dir ? (sl >= r32) : (sl <= r32); pt[r] = keep ? pt[r] : 0.f; } }
                f16x8 pw[2];
#pragma unroll
                for (int j = 0; j < 8; ++j) { pw[0][j] = (f16)pt[j]; pw[1][j] = (f16)pt[8 + j]; }
#pragma unroll
                for (int dvb = 0; dvb < 2; ++dvb)
#pragma unroll
                    for (int ss = 0; ss < 2; ++ss) { const int i16 = lane & 15, g1 = (lane >> 4) & 1; const int r0 = 32 * sb + 16 * ss + 4 * hi + (i16 >> 2), c0 = 32 * dvb + 16 * g1 + 4 * (i16 & 3);
                        const s16x4 a = tr_read(BB + swz(r0, c0)), b = tr_read(BB + swz(r0 + 8, c0));
                        const s16x8 vf = (s16x8){a[0], a[1], a[2], a[3], b[0], b[1], b[2], b[3]};
                        o[dvb][tb] = __builtin_amdgcn_mfma_f32_32x32x16_f16(__builtin_bit_cast(f16x8, vf), pw[ss], o[dvb][tb], 0, 0, 0); }
            }
        LGKM0();
        { const int c8 = lane & 7; const f32x4 er0 = *(const LAS f32x4*)(wx + 8 * c8), er1 = *(const LAS f32x4*)(wx + 8 * c8 + 4);
#pragma unroll
          for (int it = 0; it < 8; ++it) { const int row = 8 * it + (lane >> 3); const u32x4 sv = sreg[it];
              u32x4 w4;
#pragma unroll
              for (int q = 0; q < 4; ++q) { const float lo = __builtin_bit_cast(float, sv[q] << 16), hi2 = __builtin_bit_cast(float, sv[q] & 0xffff0000u);
                  const float e0 = (q < 2) ? er0[2 * q] : er1[2 * q - 4], e1 = (q < 2) ? er0[2 * q + 1] : er1[2 * q - 3]; w4[q] = cvt_pk_bf16(lo * e0, hi2 * e1); }
              *(LAS u32x4*)(BA + row * 64 + ((c8 ^ (row & 7)) << 3)) = w4; } }
        LGKM0();
#pragma unroll
        for (int dvb = 0; dvb < 2; ++dvb)
#pragma unroll
            for (int d0 = 0; d0 < 4; ++d0) { const int row = 32 * dvb + r32, ch = 2 * d0 + hi; const s16x8 sf = *(const LAS s16x8*)(BA + row * 64 + ((ch ^ (row & 7)) << 3));
#pragma unroll
                for (int tb = 0; tb < 2; ++tb) o[dvb][tb] = __builtin_amdgcn_mfma_f32_32x32x16_bf16(sf, qf[tb][d0], o[dvb][tb], 0, 0, 0); }
        LGKM0();
    }
    const float* gn = p.hgrn_norm_g + l * 64;
#pragma unroll
    for (int tb = 0; tb < 2; ++tb) { float ss = 0.f;
#pragma unroll
        for (int dvb = 0; dvb < 2; ++dvb)
#pragma unroll
            for (int r = 0; r < 16; ++r) ss += o[dvb][tb][r] * o[dvb][tb][r];
        ss += __shfl_xor(ss, 32); const float rn = __builtin_amdgcn_rsqf(ss * (1.f / 64.f) + EPS);
        const size_t row = (size_t)ti.row0 + 32 * tb + r32;
#pragma unroll
        for (int dvb = 0; dvb < 2; ++dvb)
#pragma unroll
            for (int g4 = 0; g4 < 4; ++g4) { const int dv0 = 32 * dvb + 8 * g4 + 4 * hi; const f16x4 gt = *(const f16x4*)(P + row * INC + C_HG + h * 64 + dv0); const f32x4 gg = *(const f32x4*)(gn + dv0);
                f16x4 ov;
#pragma unroll
                for (int i = 0; i < 4; ++i) ov[i] = (f16)(o[dvb][tb][4 * g4 + i] * rn * gg[i] * siluf((float)gt[i]));
                *(f16x4*)(MIX + row * DM + 768 + h * 64 + dv0) = ov; } }
}
DI void phase_hgrn_out_w(const Params& p, int l, ldsp lds, int lane, int wave, int vcu, int G) {
    LAS unsigned short* wl = (LAS unsigned short*)(lds + wave * 16384); LAS float* wx = (LAS float*)(lds + BLK_OFF + 1024 + wave * 512);
    const int gw = vcu * 8 + wave, NGW = G * 8;
    const int nit = (l == DEPTH - 1) ? 512 * 4 : 528 * 4;
    for (int it = gw; it < nit; it += NGW) hgrn_out_wave(p, l, it, wl, wx, lane);
}

DI void phase_scan(const Params& p, int tid, int vcu, int G, int dry) {
    const float* HS = (const float*)(p.ws + WS_HS); const float* HA = (const float*)(p.ws + WS_HA); unsigned short* HSB = (unsigned short*)(p.ws + (dry ? WS_DUMMY : WS_HSB));
    for (int gid = vcu * 512 + tid; gid < 2 * NB * 4 * 4096; gid += G * 512) {
        const int el = gid & 4095, h = (gid >> 12) & 3, db = gid >> 14;
        const size_t hoff = ((size_t)db * NPOS * 4 + h) * 4096 + el; const float* hs = HS + hoff; unsigned short* hso = HSB + hoff; const float* ha = HA + ((size_t)db * NPOS * 4 + h) * 64 + (el & 63);
        float S = 0.f;
        for (int pos = 0; pos < NPOS; pos += 12) { float u[12], a[12];
#pragma unroll
            for (int j = 0; j < 12; ++j) { u[j] = hs[(size_t)(pos + j) * 4 * 4096]; a[j] = ha[(size_t)(pos + j) * 4 * 64]; }
#pragma unroll
            for (int j = 0; j < 12; ++j) { hso[(size_t)(pos + j) * 4 * 4096] = f2bf(S); S = a[j] * S + u[j]; } }
    }
}

DI void attn_item(const Params& p, int l, int idx, ldsp lds, int tid, int lane, int wave) {
    const f16* P = (const f16*)(p.ws + WS_P); const f16* QN = (const f16*)(p.ws + WS_QN); const f16* KN = (const f16*)(p.ws + WS_KN); f16* MIX = (f16*)(p.ws + WS_MIX);
    int b, kvh, qb, isctx;
    if (idx < 1024) { b = idx >> 8; kvh = (idx >> 7) & 1; qb = idx & 127; isctx = 0; } else { const int j = idx - 1024; b = j >> 3; kvh = (j >> 2) & 1; qb = j & 3; isctx = 1; }
    const int q0 = qb * 64; const int qrowbase = isctx ? TL + b * CTXL : b * SEQ;
    const int r32 = lane & 31, hi = lane >> 5; const int hq = kvh * 4 + (wave >> 1); const int qpos = q0 + (wave & 1) * 32 + r32; const size_t qrow = (size_t)qrowbase + qpos;
    LAS f16* KB = (LAS f16*)lds;
    LAS f16* VTB = KB + 2 * 64 * TP;
    f16x8 qr[4];
#pragma unroll
    for (int d0 = 0; d0 < 4; ++d0) qr[d0] = *(const f16x8*)(QN + qrow * 512 + hq * 64 + 16 * d0 + 8 * hi);
    float lsum = hi ? 0.f : __builtin_amdgcn_exp2f(p.attn_sink[l * 8 + hq] * LOG2E - 4.f);
    f32x16 o[2];
#pragma unroll
    for (int r = 0; r < 16; ++r) { o[0][r] = 0.f; o[1][r] = 0.f; }
    const int srow = tid >> 3, sc8 = tid & 7;
    const int ntile = isctx ? 4 : 9;
    int cur = 0; bool have = false; f16x8 kreg, vreg;
    int tix = 0;
#define TILE_VALID(t) (isctx || (t) >= 5 || ((q0 - 128 + 64 * (t)) >= 0 && (q0 - 128 + 64 * (t)) < SEQ))
#define TILE_ROW(t) ((isctx || (t) >= 5) ? (TL + b * CTXL + 64 * (isctx ? (t) : (t) - 5)) : (b * SEQ + q0 - 128 + 64 * (t)))
    while (tix < ntile && !TILE_VALID(tix)) ++tix;
    { const size_t kr = (size_t)TILE_ROW(tix) + srow; kreg = *(const f16x8*)(KN + kr * 128 + kvh * 64 + 8 * sc8); vreg = *(const f16x8*)(P + kr * INC + C_V + kvh * 64 + 8 * sc8); }
    __syncthreads();
    { *(LAS f16x8*)(KB + srow * TP + 8 * sc8) = kreg;
#pragma unroll
      for (int i = 0; i < 8; ++i) VTB[(8 * sc8 + i) * TP + srow] = vreg[i]; }
    __syncthreads();
    while (tix < ntile) {
        int nx = tix + 1; while (nx < ntile && !TILE_VALID(nx)) ++nx;
        have = nx < ntile;
        if (have) { const size_t kr = (size_t)TILE_ROW(nx) + srow; kreg = *(const f16x8*)(KN + kr * 128 + kvh * 64 + 8 * sc8); vreg = *(const f16x8*)(P + kr * INC + C_V + kvh * 64 + 8 * sc8); }
        const LAS f16* Kc = KB + cur * 64 * TP; const LAS f16* Vc = VTB + cur * 64 * TP;
        f32x16 p0, p1;
#pragma unroll
        for (int r = 0; r < 16; ++r) { p0[r] = -4.f; p1[r] = -4.f; }
#pragma unroll
        for (int d0 = 0; d0 < 4; ++d0) { const f16x8 k0 = *(const LAS f16x8*)(Kc + r32 * TP + 16 * d0 + 8 * hi); const f16x8 k1 = *(const LAS f16x8*)(Kc + (32 + r32) * TP + 16 * d0 + 8 * hi);
            p0 = __builtin_amdgcn_mfma_f32_32x32x16_f16(k0, qr[d0], p0, 0, 0, 0); p1 = __builtin_amdgcn_mfma_f32_32x32x16_f16(k1, qr[d0], p1, 0, 0, 0); }
        if (!isctx && (tix == 0 || tix == 4)) { const int kstart = q0 - 128 + 64 * tix;
#pragma unroll
            for (int r = 0; r < 16; ++r) { const int d0_ = qpos - (kstart + crow(r, hi)); if (d0_ > 128 || d0_ < -128) p0[r] = -INFINITY; const int d1_ = d0_ - 32; if (d1_ > 128 || d1_ < -128) p1[r] = -INFINITY; } }
        float ps = 0.f;
#pragma unroll
        for (int r = 0; r < 16; ++r) { p0[r] = __builtin_amdgcn_exp2f(p0[r]); p1[r] = __builtin_amdgcn_exp2f(p1[r]); ps += p0[r] + p1[r]; }
        lsum += ps;
        f16x8 pw[4];
#pragma unroll
        for (int j = 0; j < 8; ++j) { pw[0][j] = (f16)p0[j]; pw[1][j] = (f16)p0[8 + j]; pw[2][j] = (f16)p1[j]; pw[3][j] = (f16)p1[8 + j]; }
#pragma unroll
        for (int s_ = 0; s_ < 4; ++s_) pw[s_] = __builtin_elementwise_min(pw[s_], (f16x8){(f16)65504.f, (f16)65504.f, (f16)65504.f, (f16)65504.f, (f16)65504.f, (f16)65504.f, (f16)65504.f, (f16)65504.f});
#pragma unroll
        for (int d1 = 0; d1 < 2; ++d1)
#pragma unroll
            for (int s = 0; s < 4; ++s) { const LAS f16* vp = Vc + (32 * d1 + r32) * TP + 16 * s + 4 * hi; const f16x4 lo = *(const LAS f16x4*)vp, hv = *(const LAS f16x4*)(vp + 8);
                const f16x8 vf = (f16x8){lo[0], lo[1], lo[2], lo[3], hv[0], hv[1], hv[2], hv[3]};
                o[d1] = __builtin_amdgcn_mfma_f32_32x32x16_f16(vf, pw[s], o[d1], 0, 0, 0); }
        if (have) { LAS f16* Kn = KB + (cur ^ 1) * 64 * TP; LAS f16* Vn = VTB + (cur ^ 1) * 64 * TP;
            *(LAS f16x8*)(Kn + srow * TP + 8 * sc8) = kreg;
#pragma unroll
            for (int i = 0; i < 8; ++i) Vn[(8 * sc8 + i) * TP + srow] = vreg[i]; }
        __syncthreads();
        cur ^= 1; tix = nx;
    }
#undef TILE_VALID
#undef TILE_ROW
    const float lt = lsum + __shfl_xor(lsum, 32); const float il = 1.f / lt;
    f16* orow = MIX + qrow * DM + 256 + hq * 64;
#pragma unroll
    for (int d1 = 0; d1 < 2; ++d1)
#pragma unroll
        for (int g = 0; g < 4; ++g) { f16x4 v;
#pragma unroll
            for (int i = 0; i < 4; ++i) v[i] = (f16)(o[d1][4 * g + i] * il);
            *(f16x4*)(orow + 32 * d1 + 8 * g + 4 * hi) = v; }
}
DI void phase_attn(const Params& p, int l, ldsp lds, int tid, int lane, int wave, int vcu, int G, int rep) {
    unsigned* qc = (unsigned*)(p.ws + WS_CTL) + CW_QUEUE + (l * 2 + rep) * 64; volatile LAS unsigned* slot = (volatile LAS unsigned*)(lds + MISC_OFF) + 16;
    const int nitems = (l == DEPTH - 1) ? 1024 : 1056;
    __syncthreads();
    if (tid == 0) slot[0] = atomicAdd(qc, 1u);
    __syncthreads();
    unsigned it = slot[0];
    while (it < (unsigned)nitems) {
        __syncthreads();
        if (tid == 0) slot[0] = atomicAdd(qc, 1u);
        attn_item(p, l, (int)it, lds, tid, lane, wave);
        __syncthreads();
        it = slot[0];
    }
    __syncthreads();
}

DI void phase_outproj_ctx(const Params& p, int l, int lane, int wave, int vcu, int G, int dry) {
    const f16* MIX = (const f16*)(p.ws + WS_MIX) + (size_t)TL * DM; const f16* W = (const f16*)(p.ws + WS_WOUT) + (size_t)l * DM * DM;
    f16* xd = (f16*)(p.ws + (dry ? WS_DUMMY + 136 * MiB : WS_DELTA)) + (dry ? 0 : (size_t)TL * DM);
    const float* g1 = (const float*)(p.ws + WS_MOD) + ((size_t)l * 5 + 4) * 6144 + 2 * 1024;
    const int fr = lane & 15, fq = lane >> 4;
    for (int it = vcu; it < 256; it += G) { const int r0 = (it >> 4) * 64 + 16 * (wave & 3), c0 = (it & 15) * 64 + 32 * (wave >> 2);
        f32x4 acc[2] = {(f32x4){0.f, 0.f, 0.f, 0.f}, (f32x4){0.f, 0.f, 0.f, 0.f}};
        const f16* ap = MIX + (size_t)(r0 + fr) * DM + 8 * fq; const f16* bp = W + (size_t)(c0 + fr) * DM + 8 * fq;
#pragma unroll 8
        for (int ks = 0; ks < 32; ++ks) { const f16x8 a = *(const f16x8*)(ap + 32 * ks); const f16x8 b0 = *(const f16x8*)(bp + 32 * ks), b1 = *(const f16x8*)(bp + 16 * DM + 32 * ks);
            acc[0] = mma_f16(a, b0, acc[0]); acc[1] = mma_f16(a, b1, acc[1]); }
#pragma unroll
        for (int n = 0; n < 2; ++n) { const int col = c0 + 16 * n + fr; const float gv = g1[col];
#pragma unroll
            for (int i = 0; i < 4; ++i) xd[(size_t)(r0 + 4 * fq + i) * DM + col] = (f16)(gv * acc[n][i]); } }
}

DI void phase_router(const Params& p, int l, ldsp lds, int tid, int lane, int wave, int vcu, int G, int dry) {
    const float* MOD = (const float*)(p.ws + WS_MOD); f16* H = (f16*)(p.ws + (dry ? WS_DUMMY : WS_H)); const float* XC = (const float*)(p.ws + WS_XC); const f16* WRH = (const f16*)(p.ws + WS_WR) + (size_t)l * 48 * 1024; const f16* WRL = WRH + (size_t)DEPTH * 48 * 1024;
    int* SLOT = (int*)(p.ws + (dry ? WS_DUMMY + 88 * MiB : WS_SLOT)); float* GT = (float*)(p.ws + (dry ? WS_DUMMY + 80 * MiB : WS_GATES)); int* LIST = (int*)(p.ws + (dry ? WS_DUMMY + 96 * MiB : WS_LIST)); unsigned* CNT = (unsigned*)(p.ws + WS_CTL) + CW_CNT + l * 32 * 16 + (dry ? 4096 : 0);
    constexpr int XP = 1028;
    LAS float* XT = (LAS float*)lds;
    LAS float* PART = XT + 16 * XP;
    LAS float* LG = PART + 8 * 16 * 48;
    const int fr = lane & 15, fq = lane >> 4;
    f16x8 wh[4][3], wl_[4][3];
#pragma unroll
    for (int ks = 0; ks < 4; ++ks)
#pragma unroll
        for (int n = 0; n < 3; ++n) { const size_t o = (size_t)(16 * n + fr) * 1024 + wave * 128 + 32 * ks + 8 * fq; wh[ks][n] = *(const f16x8*)(WRH + o); wl_[ks][n] = *(const f16x8*)(WRL + o); }
    const int ntiles = (l == DEPTH - 1 ? TL : TT) / 16;
    LAS int* SEL = (LAS int*)(LG + 16 * 48);
    LAS int* BASE = SEL + 64;
    f32x4 v[2][4];
    const float* xsl = (l == 0) ? p.x : p.out; const float* xsc = (l == 0) ? p.ctx : XC; const f16* DL = (const f16*)(p.ws + WS_DELTA);
    float* xwl = dry ? (float*)(p.ws + WS_DUMMY + 8 * MiB) : p.out; float* xwc = dry ? (float*)(p.ws + WS_DUMMY + 8 * MiB) : (float*)(p.ws + WS_XC);
    f16x4 dv[2][4];
#define RT_LOAD(tile_) do { _Pragma("unroll") for (int q = 0; q < 2; ++q) { const int row = (tile_) * 16 + wave + 8 * q; const float* xr_ = (row < TL) ? xsl + (size_t)row * DM : xsc + (size_t)(row - TL) * DM; \
        _Pragma("unroll") for (int j = 0; j < 4; ++j) { v[q][j] = *(const f32x4*)(xr_ + 256 * j + 4 * lane); dv[q][j] = *(const f16x4*)(DL + (size_t)row * DM + 256 * j + 4 * lane); } } } while (0)
#define RT_FLUSH(buf_, row0_) do { if (tid < 32) { const int e = SEL[(buf_) * 32 + tid]; int rank = 0; \
        _Pragma("unroll") for (int j = 0; j < 32; ++j) rank += (j < tid && SEL[(buf_) * 32 + j] == e) ? 1 : 0; \
        const int pos_ = BASE[(buf_) * 32 + e] + rank; const int ent_ = ((row0_) + (tid >> 1)) * 2 + (tid & 1); LIST[(size_t)e * TT + pos_] = ent_; SLOT[ent_] = (e << 20) | pos_; } } while (0)
    int tile = vcu; int cur = 0; int prev_row0 = -1; unsigned pend = 0u; bool pend_valid = false;
    if (tile < ntiles) RT_LOAD(tile);
    for (; tile < ntiles; tile += G, cur ^= 1) {
        const int row0 = tile * 16;
        { float ssum[2];
#pragma unroll
          for (int q = 0; q < 2; ++q) { float s = 0.f; const int row = row0 + wave + 8 * q; float* xw_ = (row < TL) ? xwl + (size_t)(dry ? (row & 1023) : row) * DM : xwc + (size_t)(row - TL) * DM;
#pragma unroll
              for (int j = 0; j < 4; ++j) {
#pragma unroll
                  for (int i = 0; i < 4; ++i) v[q][j][i] += (float)dv[q][j][i];
                  s += v[q][j][0] * v[q][j][0] + v[q][j][1] * v[q][j][1] + v[q][j][2] * v[q][j][2] + v[q][j][3] * v[q][j][3]; }
              ssum[q] = s; }
#pragma unroll
          for (int o = 1; o < 64; o <<= 1) { ssum[0] += __shfl_xor(ssum[0], o); ssum[1] += __shfl_xor(ssum[1], o); }
          const int b = modb_of_row(row0); const float* m2 = MOD + ((size_t)l * 5 + b) * 6144; const float* gn = p.norm2_g + l * DM;
#pragma unroll
          for (int j = 0; j < 4; ++j) { const int c = 256 * j + 4 * lane; const f32x4 g = *(const f32x4*)(gn + c), sh = *(const f32x4*)(m2 + 3 * 1024 + c), sc = *(const f32x4*)(m2 + 4 * 1024 + c);
#pragma unroll
              for (int q = 0; q < 2; ++q) { const int rr = wave + 8 * q; const float r = __builtin_amdgcn_rsqf(ssum[q] * (1.f / DM) + EPS); f32x4 hv; f16x4 o;
#pragma unroll
                  for (int i = 0; i < 4; ++i) { hv[i] = v[q][j][i] * r * g[i] * (1.f + sc[i]) + sh[i]; o[i] = (f16)hv[i]; }
                  *(f16x4*)(H + (size_t)(row0 + rr) * DM + c) = o; *(LAS f32x4*)(XT + rr * XP + c) = hv; } } }
        if (pend_valid) BASE[(cur ^ 1) * 32 + tid] = (int)pend;
        __syncthreads();
        if (tile + G < ntiles) RT_LOAD(tile + G);
        if (prev_row0 >= 0) RT_FLUSH(cur ^ 1, prev_row0);
        { f32x4 acc[3];
#pragma unroll
          for (int n = 0; n < 3; ++n) acc[n] = (f32x4){0.f, 0.f, 0.f, 0.f};
#pragma unroll
          for (int ks = 0; ks < 4; ++ks) { const LAS float* xp = XT + fr * XP + wave * 128 + 32 * ks + 8 * fq; const f32x4 x0 = *(const LAS f32x4*)xp, x1 = *(const LAS f32x4*)(xp + 4);
              f16x8 ah, al;
#pragma unroll
              for (int j = 0; j < 4; ++j) { ah[j] = (f16)x0[j]; al[j] = (f16)(x0[j] - (float)ah[j]); ah[4 + j] = (f16)x1[j]; al[4 + j] = (f16)(x1[j] - (float)ah[4 + j]); }
#pragma unroll
              for (int n = 0; n < 3; ++n) { acc[n] = mma_f16(ah, wh[ks][n], acc[n]); acc[n] = mma_f16(ah, wl_[ks][n], acc[n]); acc[n] = mma_f16(al, wh[ks][n], acc[n]); } }
#pragma unroll
          for (int n = 0; n < 3; ++n)
#pragma unroll
              for (int i = 0; i < 4; ++i) PART[(wave * 16 + 4 * fq + i) * 48 + 16 * n + fr] = acc[n][i] * (1.f / 1024.f); }
        __syncthreads();
        for (int i = tid; i < 16 * 36; i += 512) { const int tk = i / 36, o = i % 36; float s = 0.f;
#pragma unroll
            for (int w = 0; w < 8; ++w) s += PART[(w * 16 + tk) * 48 + o];
            LG[tk * 48 + o] = s + (o < 4 ? p.rgb[l * 4 + o] : p.reb[l * 32 + (o - 4)]); }
        __syncthreads();
        if (tid < 16) { const int row = row0 + tid; const LAS float* lg = LG + tid * 48;
            int g = 0; float gm = lg[0];
#pragma unroll
            for (int j = 1; j < 4; ++j) if (lg[j] > gm) { gm = lg[j]; g = j; }
            float den = 0.f;
#pragma unroll
            for (int j = 0; j < 4; ++j) den += expf(lg[j] - gm);
            const float pg = 1.f / den;
            const LAS float* le = lg + 4 + 8 * g; int e0 = 0; float m0 = le[0];
#pragma unroll
            for (int j = 1; j < 8; ++j) if (le[j] > m0) { m0 = le[j]; e0 = j; }
            int e1 = -1; float m1 = -INFINITY;
#pragma unroll
            for (int j = 0; j < 8; ++j) if (j != e0 && le[j] > m1) { m1 = le[j]; e1 = j; }
            const float w0 = 1.f / (1.f + expf(m1 - m0)), w1 = 1.f - w0;
            *(f32x2*)(GT + row * 2) = (f32x2){pg * w0, pg * w1};
            SEL[cur * 32 + tid * 2] = 8 * g + e0; SEL[cur * 32 + tid * 2 + 1] = 8 * g + e1; }
        __syncthreads();
        pend_valid = false;
        if (tid < 32) { int c = 0;
#pragma unroll
            for (int j = 0; j < 32; ++j) c += (SEL[cur * 32 + j] == tid) ? 1 : 0;
            if (c > 0) { pend = atomicAdd(CNT + tid * 16, (unsigned)c); pend_valid = true; } }
        prev_row0 = row0;
    }
    if (pend_valid) BASE[(cur ^ 1) * 32 + tid] = (int)pend;
    __syncthreads();
    if (prev_row0 >= 0) RT_FLUSH(cur ^ 1, prev_row0);
    __syncthreads();
#undef RT_LOAD
#undef RT_FLUSH
}

DI int moe_setup(const Params& p, int l, ldsp lds, int tid, int G, int bx) {
    LAS int* blk = (LAS int*)(lds + BLK_OFF); LAS int* cnt = blk + 40; LAS int* utab = blk + 80;
    const unsigned* CNT = (const unsigned*)(p.ws + WS_CTL) + CW_CNT + l * 32 * 16;
    if (tid < 32) cnt[tid] = (int)__hip_atomic_load(CNT + tid * 16, __ATOMIC_RELAXED, __HIP_MEMORY_SCOPE_AGENT);
    __syncthreads();
    if (tid == 0) { int a = 0; for (int e = 0; e < 32; ++e) { blk[e] = a; a += (cnt[e] + 255) >> 8; } blk[32] = a; }
    __syncthreads();
    if (tid < 16) { const int Lq = pg8::moe_unit(tid, G, bx, blk[32] * 4); const int L = Lq < 0 ? 0 : Lq; const int rb = L >> 2; int e = 0;
        for (int j = 1; j < NEXP; ++j) e = (blk[j] <= rb) ? j : e;
        utab[tid] = (e << 16) | ((rb - blk[e]) & 0xffff); }
    __syncthreads();
    return blk[32];
}


#if defined(__HIP_DEVICE_COMPILE__)
#define LOADP() Params p; { const __attribute__((address_space(4))) Params* kp_ = (const __attribute__((address_space(4))) Params*)__builtin_amdgcn_kernarg_segment_ptr(); asm volatile("" : "+s"(kp_)); \
    __builtin_memcpy(&p, (const Params*)kp_, sizeof(Params)); }
#else
#define LOADP() Params p = p_unused;
#endif
#define PV() int tid = tid0; asm volatile("" : "+v"(tid)); const int lane = tid & 63, wave = __builtin_amdgcn_readfirstlane(tid >> 6); int G = G0, bx = bx0; asm volatile("" : "+s"(G), "+s"(bx)); \
    const int vcu = (G % 8 == 0) ? (bx % 8) * (G / 8) + bx / 8 : bx; int l = l0; asm volatile("" : "+s"(l)); (void)lane; (void)wave; (void)vcu; (void)l;
#define AMP_T0(n) unsigned long long amp_t0_ = 0; if (AMP_PHASE == (n)) amp_t0_ = __builtin_amdgcn_s_memrealtime();
#define AMP_WAIT(n) if (AMP_PHASE == (n)) { const unsigned long long t1_ = __builtin_amdgcn_s_memrealtime(); const unsigned long long w_ = (t1_ - amp_t0_) * AMP_K; while (__builtin_amdgcn_s_memrealtime() - t1_ < w_) __builtin_amdgcn_s_sleep(8); }
template <int L0> DI void layer_body(const XcdBarrier& bar, ldsp lds, const int tid0, const int G0, const int bx0, const Params& p_unused) {
    constexpr int l0 = L0;


{ AMP_T0(2)
#ifndef SKIP_INPROJ
        for (int rep_ = 0; rep_ < (DUP_PHASE == 2 ? 2 : 1); ++rep_) { LOADP(); PV(); unsigned char* ws = p.ws; pg8::Gemm g{(const f16*)(ws + WS_H), (const f16*)(ws + WS_WIN) + (size_t)l * INC * DM, DM, 0}; pg8::StaticOrder S; S.init(TT, INC, G, bx);
          EpiP E{(f16*)(ws + WS_P), INC};
          pg8::gemm_phase<EpiP, pg8::StaticOrder, true, false>(lds, g, S, E, tid);
          if (l < DEPTH - 1 && rep_ == 0) { const int nu = (TT / 256) * (INC / 256); if ((nu - bx + G - 1) / G < (nu + G - 1) / G) convert_steal(p, l + 1, 2, lds, tid, lane, wave); } }
#endif

        xcd_barrier(bar); AMP_WAIT(2) }

{ AMP_T0(3)
#ifndef SKIP_PREP
        for (int rep_ = 0; rep_ < (DUP_PHASE == 3 ? 2 : 1); ++rep_) { LOADP(); PV(); phase_prep_w(p, l, lds, lane, wave, vcu, G); }
#endif

        xcd_barrier(bar); AMP_WAIT(3) }

{ AMP_T0(5)
#ifndef SKIP_SCAN
        for (int rep_ = (DUP_PHASE == 4 ? 1 : 0); rep_ >= 0; --rep_) { LOADP(); PV(); phase_scan(p, tid, vcu, G, rep_); }
#endif
        xcd_barrier(bar); AMP_WAIT(5) }
{ AMP_T0(6)
#ifndef SKIP_HOUT
        for (int rep_ = 0; rep_ < (DUP_PHASE == 6 ? 2 : 1); ++rep_) { LOADP(); PV(); phase_hgrn_out_w(p, l, lds, lane, wave, vcu, G); }
#endif
#ifndef SKIP_ATTN
        for (int rep_ = 0; rep_ < (DUP_PHASE == 5 ? 2 : 1); ++rep_) { LOADP(); PV(); phase_attn(p, l, lds, tid, lane, wave, vcu, G, rep_); }
#endif
        xcd_barrier(bar); AMP_WAIT(6) }

{ AMP_T0(7)
#ifndef SKIP_OUTPROJ
        for (int rep_ = (DUP_PHASE == 7 ? 1 : 0); rep_ >= 0; --rep_) { LOADP(); PV(); unsigned char* ws = p.ws; pg8::Gemm g{(const f16*)(ws + WS_MIX), (const f16*)(ws + WS_WOUT) + (size_t)l * DM * DM, DM, 0}; pg8::StaticOrder S; S.init(TL, DM, G, bx);
          EpiOut E{(f16*)(ws + (rep_ ? WS_DUMMY : WS_DELTA)), (const float*)(ws + WS_MOD) + (size_t)l * 5 * 6144};
          pg8::gemm_phase<EpiOut, pg8::StaticOrder, true, false>(lds, g, S, E, tid);
          if (l < DEPTH - 1) phase_outproj_ctx(p, l, lane, wave, vcu, G, rep_); }
#endif

        xcd_barrier(bar); AMP_WAIT(7) }

{ AMP_T0(8)
#ifndef SKIP_ROUTER
        for (int rep_ = (DUP_PHASE == 8 ? 1 : 0); rep_ >= 0; --rep_) { LOADP(); PV(); if (l > 0 && rep_ == 0) convert_steal(p, l, 1 << 20, lds, tid, lane, wave); phase_router(p, l, lds, tid, lane, wave, vcu, G, rep_); }
#endif

        xcd_barrier(bar); AMP_WAIT(8) }

{ AMP_T0(9)
#ifndef SKIP_MOE1
        for (int rep_ = 0; rep_ < (DUP_PHASE == 9 ? 2 : 1); ++rep_) { LOADP(); PV(); unsigned char* ws = p.ws; const int nblk = moe_setup(p, l, lds, tid, G, bx);
          pg8::Gemm g{(const f16*)(ws + WS_H), (const f16*)(ws + WS_WGU) + (size_t)l * NEXP * 1024 * 1024, DM, (size_t)1024 * 1024};
          pg8::MoeOrder S{G, bx, nblk, (const LAS int*)(lds + BLK_OFF), (const LAS int*)(lds + BLK_OFF) + 40, (const int*)(ws + WS_LIST), DM * 2, (const LAS int*)(lds + BLK_OFF) + 80};
          EpiMoe1 E{(f16*)(ws + WS_HID)};
          pg8::gemm_phase<EpiMoe1, pg8::MoeOrder, true, true>(lds, g, S, E, tid);
          if (l < DEPTH - 1 && rep_ == 0) { const int nu = nblk * 4; if (pg8::moe_unit((nu + G - 1) / G - 1, G, bx, nu) < 0) convert_steal(p, l + 1, 2, lds, tid, lane, wave); } }
#endif

        xcd_barrier(bar); AMP_WAIT(9) }

{ AMP_T0(10)
#ifndef SKIP_MOE2
        for (int rep_ = 0; rep_ < (DUP_PHASE == 10 ? 2 : 1); ++rep_) { LOADP(); PV(); unsigned char* ws = p.ws; const int nblk = ((const LAS int*)(lds + BLK_OFF))[32];
          pg8::Gemm g{(const f16*)(ws + WS_HID), (const f16*)(ws + WS_WD) + (size_t)l * NEXP * 1024 * 512, EH, (size_t)1024 * 512};
          pg8::MoeOrder S{G, bx, nblk, (const LAS int*)(lds + BLK_OFF), (const LAS int*)(lds + BLK_OFF) + 40, (const int*)(ws + WS_LIST), EH * 2, (const LAS int*)(lds + BLK_OFF) + 80};
          EpiMoe2 E{(f16*)(ws + WS_Y2)};
          pg8::gemm_phase<EpiMoe2, pg8::MoeOrder, true, false>(lds, g, S, E, tid);
          if (l < DEPTH - 1 && rep_ == 0) { const int nu = nblk * 4; if (pg8::moe_unit((nu + G - 1) / G - 1, G, bx, nu) < 0) convert_steal(p, l + 1, 1, lds, tid, lane, wave); } }
#endif

        xcd_barrier(bar); AMP_WAIT(10) }

{ AMP_T0(11)
#ifndef SKIP_COMBINE
        for (int rep_ = (DUP_PHASE == 11 ? 1 : 0); rep_ >= 0; --rep_) { LOADP(); PV(); phase_combine(p, l, lds, lane, wave, vcu, G, rep_); }
#endif

        if (l0 < DEPTH - 1) xcd_barrier(bar); AMP_WAIT(11) }
        if (DUP_PHASE == 13) { for (int q_ = 0; q_ < 8; ++q_) xcd_barrier(bar); }

}

__global__ void __launch_bounds__(512, 2) fwd_kernel(Params p_unused) {
    extern __shared__ __attribute__((aligned(16))) unsigned char lds_raw[];
    ldsp lds = (ldsp)lds_raw;
    const int tid0 = threadIdx.x; const int G0 = gridDim.x; const int bx0 = blockIdx.x;
    const int tid = tid0;
    volatile LAS unsigned* MISC = (volatile LAS unsigned*)(lds + MISC_OFF);
    for (int u = tid; u < (LDS_BYTES - MISC_OFF) / 4; u += 512) ((LAS unsigned*)(lds + MISC_OFF))[u] = 0u;
    __syncthreads();
    XcdBarrier bar;
    { LOADP(); bar = xcd_barrier_post((unsigned*)(p.ws + WS_CTL) + CW_BAR, MISC + 8); }


    const int l0 = 0;
#ifndef SKIP_PROLOGUE
    for (int rep_ = 0; rep_ < (DUP_PHASE == 1 ? 2 : 1); ++rep_) { LOADP(); PV(); phase_prologue(p, lds, tid, lane, wave, vcu, G); __syncthreads(); }
#endif

    xcd_barrier(bar);

#ifndef SKIP_MOD0
        for (int rep_ = 0; rep_ < (DUP_PHASE == 12 ? 2 : 1); ++rep_) { LOADP(); PV(); phase_mod0(p, lane, wave, vcu, G); }
#endif

    xcd_barrier(bar);
    layer_body<0>(bar, lds, tid0, G0, bx0, p_unused); layer_body<1>(bar, lds, tid0, G0, bx0, p_unused); layer_body<2>(bar, lds, tid0, G0, bx0, p_unused); layer_body<3>(bar, lds, tid0, G0, bx0, p_unused);
}

extern "C" void kernel_launch(void* const* d_in, const int* in_sizes, int n_in, void* d_out, int out_size, void* d_ws, size_t ws_size, hipStream_t stream) {
    static int grid = 0;
    if (grid == 0) {
        if (n_in != 24 || out_size != TL * DM || ws_size < WS_END) { fprintf(stderr, "kernel_launch: unexpected shapes (n_in %d, out %d, ws %zu < %zu)\n", n_in, out_size, ws_size, (size_t)WS_END); grid = -1; return; }
        int dev = 0, cus = 0, per_cu = 0;
        if (hipGetDevice(&dev) != hipSuccess || hipDeviceGetAttribute(&cus, hipDeviceAttributeMultiprocessorCount, dev) != hipSuccess) { grid = -1; return; }
        if (hipFuncSetAttribute((const void*)fwd_kernel, hipFuncAttributeMaxDynamicSharedMemorySize, LDS_BYTES) != hipSuccess) { fprintf(stderr, "kernel_launch: hipFuncSetAttribute failed\n"); grid = -1; return; }
        if (hipOccupancyMaxActiveBlocksPerMultiprocessor(&per_cu, (const void*)fwd_kernel, 512, LDS_BYTES) != hipSuccess || per_cu < 1) { fprintf(stderr, "kernel_launch: occupancy query reports %d\n", per_cu); }
        (void)hipGetLastError();
        grid = cus;
    }
    if (grid < 0) return;
    (void)hipMemsetAsync((char*)d_ws + WS_CTL, 0, CTL_ZERO_BYTES, stream);
    Params p{};
    const float** pp = (const float**)&p;
    for (int i = 0; i < 24; ++i) pp[i] = (const float*)d_in[i];
    p.out = (float*)d_out; p.ws = (unsigned char*)d_ws;
    hipLaunchKernelGGL(fwd_kernel, dim3(grid), dim3(512), LDS_BYTES, stream, p);
}
```

```cpp
#include <hip/hip_runtime.h>
#include <cstdio>
#include <cstdint>

#define DI __device__ __forceinline__
#ifndef AMP_PHASE
#define AMP_PHASE 0
#endif
#define AMP_K 4
#ifndef DUP_PHASE
#define DUP_PHASE 0
#endif
#define LAS __attribute__((address_space(3)))
#define GAS __attribute__((address_space(1)))
typedef _Float16 f16;
typedef _Float16 f16x8 __attribute__((ext_vector_type(8)));
typedef _Float16 f16x4 __attribute__((ext_vector_type(4)));
typedef _Float16 f16x2 __attribute__((ext_vector_type(2)));
typedef short s16x8 __attribute__((ext_vector_type(8)));
typedef short s16x4 __attribute__((ext_vector_type(4)));
typedef float f32x4 __attribute__((ext_vector_type(4)));
typedef float f32x2 __attribute__((ext_vector_type(2)));
typedef float f32x16 __attribute__((ext_vector_type(16)));
typedef unsigned u32x4 __attribute__((ext_vector_type(4)));
typedef unsigned u32x2 __attribute__((ext_vector_type(2)));
typedef LAS unsigned char* ldsp;

constexpr int DM = 1024, NB = 4, SEQ = 8192, CTXL = 256, DEPTH = 4;
constexpr int TL = NB * SEQ, TC = NB * CTXL, TT = TL + TC;
constexpr int INC = 2304;
constexpr int C_U = 0, C_Q = 256, C_K = 768, C_V = 896, C_HQ = 1024, C_HI = 1280, C_HZF = 1536, C_HZB = 1792, C_HG = 2048;
constexpr int NEXP = 32, EH = 512;
constexpr int NPOS = 132;
constexpr float EPS = 1e-6f;
constexpr float LOG2E = 1.4426950408889634f;
constexpr int MAXBLK = 296;

constexpr size_t MiB = 1u << 20;
constexpr size_t WS_CTL = 0, CTL_ZERO_BYTES = 1 * MiB;
constexpr size_t WS_WIN = 1 * MiB;
constexpr size_t WS_WOUT = WS_WIN + (size_t)DEPTH * INC * DM * 2;
constexpr size_t WS_WGU = WS_WOUT + (size_t)DEPTH * DM * DM * 2;
constexpr size_t WS_WD = WS_WGU + (size_t)DEPTH * NEXP * 1024 * 1024 * 2;
constexpr size_t WS_POOLW = WS_WD + (size_t)DEPTH * NEXP * 1024 * 512 * 2;
constexpr size_t WS_WR = WS_POOLW + (size_t)DEPTH * 4 * 64 * 64 * 2;
constexpr size_t WS_MOD = WS_WR + (size_t)DEPTH * 1024 * 48 * 4;
constexpr size_t WS_LB = WS_MOD + (size_t)DEPTH * 5 * 6144 * 4;
constexpr size_t WS_ROPE = WS_LB + (size_t)DEPTH * 2 * 256 * 4;
constexpr size_t WS_XC = WS_ROPE + (size_t)(2 * 128 * 16 + 2 * 64 * 16) * 4;
constexpr size_t WS_GATES = WS_XC + (size_t)TC * DM * 4;
constexpr size_t WS_SLOT = WS_GATES + (size_t)TT * 2 * 4;
constexpr size_t WS_LIST = WS_SLOT + (size_t)TT * 2 * 4;
constexpr size_t WS_H = WS_LIST + (size_t)NEXP * TT * 4;
constexpr size_t WS_P = WS_H + (size_t)TT * DM * 2;
constexpr size_t WS_Y2 = WS_P;

constexpr size_t WS_QN = WS_P + (size_t)TT * INC * 2;
constexpr size_t WS_KN = WS_QN + (size_t)TT * 512 * 2;
constexpr size_t WS_MIX = WS_KN + (size_t)TT * 128 * 2;
constexpr size_t WS_HS = WS_MIX + (size_t)TT * DM * 2;
constexpr size_t WS_HA = WS_HS + (size_t)2 * NB * NPOS * 4 * 4096 * 4;
constexpr size_t WS_HSB = WS_HA + (size_t)2 * NB * NPOS * 4 * 64 * 4;
constexpr size_t WS_QS = WS_HSB + (size_t)2 * NB * NPOS * 4 * 4096 * 2;
constexpr size_t WS_DELTA = WS_QS + (size_t)TT * 256 * 2;
constexpr size_t WS_END0 = WS_DELTA + (size_t)TT * DM * 2;
constexpr size_t WS_HID = WS_QN;
constexpr size_t WS_DUMMY = WS_END0;
constexpr size_t WS_END = WS_END0 + (DUP_PHASE ? 144 * MiB : 0);
static_assert((size_t)2 * TT * DM * 2 <= (size_t)TT * INC * 2, "Y2 fits in P");
static_assert(WS_HID + (size_t)MAXBLK * 256 * EH * 2 <= WS_END0, "HID fits in its overlay");
static_assert(WS_WIN % 256 == 0 && WS_H % 256 == 0 && WS_P % 256 == 0 && WS_QN % 256 == 0 && WS_KN % 256 == 0 && WS_MIX % 256 == 0 && WS_HS % 256 == 0 && WS_HA % 256 == 0 && WS_XC % 256 == 0 && WS_LIST % 256 == 0 && WS_GATES % 256 == 0, "alignment");
constexpr int CW_BAR = 4096;
constexpr int CW_QUEUE = 12288;
constexpr int CW_CVQ = 13312;
constexpr int CW_CNT = 16384;
constexpr int RING_BYTES = 131072;
constexpr int MISC_OFF = RING_BYTES;
constexpr int BLK_OFF = MISC_OFF + 512;
constexpr int LDS_BYTES = 147456;

struct Params {
    const float *x, *c, *ctx, *c_ctx, *norm1_g, *norm2_g, *ada_w, *ada_b, *w_in, *w_out, *pool_w, *pool_scale, *q_norm_g, *k_norm_g, *attn_sink, *hgrn_lb,
        *hgrn_norm_g, *rgw, *rgb, *rew, *reb, *ewg, *ewu, *ewd;
    float* out; unsigned char* ws;
};

DI unsigned short f2bf(float f) { unsigned u = __builtin_bit_cast(unsigned, f); return (unsigned short)((u + 0x7fffu + ((u >> 16) & 1u)) >> 16); }
DI float wave_sum(float v) {
#pragma unroll
    for (int o = 1; o < 64; o <<= 1) v += __shfl_xor(v, o);
    return v;
}
DI float fast_rcp(float v) { return __builtin_amdgcn_rcpf(v); }
DI float siluf(float v) { return v * fast_rcp(1.f + __expf(-v)); }
DI unsigned cvt_pk_bf16(float lo, float hi) { unsigned r; asm volatile("v_cvt_pk_bf16_f32 %0, %1, %2" : "=v"(r) : "v"(lo), "v"(hi)); return r; }
DI int modb_of_row(int row) { return row < TL ? (row >> 13) : 4; }

#define XB_TMO      128
#define XB_XCNT(j)  (256  + 64 * (j))
#define XB_XSUB(j)  (1280 + 64 * (j))
#define XB_XGEN(j)  (2304 + 64 * (j))
#define XB_TOP      3328
#define XB_TOPGEN   3392
#define XCD_BAR_WORDS 3456
#define XB_SPIN_CAP (1u << 18)
__device__ __forceinline__ unsigned xb_ld(unsigned* p)              { return __hip_atomic_load(p, __ATOMIC_RELAXED, __HIP_MEMORY_SCOPE_AGENT); }
__device__ __forceinline__ unsigned xb_add(unsigned* p, unsigned v) { return __hip_atomic_fetch_add(p, v, __ATOMIC_RELAXED, __HIP_MEMORY_SCOPE_AGENT); }
__device__ __forceinline__ unsigned xb_xcc_id() { return (unsigned)__builtin_amdgcn_s_getreg((3 << 11) | 20) & 0xFu; }
#define XB_SPIN(cond, bar) do { unsigned _sp = 0; while (cond) { __builtin_amdgcn_s_sleep(1); \
    if ((++_sp & 255u) == 0u) { if (xb_ld(&(bar)[XB_TMO])) break; if (_sp > XB_SPIN_CAP) { atomicAdd(&(bar)[XB_TMO], 1u); break; } } } } while (0)
struct XcdBarrier { unsigned* bar; unsigned x; volatile LAS unsigned* st; };
__device__ __forceinline__ XcdBarrier xcd_barrier_post(unsigned* bar, volatile LAS unsigned* st) {
    XcdBarrier b; b.bar = bar; b.x = xb_xcc_id(); b.st = st;
    if (threadIdx.x == 0) (void)xb_add(&bar[XB_XCNT(b.x)], 1u);
    return b;
}
__device__ __forceinline__ void xcd_barrier_complete(unsigned* bar, unsigned x, unsigned& nloc, unsigned& nx) {
    const unsigned G = gridDim.x * gridDim.y * gridDim.z;
    unsigned sum, cnt, mine, sp = 0u;
    for (;;) {
        sum = 0u; cnt = 0u; mine = 0u;
#pragma unroll 1
        for (unsigned j = 0; j < 16; ++j) { const unsigned c = xb_ld(&bar[XB_XCNT(j)]); sum += c; cnt += (c > 0u) ? 1u : 0u; mine = (j == x) ? c : mine; }
        if (sum == G) break;
        __builtin_amdgcn_s_sleep(1);
        if ((++sp & 255u) == 0u) { if (xb_ld(&bar[XB_TMO])) break; if (sp > XB_SPIN_CAP) { atomicAdd(&bar[XB_TMO], 1u); break; } }
    }
    nloc = mine > 0u ? mine : 1u; nx = cnt > 0u ? cnt : 1u;
}
__device__ __forceinline__ void xcd_barrier(const XcdBarrier& b) {
    asm volatile("s_waitcnt vmcnt(0)" ::: "memory");
    __syncthreads();
    if (threadIdx.x == 0) {
        unsigned* bar = b.bar;
        __builtin_amdgcn_s_waitcnt(0);
        unsigned nloc = b.st[0], nx = b.st[1];
        if (nloc == 0u) { xcd_barrier_complete(bar, b.x, nloc, nx); b.st[0] = nloc; b.st[1] = nx; }
        const unsigned old = xb_add(&bar[XB_XSUB(b.x)], 1u);
        const unsigned gen = old / nloc;
        if (old + 1u == (gen + 1u) * nloc) {
            __builtin_amdgcn_fence(__ATOMIC_RELEASE, "agent");
            asm volatile("s_waitcnt vmcnt(0)" ::: "memory");
            const unsigned og = xb_add(&bar[XB_TOP], 1u);
            const unsigned tg = og / nx;
            if (og + 1u == (tg + 1u) * nx) xb_add(&bar[XB_TOPGEN], 1u);
            else XB_SPIN(xb_ld(&bar[XB_TOPGEN]) == tg, bar);
            __builtin_amdgcn_fence(__ATOMIC_ACQUIRE, "agent");
            xb_add(&bar[XB_XGEN(b.x)], 1u);
            asm volatile("s_waitcnt vmcnt(0)" ::: "memory");
        } else {
            XB_SPIN(xb_ld(&bar[XB_XGEN(b.x)]) == gen, bar);
            __builtin_amdgcn_fence(__ATOMIC_ACQUIRE, "agent");
            asm volatile("s_waitcnt vmcnt(0)" ::: "memory");
        }
    }
    __syncthreads();
}

namespace pg8 {
constexpr int BM = 256, BK = 64, HALF = 128, HTB = HALF * BK * 2, STAGE_BYTES = 8 * HTB, NXCD = 8, WGM = 8;
DI int lds_byte(int r, int c) { const int st = (r >> 4) * 2 + (c >> 5), rr = r & 15, cc = c & 31, ob = rr * 64 + cc * 2; return st * 1024 + (ob ^ (((ob >> 9) & 1) << 5)); }
DI void stage_rc(int b, int& R, int& C) { const int st = b / 1024, sb = b % 1024, swz = sb ^ (((sb >> 9) & 1) << 5); R = (st >> 1) * 16 + swz / 64; C = (st & 1) * 32 + (swz % 64) / 2; }
DI int perm32(int rho) { const int n = rho >> 4, i = rho & 15; return 8 * (i >> 2) + 4 * n + (i & 3); }

struct Unit { int pm, pn, e, lrb; };
struct Gemm { const f16* A; const f16* Bt; int K; size_t bstride; };

struct StaticOrder {
    int nM, nN, nwg, G, c;
    DI void init(int M, int N, int G_, int c_) { nM = M / BM; nN = N / BM; nwg = nM * nN; G = G_; c = c_; }
    DI bool next(int i, Unit& u) const {
        const long L = (long)i * G + c; if (L >= nwg) return false;
        int wgid = (int)L; { const int q = nwg / NXCD, r = nwg % NXCD, xcd = wgid % NXCD, off = wgid / NXCD; wgid = (xcd < r ? xcd * (q + 1) : r * (q + 1) + (xcd - r) * q) + off; }
        const int nig = WGM * nN, gid = wgid / nig, fm = gid * WGM, gsz = (nM - fm) < WGM ? (nM - fm) : WGM;
        u.pm = fm + ((wgid % nig) % gsz); u.pn = (wgid % nig) / gsz; u.e = 0; u.lrb = 0; return true;
    }
    DI unsigned arow(const Unit&, int) const { return 0u; }
};
DI int moe_unit(int i, int G, int c, int U) {
    if (G % 8 != 0) { const int L = i * G + c; return L < U ? L : -1; }
    const int x = c & 7, j = c >> 3, W = G >> 3; const int lo = (int)(((long)U * x) >> 3), hi = (int)(((long)U * (x + 1)) >> 3); const int k = lo + i * W + j; return k < hi ? k : -1;
}
struct MoeOrder {
    int G, c, nblk; const LAS int* blk; const LAS int* cnt; const int* list; int rowbytes;
    const LAS int* utab;
    DI bool next(int i, Unit& u) const {
        const int L = moe_unit(i, G, c, nblk * 4); if (L < 0) return false;
        const int rb = L >> 2; u.pn = L & 3; u.pm = rb;
        const int t = utab[i]; u.e = t >> 16; u.lrb = t & 0xffff; return true;
    }
    DI unsigned arow(const Unit& u, int r) const {
        const int pos = u.lrb * 256 + r; const int ent = (pos < cnt[u.e]) ? list[(size_t)u.e * TT + pos] : 0;
        return (unsigned)(ent >> 1) * (unsigned)rowbytes;
    }
};

template <class Epi, class Sched, bool ALIGN_EPI, bool GATHER>
DI void gemm_phase(ldsp lds, const Gemm g, const Sched& S, const Epi& E, const int tid) {
    const int wid = __builtin_amdgcn_readfirstlane(tid >> 6), lane = tid & 63, wr = wid >> 2, wc = wid & 3, fr = lane & 15, fq = lane >> 4;
    const int K = g.K, nt = K / BK;
    int Rr[2], Cc[2]; unsigned voffB[2], voffA[2];
#pragma unroll
    for (int i = 0; i < 2; ++i) { int R, C; stage_rc(tid * 16 + i * 8192, R, C); const int Rb = Epi::PERM ? ((R & ~31) + perm32(R & 31)) : R;
        Rr[i] = R; Cc[i] = C; voffB[i] = (unsigned)(Rb * K + C) * 2u; voffA[i] = (unsigned)(R * K + C) * 2u; }
    const size_t kstep = (size_t)(BK * 2);
    const size_t hstep = (size_t)HALF * K * 2;
    const size_t tstep = 2 * hstep;
    const unsigned ldsw = (unsigned)wid * 1024u;
    const int aoff = lds_byte(wr * 64 + fr, fq * 8), boff = lds_byte(wc * 32 + fr, fq * 8);
    const char* const Ab = (const char*)g.A;
#define PG8_SA(b, h) (((b) * 2 + (h)) * HTB)
#define PG8_SB(b, h) ((4 + (b) * 2 + (h)) * HTB)
#define PG8_STAGE(bufoff, gbase, voff) do { _Pragma("unroll") for (int _i = 0; _i < 2; ++_i) \
        __builtin_amdgcn_global_load_lds((const unsigned*)((const char*)(gbase) + (voff)[_i]), (LAS unsigned*)(lds + (bufoff) + ldsw + _i * 8192), 16, 0, 0); } while (0)
#define PG8_LDA(dst, b, h) do { _Pragma("unroll") for (int m = 0; m < 4; ++m) _Pragma("unroll") for (int k = 0; k < 2; ++k) dst[m][k] = *(const LAS f16x8*)(lds + PG8_SA(b, h) + aoff + m * 2048 + k * 1024); } while (0)
#define PG8_LDB(dst, b, h) do { _Pragma("unroll") for (int n = 0; n < 2; ++n) _Pragma("unroll") for (int k = 0; k < 2; ++k) dst[n][k] = *(const LAS f16x8*)(lds + PG8_SB(b, h) + boff + n * 2048 + k * 1024); } while (0)
#define PG8_MMA(ai, bj, At, Bt) do { __builtin_amdgcn_s_setprio(1); _Pragma("unroll") for (int m = 0; m < 4; ++m) _Pragma("unroll") for (int n = 0; n < 2; ++n) _Pragma("unroll") for (int k = 0; k < 2; ++k) \
        acc[ai][bj][m][n] = __builtin_amdgcn_mfma_f32_16x16x32_f16(Bt[n][k], At[m][k], acc[ai][bj][m][n], 0, 0, 0); __builtin_amdgcn_s_setprio(0); } while (0)
#define PG8_WAIT_V(n) asm volatile("s_waitcnt vmcnt(" #n ")" ::: "memory")
#define PG8_WAIT_L(n) asm volatile("s_waitcnt lgkmcnt(" #n ")" ::: "memory")
#define PG8_BAR __builtin_amdgcn_s_barrier()
#define PG8_SCHED __builtin_amdgcn_sched_barrier(0)
#define PG8_AOFF(dst, U) do { if constexpr (GATHER) { _Pragma("unroll") for (int _h = 0; _h < 2; ++_h) _Pragma("unroll") for (int _i = 0; _i < 2; ++_i) \
        dst[_h][_i] = S.arow(U, _h * HALF + Rr[_i]) + (unsigned)Cc[_i] * 2u; } } while (0)
#define PG8_STAGE_A(bufoff, kb, nx, h) do { if constexpr (GATHER) { if (nx) PG8_STAGE(bufoff, Ab + (kb), aon[h]); else PG8_STAGE(bufoff, Ab + (kb), aoc[h]); } \
        else { PG8_STAGE(bufoff, ((nx) ? nA : cA) + (kb) + (h) * hstep, voffA); } } while (0)
    Unit cur, nxt; int ui = 0;
    if (!S.next(0, cur)) return;
    f32x4 acc[2][2][4][2];
#pragma unroll
    for (int a = 0; a < 2; ++a)
#pragma unroll
        for (int b = 0; b < 2; ++b)
#pragma unroll
            for (int m = 0; m < 4; ++m)
#pragma unroll
                for (int n = 0; n < 2; ++n) acc[a][b][m][n] = (f32x4){0.f, 0.f, 0.f, 0.f};
    f16x8 At[4][2], B0[2][2], B1[2][2];
    unsigned aoc[2][2], aon[2][2];
    PG8_AOFF(aoc, cur);
    const char* cA = Ab + (GATHER ? (size_t)0 : (size_t)cur.pm * tstep); const char* nA = cA;
    const char* cB = (const char*)g.Bt + ((size_t)cur.e * g.bstride) * 2 + (size_t)cur.pn * tstep;
    PG8_STAGE(PG8_SB(0, 0), cB, voffB); PG8_STAGE(PG8_SB(0, 1), cB + hstep, voffB); PG8_STAGE_A(PG8_SA(0, 0), 0, 0, 0); PG8_STAGE_A(PG8_SA(0, 1), 0, 0, 1);
    if (wr == 1) PG8_BAR;
    PG8_WAIT_V(2); PG8_BAR;
    PG8_STAGE(PG8_SB(1, 0), cB + kstep, voffB); PG8_STAGE_A(PG8_SA(1, 0), kstep, 0, 0); PG8_STAGE(PG8_SB(1, 1), cB + hstep + kstep, voffB);
    PG8_WAIT_V(6); PG8_BAR;
    for (;;) {
        const bool has_next = S.next(ui + 1, nxt);
        if constexpr (GATHER) { if (has_next) { PG8_AOFF(aon, nxt); } else {
#pragma unroll
            for (int _h = 0; _h < 2; ++_h)
#pragma unroll
                for (int _i = 0; _i < 2; ++_i) aon[_h][_i] = aoc[_h][_i]; } }
        else { nA = has_next ? Ab + (size_t)nxt.pm * tstep : cA; }
        const char* nB = has_next ? (const char*)g.Bt + ((size_t)nxt.e * g.bstride) * 2 + (size_t)nxt.pn * tstep : cB;
        for (int t = 0; t < nt; t += 2) {
            const bool last = (t == nt - 2);
            const size_t k1 = (size_t)(t + 1) * kstep, k2 = last ? (size_t)0 : (size_t)(t + 2) * kstep, k3 = k2 + kstep;
            const char* b2 = last ? nB : cB + (size_t)(t + 2) * kstep; const char* b3 = b2 + kstep;
            PG8_LDB(B0, 0, 0); PG8_LDB(B1, 0, 1); PG8_SCHED; PG8_LDA(At, 0, 0); PG8_STAGE_A(PG8_SA(1, 1), k1, 0, 1);
            PG8_WAIT_V(8); PG8_WAIT_L(0); PG8_BAR; PG8_MMA(0, 0, At, B0); PG8_MMA(0, 1, At, B1); PG8_BAR; PG8_SCHED;
            PG8_LDA(At, 0, 1); PG8_STAGE(PG8_SB(0, 0), b2, voffB); PG8_STAGE(PG8_SB(0, 1), b2 + hstep, voffB); PG8_STAGE_A(PG8_SA(0, 0), k2, last, 0);
            PG8_WAIT_V(8); PG8_WAIT_L(0); PG8_BAR; PG8_MMA(1, 0, At, B0); PG8_MMA(1, 1, At, B1); PG8_BAR; PG8_SCHED;
            PG8_LDB(B0, 1, 0); PG8_LDB(B1, 1, 1); PG8_SCHED; PG8_LDA(At, 1, 0); PG8_STAGE_A(PG8_SA(0, 1), k2, last, 1);
            PG8_WAIT_V(8); PG8_WAIT_L(0); PG8_BAR; PG8_MMA(0, 0, At, B0); PG8_MMA(0, 1, At, B1); PG8_BAR; PG8_SCHED;
            PG8_LDA(At, 1, 1); PG8_STAGE(PG8_SB(1, 0), b3, voffB); PG8_STAGE(PG8_SB(1, 1), b3 + hstep, voffB); PG8_STAGE_A(PG8_SA(1, 0), k3, last, 0);
            PG8_WAIT_V(8); PG8_WAIT_L(0); PG8_BAR; PG8_MMA(1, 0, At, B0); PG8_MMA(1, 1, At, B1); PG8_BAR; PG8_SCHED;
        }
        if constexpr (ALIGN_EPI) { if (wr == 0) PG8_BAR; }
        E(acc, cur, wr, wc, fr, fq);
        if (!has_next) break;
#pragma unroll
        for (int a = 0; a < 2; ++a)
#pragma unroll
            for (int b = 0; b < 2; ++b)
#pragma unroll
                for (int m = 0; m < 4; ++m)
#pragma unroll
                    for (int n = 0; n < 2; ++n) acc[a][b][m][n] = (f32x4){0.f, 0.f, 0.f, 0.f};
        cur = nxt; cB = nB; cA = nA; ++ui;
        if constexpr (GATHER) {
#pragma unroll
        for (int _h = 0; _h < 2; ++_h)
#pragma unroll
            for (int _i = 0; _i < 2; ++_i) aoc[_h][_i] = aon[_h][_i]; }
        if constexpr (ALIGN_EPI) { if (wr == 1) PG8_BAR; }
    }
    PG8_WAIT_V(0);
    if constexpr (!ALIGN_EPI) { if (wr == 0) PG8_BAR; }
    PG8_BAR;
#undef PG8_SA
#undef PG8_SB
#undef PG8_STAGE
#undef PG8_LDA
#undef PG8_LDB
#undef PG8_MMA
#undef PG8_WAIT_V
#undef PG8_WAIT_L
#undef PG8_BAR
#undef PG8_SCHED
#undef PG8_AOFF
#undef PG8_STAGE_A
}
}

typedef f32x4 AccT[2][2][4][2];
DI u32x4 pack8_f16(f32x4 a, f32x4 b) {
    f16x8 h; h[0] = (f16)a[0]; h[1] = (f16)a[1]; h[2] = (f16)a[2]; h[3] = (f16)a[3]; h[4] = (f16)b[0]; h[5] = (f16)b[1]; h[6] = (f16)b[2]; h[7] = (f16)b[3];
    return __builtin_bit_cast(u32x4, h);
}
struct EpiP { static constexpr bool PERM = true; f16* O; int ldc;
    DI void operator()(const AccT& acc, const pg8::Unit& u, int wr, int wc, int fr, int fq) const {
        char* base = (char*)(O + (size_t)u.pm * 256 * ldc + u.pn * 256);
        unsigned loff = (unsigned)((wr * 64 + fr) * ldc + wc * 32 + 8 * fq) * 2u;
        asm volatile("" : "+v"(loff));
#pragma unroll
        for (int ai = 0; ai < 2; ++ai)
#pragma unroll
            for (int m = 0; m < 4; ++m) {
#pragma unroll
                for (int bj = 0; bj < 2; ++bj) *(u32x4*)(base + (size_t)((ai * 128 + m * 16) * ldc + bj * 128) * 2 + loff) = pack8_f16(acc[ai][bj][m][0], acc[ai][bj][m][1]); }
    }
};
struct EpiOut { static constexpr bool PERM = true; f16* D; const float* modl;
    DI void operator()(const AccT& acc, const pg8::Unit& u, int wr, int wc, int fr, int fq) const {
        char* base = (char*)(D + (size_t)u.pm * 256 * DM + u.pn * 256);
        const float* g1 = modl + (u.pm < 128 ? (u.pm >> 5) : 4) * 6144 + 2 * 1024 + u.pn * 256;
        unsigned loff = (unsigned)((wr * 64 + fr) * DM + wc * 32 + 8 * fq) * 2u, goff = (unsigned)(wc * 32 + 8 * fq);
        asm volatile("" : "+v"(loff), "+v"(goff));
#pragma unroll
        for (int bj = 0; bj < 2; ++bj) { const f32x4 g0 = *(const f32x4*)(g1 + goff + bj * 128), g4 = *(const f32x4*)(g1 + goff + bj * 128 + 4);
#pragma unroll
            for (int ai = 0; ai < 2; ++ai)
#pragma unroll
                for (int m = 0; m < 4; ++m) *(u32x4*)(base + (size_t)((ai * 128 + m * 16) * DM + bj * 128) * 2 + loff) = pack8_f16(acc[ai][bj][m][0] * g0, acc[ai][bj][m][1] * g4); }
    }
};
struct EpiMoe1 { static constexpr bool PERM = true; f16* HID;
    DI void operator()(const AccT& acc, const pg8::Unit& u, int wr, int wc, int fr, int fq) const {
        char* base = (char*)(HID + (size_t)u.pm * 256 * EH + u.pn * 128);
        unsigned loff = (unsigned)((wr * 64 + fr) * EH + wc * 32 + 8 * fq) * 2u;
        asm volatile("" : "+v"(loff));
#pragma unroll
        for (int ai = 0; ai < 2; ++ai)
#pragma unroll
            for (int m = 0; m < 4; ++m) { f32x4 h0, h1;
#pragma unroll
                for (int i = 0; i < 4; ++i) { h0[i] = siluf(acc[ai][0][m][0][i]) * acc[ai][1][m][0][i]; h1[i] = siluf(acc[ai][0][m][1][i]) * acc[ai][1][m][1][i]; }
                *(u32x4*)(base + (size_t)((ai * 128 + m * 16) * EH) * 2 + loff) = pack8_f16(h0, h1); }
    }
};
struct EpiMoe2 { static constexpr bool PERM = true; f16* Y2;
    DI void operator()(const AccT& acc, const pg8::Unit& u, int wr, int wc, int fr, int fq) const {
        char* base = (char*)(Y2 + (size_t)u.pm * 256 * DM + u.pn * 256);
        unsigned loff = (unsigned)((wr * 64 + fr) * DM + wc * 32 + 8 * fq) * 2u;
        asm volatile("" : "+v"(loff));
#pragma unroll
        for (int ai = 0; ai < 2; ++ai)
#pragma unroll
            for (int m = 0; m < 4; ++m) {
#pragma unroll
                for (int bj = 0; bj < 2; ++bj) *(u32x4*)(base + (size_t)((ai * 128 + m * 16) * DM + bj * 128) * 2 + loff) = pack8_f16(acc[ai][bj][m][0], acc[ai][bj][m][1]); }
    }
};

DI void p0_transpose_item(const float* W, int K, int N, f16* WT, int mode, LAS float* scr, int item, int lane) {
    const int nblk = N / 32, kb = item / nblk, nb = item % nblk, k0 = 64 * kb, n0 = 32 * nb;
    const int rbase = (mode == 0) ? n0 : (256 * (n0 >> 7) + (n0 & 127) + (mode == 2 ? 128 : 0));
#pragma unroll 8
    for (int i = 0; i < 32; ++i) { const int kk = 2 * i + (lane >> 5); scr[kk * 33 + (lane & 31)] = W[(size_t)(k0 + kk) * N + n0 + (lane & 31)]; }
    asm volatile("s_waitcnt lgkmcnt(0)" ::: "memory");
    const int c = lane & 7;
#pragma unroll
    for (int j = 0; j < 4; ++j) { const int n = (lane >> 3) + 8 * j; const LAS float* s = scr + (8 * c) * 33 + n;
        f16x8 o;
#pragma unroll
        for (int q = 0; q < 8; ++q) o[q] = (f16)s[q * 33];
        *(f16x8*)(WT + (size_t)(rbase + n) * K + k0 + 8 * c) = o; }
    asm volatile("s_waitcnt lgkmcnt(0)" ::: "memory");
}

constexpr int CV_CHUNKS = 768;
DI void expert_item(const Params& p, int l, int r, LAS float* scr, int lane) {
    unsigned char* ws = p.ws; const int e = r / 768, q = r % 768, which = q >> 8, item = q & 255; const size_t le = (size_t)l * NEXP + e;
    if (which == 0) p0_transpose_item(p.ewg + le * DM * EH, DM, EH, (f16*)(ws + WS_WGU) + le * 1024 * 1024, 1, scr, item, lane);
    else if (which == 1) p0_transpose_item(p.ewu + le * DM * EH, DM, EH, (f16*)(ws + WS_WGU) + le * 1024 * 1024, 2, scr, item, lane);
    else p0_transpose_item(p.ewd + le * EH * DM, EH, DM, (f16*)(ws + WS_WD) + le * 1024 * 512, 0, scr, item, lane);
}
DI void convert_steal(const Params& p, int l, int maxpull, ldsp lds, int tid, int lane, int wave) {
    unsigned* qh = (unsigned*)(p.ws + WS_CTL) + CW_CVQ + l * 64; volatile LAS unsigned* slot = (volatile LAS unsigned*)(lds + MISC_OFF) + 24;
    LAS float* scr = (LAS float*)(lds + wave * 16384);
    for (int k = 0; k < maxpull; ++k) {
        __syncthreads();
        if (tid == 0) slot[0] = atomicAdd(qh, 1u);
        __syncthreads();
        const unsigned c = slot[0];
        if (c >= (unsigned)CV_CHUNKS) break;
#pragma unroll 1
        for (int j = 0; j < 4; ++j) expert_item(p, l, (int)c * 32 + wave * 4 + j, scr, lane);
    }
    __syncthreads();
}

DI void phase_prologue(const Params& p, ldsp lds, int tid, int lane, int wave, int vcu, int G) {
    unsigned char* ws = p.ws;
    LAS float* scr = (LAS float*)(lds + wave * 16384);
    const int gw = vcu * 8 + wave, NGW = G * 8;
    constexpr int PER_L = 1152 + 512;
    constexpr int NW_ITEMS = DEPTH * PER_L;
    for (int it = gw; it < NW_ITEMS + 32; it += NGW) {
        if (it >= NW_ITEMS) { const int j = it - NW_ITEMS, mat = j >> 1;
            p0_transpose_item(p.pool_w + (size_t)mat * 4096, 64, 64, (f16*)(ws + WS_POOLW) + (size_t)mat * 4096, 0, scr, j & 1, lane); continue; }
        const int l = it / PER_L; int r = it % PER_L;
        if (r < 1152) { p0_transpose_item(p.w_in + (size_t)l * DM * INC, DM, INC, (f16*)(ws + WS_WIN) + (size_t)l * INC * DM, 0, scr, r, lane); continue; } r -= 1152;
        p0_transpose_item(p.w_out + (size_t)l * DM * DM, DM, DM, (f16*)(ws + WS_WOUT) + (size_t)l * DM * DM, 0, scr, r, lane);
    }
    for (int it = gw; it < 32 * 768; it += NGW) expert_item(p, 0, it, scr, lane);
    { f16* WRH = (f16*)(ws + WS_WR); f16* WRL = WRH + (size_t)DEPTH * 48 * 1024;
      for (int i = vcu * 512 + tid; i < DEPTH * 48 * 1024; i += G * 512) { const int k = i & 1023, o = (i >> 10) % 48, l = i / (48 * 1024);
          float v = 0.f; if (o < 4) v = p.rgw[((size_t)l * 1024 + k) * 4 + o]; else if (o < 36) v = p.rew[((size_t)l * 1024 + k) * 32 + (o - 4)];
          v *= 1024.f; const f16 hi = (f16)v; WRH[i] = hi; WRL[i] = (f16)(v - (float)hi); } }
    { float* RT = (float*)(ws + WS_ROPE);
      for (int i = vcu * 512 + tid; i < (128 + 64) * 16; i += G * 512) { const int m = i & 15, pos = i >> 4;
          const float inv = powf(10000.f, -(float)m / 16.f); const float ang = (float)(pos < 128 ? pos : pos - 128) * inv; float s, c; sincosf(ang, &s, &c);
          if (pos < 128) { RT[pos * 16 + m] = c; RT[2048 + pos * 16 + m] = s; } else { RT[4096 + (pos - 128) * 16 + m] = c; RT[4096 + 1024 + (pos - 128) * 16 + m] = s; } } }
    if (vcu == 0) { float* LB = (float*)(ws + WS_LB);
        const float a0 = p.hgrn_lb[tid], a1 = p.hgrn_lb[512 + tid], a2 = p.hgrn_lb[1024 + tid], a3 = p.hgrn_lb[1536 + tid];
        const float mx = fmaxf(fmaxf(a0, a1), fmaxf(a2, a3)); const float e0 = expf(a0 - mx), e1 = expf(a1 - mx), e2 = expf(a2 - mx), e3 = expf(a3 - mx); const float inv = 1.f / (e0 + e1 + e2 + e3);
        LB[tid] = 0.f; LB[512 + tid] = e1 * inv; LB[1024 + tid] = (e1 + e2) * inv; LB[1536 + tid] = (e1 + e2 + e3) * inv; }
    __syncthreads();
    { LAS float* sl = (LAS float*)lds;
      LAS float* red = (LAS float*)(lds + 32768);
      for (int i = tid; i < 5 * 1024; i += 512) { const int b = i >> 10, k = i & 1023; const float v = (b < 4) ? p.c[b * 1024 + k] : p.c_ctx[k]; sl[i] = siluf(v); }
      __syncthreads();
      float* MOD = (float*)(ws + WS_MOD);
      for (int it = vcu; it < DEPTH * 96; it += G) { const int l = it / 96, col = (it % 96) * 64 + lane;
          const float* W = p.ada_w + (size_t)l * 1024 * 6144 + col; float a[5] = {0.f, 0.f, 0.f, 0.f, 0.f};
#pragma unroll 8
          for (int k = wave * 128; k < wave * 128 + 128; ++k) { const float w = W[(size_t)k * 6144];
#pragma unroll
              for (int b = 0; b < 5; ++b) a[b] += sl[b * 1024 + k] * w; }
#pragma unroll
          for (int b = 0; b < 5; ++b) red[(wave * 5 + b) * 64 + lane] = a[b];
          __syncthreads();
          if (tid < 320) { const int b = tid >> 6, cc = tid & 63; float s = 0.f;
#pragma unroll
              for (int w = 0; w < 8; ++w) s += red[(w * 5 + b) * 64 + cc];
              const int c2 = (it % 96) * 64 + cc; MOD[((size_t)l * 5 + b) * 6144 + c2] = s + p.ada_b[l * 6144 + c2]; }
          __syncthreads(); } }
}

DI void modulate_row_store(const f32x4 (&v)[4], float r, const float* gn, const float* sh, const float* sc, f16* hrow, int lane) {
#pragma unroll
    for (int j = 0; j < 4; ++j) { const int c = 256 * j + 4 * lane; const f32x4 g = *(const f32x4*)(gn + c), s = *(const f32x4*)(sh + c), k = *(const f32x4*)(sc + c);
        f16x4 o;
#pragma unroll
        for (int i = 0; i < 4; ++i) o[i] = (f16)(v[j][i] * r * g[i] * (1.f + k[i]) + s[i]);
        *(f16x4*)(hrow + c) = o; }
}
DI void phase_mod0(const Params& p, int lane, int wave, int vcu, int G) {
    const float* MOD = (const float*)(p.ws + WS_MOD); f16* H = (f16*)(p.ws + WS_H);
    for (int row = vcu * 8 + wave; row < TT; row += G * 8) {
        const float* xr = (row < TL) ? p.x + (size_t)row * DM : p.ctx + (size_t)(row - TL) * DM; const int b = modb_of_row(row);
        f32x4 v[4]; float s = 0.f;
#pragma unroll
        for (int j = 0; j < 4; ++j) { v[j] = *(const f32x4*)(xr + 256 * j + 4 * lane); s += v[j][0] * v[j][0] + v[j][1] * v[j][1] + v[j][2] * v[j][2] + v[j][3] * v[j][3]; }
        const float r = __builtin_amdgcn_rsqf(wave_sum(s) * (1.f / DM) + EPS);
        modulate_row_store(v, r, p.norm1_g, MOD + (size_t)b * 6144, MOD + (size_t)b * 6144 + 1024, H + (size_t)row * DM, lane);
    }
}
DI void phase_combine(const Params& p, int l, ldsp lds, int lane, int wave, int vcu, int G, int dry) {
    const LAS int* blk = (const LAS int*)(lds + BLK_OFF); const int* SLOT = (const int*)(p.ws + WS_SLOT);
    const float* MOD = (const float*)(p.ws + WS_MOD); f16* H = (f16*)(p.ws + (dry ? WS_DUMMY + 64 * MiB : WS_H)); const f16* Y2 = (const f16*)(p.ws + WS_Y2); const float* GT = (const float*)(p.ws + WS_GATES);
    float* XC = (float*)(p.ws + WS_XC);
    const int nrows = (l == DEPTH - 1) ? TL : TT; const int NGW = G * 8;
    for (int row0 = vcu * 8 + wave; row0 < nrows; row0 += 2 * NGW) {
        f32x4 v[2][4]; f16x4 ya[2][4], yb[2][4], dv[2][4]; float ga[2], gb[2]; int rows[2]; bool ok[2];
#pragma unroll
        for (int q = 0; q < 2; ++q) { const int rr = row0 + q * NGW; ok[q] = rr < nrows; const int row = ok[q] ? rr : row0; rows[q] = row;
            const float* xr = (row < TL) ? (l == 0 ? p.x : p.out) + (size_t)row * DM : (l == 0 ? p.ctx : XC) + (size_t)(row - TL) * DM; const f16* dl = (const f16*)(p.ws + WS_DELTA) + (size_t)row * DM;
            const int s0 = SLOT[row * 2], s1 = SLOT[row * 2 + 1]; const f16* y0 = Y2 + ((size_t)blk[s0 >> 20] * 256 + (s0 & 0xfffff)) * DM; const f16* y1 = Y2 + ((size_t)blk[s1 >> 20] * 256 + (s1 & 0xfffff)) * DM;
            ga[q] = GT[row * 2]; gb[q] = GT[row * 2 + 1];
#pragma unroll
            for (int j = 0; j < 4; ++j) { const int c = 256 * j + 4 * lane; v[q][j] = *(const f32x4*)(xr + c); dv[q][j] = *(const f16x4*)(dl + c); ya[q][j] = *(const f16x4*)(y0 + c); yb[q][j] = *(const f16x4*)(y1 + c); } }
        float ssum[2];
#pragma unroll
        for (int q = 0; q < 2; ++q) { const int row = rows[q]; const int b = modb_of_row(row); const float* g2 = MOD + ((size_t)l * 5 + b) * 6144 + 5 * 1024;
            float* xr = (row < TL) ? p.out + (size_t)row * DM : XC + (size_t)(row - TL) * DM; float* xw = dry ? (float*)(p.ws + WS_DUMMY) + (size_t)(row & 8191) * DM : xr; float s = 0.f;
#pragma unroll
            for (int j = 0; j < 4; ++j) { const int c = 256 * j + 4 * lane; const f32x4 g = *(const f32x4*)(g2 + c);
#pragma unroll
                for (int i = 0; i < 4; ++i) v[q][j][i] = (v[q][j][i] + (float)dv[q][j][i]) + g[i] * (ga[q] * (float)ya[q][j][i] + gb[q] * (float)yb[q][j][i]);
                if (ok[q]) *(f32x4*)(xw + c) = v[q][j];
                s += v[q][j][0] * v[q][j][0] + v[q][j][1] * v[q][j][1] + v[q][j][2] * v[q][j][2] + v[q][j][3] * v[q][j][3]; }
            ssum[q] = s; }
        if (l < DEPTH - 1) {
#pragma unroll
            for (int o = 1; o < 64; o <<= 1) { ssum[0] += __shfl_xor(ssum[0], o); ssum[1] += __shfl_xor(ssum[1], o); }
#pragma unroll
            for (int q = 0; q < 2; ++q) if (ok[q]) { const int row = rows[q]; const int b = modb_of_row(row); const float r = __builtin_amdgcn_rsqf(ssum[q] * (1.f / DM) + EPS); const float* m1 = MOD + ((size_t)(l + 1) * 5 + b) * 6144;
                modulate_row_store(v[q], r, p.norm1_g + (l + 1) * DM, m1, m1 + 1024, H + (size_t)row * DM, lane); } }
    }
}

DI f32x4 mma_f16(f16x8 a, f16x8 b, f32x4 c) { return __builtin_amdgcn_mfma_f32_16x16x32_f16(a, b, c, 0, 0, 0); }
DI f32x4 mma_bf16(s16x8 a, s16x8 b, f32x4 c) { return __builtin_amdgcn_mfma_f32_16x16x32_bf16(a, b, c, 0, 0, 0); }

constexpr int TP = 72;
struct TileInfo { int row0, t0, seqrow0, len, b, isctx, chunkpos_f, chunkpos_b; };
DI TileInfo tile_info(int tt) {
    TileInfo ti;
    if (tt < 512) { ti.b = tt >> 7; ti.t0 = (tt & 127) * 64; ti.seqrow0 = ti.b * SEQ; ti.len = SEQ; ti.isctx = 0; ti.chunkpos_f = 4 + (tt & 127); ti.chunkpos_b = 4 + 127 - (tt & 127); }
    else { const int j = tt - 512; ti.b = j >> 2; ti.t0 = (j & 3) * 64; ti.seqrow0 = TL + ti.b * CTXL; ti.len = CTXL; ti.isctx = 1; ti.chunkpos_f = (j & 3); ti.chunkpos_b = 3 - (j & 3); }
    ti.row0 = ti.seqrow0 + ti.t0; return ti;
}

typedef short v4i16_t __attribute__((ext_vector_type(4)));
DI int crow(int r, int hi) { return (r & 3) + 8 * (r >> 2) + 4 * hi; }
DI int swz(int row, int col) { return row * 64 + ((((col >> 3) ^ (row & 7)) << 3) | (col & 7)); }
DI s16x4 tr_read(const LAS unsigned short* p) { return __builtin_bit_cast(s16x4, __builtin_amdgcn_ds_read_tr16_b64_v4i16((LAS v4i16_t*)p)); }
#define LGKM0() asm volatile("s_waitcnt lgkmcnt(0)" ::: "memory")
DI void wave_load_tile64(LAS unsigned short* T, const f16* src, int pitch, int lane) {
    const int c = lane & 7;
    unsigned lo = (unsigned)((lane >> 3) * pitch + 8 * c) * 2u;
    asm volatile("" : "+v"(lo));
    const char* base = (const char*)src;
#pragma unroll
    for (int it = 0; it < 8; ++it) { const int row = 8 * it + (lane >> 3); const u32x4 v = *(const u32x4*)(base + (size_t)it * 8 * pitch * 2 + lo); *(LAS u32x4*)(T + row * 64 + ((c ^ (row & 7)) << 3)) = v; }
}
DI s16x8 tr_frag16(const LAS unsigned short* T, int k0, int n0, int lane) {
    const int g = lane >> 4, i = lane & 15, q = i >> 2, pp = i & 3; const int r0 = k0 + 8 * g + q;
    const s16x4 a = tr_read(T + swz(r0, n0 + 4 * pp)), b = tr_read(T + swz(r0 + 4, n0 + 4 * pp));
    return (s16x8){a[0], a[1], a[2], a[3], b[0], b[1], b[2], b[3]};
}

template <int CTRL, int RMASK> DI float dpp_add0(float v) { return __builtin_bit_cast(float, __builtin_amdgcn_update_dpp(0, __builtin_bit_cast(int, v), CTRL, RMASK, 0xf, true)); }
DI float bcast_lane(float v, int srclane) { return __builtin_bit_cast(float, __builtin_amdgcn_readlane(__builtin_bit_cast(int, v), srclane)); }
template <int CTRL, int RMASK> DI float dpp_mul1(float v) { return __builtin_bit_cast(float, __builtin_amdgcn_update_dpp(0x3f800000, __builtin_bit_cast(int, v), CTRL, RMASK, 0xf, false)); }
DI float wave_scan_mul(float v) {
    v *= dpp_mul1<0x111, 0xf>(v); v *= dpp_mul1<0x112, 0xf>(v); v *= dpp_mul1<0x114, 0xf>(v); v *= dpp_mul1<0x118, 0xf>(v);
    v *= dpp_mul1<0x142, 0xa>(v); v *= dpp_mul1<0x143, 0xc>(v);
    return v;
}
#define SCAN8_STEP(ctrl) \
    "v_mul_f32_dpp %0, %0, %0 " ctrl "\n\tv_mul_f32_dpp %1, %1, %1 " ctrl "\n\tv_mul_f32_dpp %2, %2, %2 " ctrl "\n\tv_mul_f32_dpp %3, %3, %3 " ctrl "\n\t" \
    "v_mul_f32_dpp %4, %4, %4 " ctrl "\n\tv_mul_f32_dpp %5, %5, %5 " ctrl "\n\tv_mul_f32_dpp %6, %6, %6 " ctrl "\n\tv_mul_f32_dpp %7, %7, %7 " ctrl "\n\t"
DI void wave_scan_mul8(float (&g)[8]) {
    asm volatile("s_nop 1\n\t"
        SCAN8_STEP("row_shr:1 row_mask:0xf bank_mask:0xf") SCAN8_STEP("row_shr:2 row_mask:0xf bank_mask:0xf") SCAN8_STEP("row_shr:4 row_mask:0xf bank_mask:0xf")
        SCAN8_STEP("row_shr:8 row_mask:0xf bank_mask:0xf") SCAN8_STEP("row_bcast:15 row_mask:0xa bank_mask:0xf") SCAN8_STEP("row_bcast:31 row_mask:0xc bank_mask:0xf")
        "s_nop 1"
        : "+v"(g[0]), "+v"(g[1]), "+v"(g[2]), "+v"(g[3]), "+v"(g[4]), "+v"(g[5]), "+v"(g[6]), "+v"(g[7]));
}
DI void hgrn_state_wave(const Params& p, int l, int item, LAS unsigned short* wl, int lane) {
    const int dir = item & 1, h = (item >> 1) & 3; const TileInfo ti = tile_info(item >> 3);
    const f16* P = (const f16*)(p.ws + WS_P); float* HS = (float*)(p.ws + WS_HS); float* HA = (float*)(p.ws + WS_HA);
    LAS unsigned short* Z = wl; LAS unsigned short* V = wl + 4096;
    const f16* prow = P + (size_t)ti.row0 * INC + h * 64;
    wave_load_tile64(Z, prow + (dir ? C_HZB : C_HZF), INC, lane); wave_load_tile64(V, prow + C_HI, INC, lane);
    const float* lbp = (const float*)(p.ws + WS_LB) + l * 512 + dir * 256 + h * 64;
    const int pos = dir ? ti.chunkpos_b : ti.chunkpos_f; const size_t slot = (size_t)((dir * NB + ti.b) * NPOS + pos) * 4 + h;
    float amine = 0.f;
    const int s_ = dir ? 63 - lane : lane;
    LGKM0();
#pragma unroll 1
    for (int c = 0; c < 8; ++c) { float g[8], kk[8]; LAS f16x8* zp = (LAS f16x8*)(Z + s_ * 64 + ((c ^ (s_ & 7)) << 3)); const f16x8 zv = *zp;
#pragma unroll
        for (int j = 0; j < 8; ++j) { const float lb = lbp[8 * c + j]; const float z = (float)zv[j]; const float sg = fast_rcp(1.f + __expf(-z)); g[j] = lb + (1.f - lb) * sg; kk[j] = (1.f - lb) * (1.f - sg); }
        wave_scan_mul8(g);
#pragma unroll
        for (int j = 0; j < 8; ++j) g[j] = fmaxf(g[j], 1e-37f);
        f16x8 ko;
#pragma unroll
        for (int j = 0; j < 8; ++j) { const float pend = bcast_lane(g[j], 63); ko[j] = (f16)(kk[j] * pend * fast_rcp(g[j])); amine = (lane == 8 * c + j) ? pend : amine; }
        *zp = ko; }
    HA[slot * 64 + lane] = amine;
    LGKM0();
    f32x4 acc[4][4];
#pragma unroll
    for (int m = 0; m < 4; ++m)
#pragma unroll
        for (int n = 0; n < 4; ++n) acc[m][n] = (f32x4){0.f, 0.f, 0.f, 0.f};
#pragma unroll
    for (int ks = 0; ks < 2; ++ks) { s16x8 a[4], b[4];
#pragma unroll
        for (int m = 0; m < 4; ++m) { a[m] = tr_frag16(V, 32 * ks, 16 * m, lane); b[m] = tr_frag16(Z, 32 * ks, 16 * m, lane); }
#pragma unroll
        for (int m = 0; m < 4; ++m)
#pragma unroll
            for (int n = 0; n < 4; ++n) acc[m][n] = mma_f16(__builtin_bit_cast(f16x8, a[m]), __builtin_bit_cast(f16x8, b[n]), acc[m][n]); }
    float* dst = HS + slot * 4096; const int fr = lane & 15, fq = lane >> 4;
#pragma unroll
    for (int m = 0; m < 4; ++m)
#pragma unroll
        for (int n = 0; n < 4; ++n)
#pragma unroll
            for (int i = 0; i < 4; ++i) dst[(16 * m + 4 * fq + i) * 64 + 16 * n + fr] = acc[m][n][i];
    LGKM0();
}

DI void qk_wave(const Params& p, int l, int pair8, int lane) {
    const f16* P = (const f16*)(p.ws + WS_P); f16* QN = (f16*)(p.ws + WS_QN); f16* KN = (f16*)(p.ws + WS_KN); const float* RT = (const float*)(p.ws + WS_ROPE);
    const int j8 = lane & 7; const int pidx = pair8 * 8 + (lane >> 3); const int row = pidx / 10, hh = pidx % 10;
    const f16x8 raw = *(const f16x8*)(P + (size_t)row * INC + C_Q + hh * 64 + 8 * j8);
    const bool lat = row < TL; const int t = lat ? (row & (SEQ - 1)) : 0; const int prow = t >> 6, pcol = t & 63; const int a0 = (8 * j8) & 31;
    const float* ct = (a0 < 16) ? RT + prow * 16 + a0 : RT + 4096 + pcol * 16 + (a0 - 16);
    const float* st = (a0 < 16) ? RT + 2048 + prow * 16 + a0 : RT + 4096 + 1024 + pcol * 16 + (a0 - 16);
    const float* gn = (hh < 8 ? p.q_norm_g : p.k_norm_g) + l * 64 + 8 * j8;
    const f32x4 c0 = *(const f32x4*)ct, c1 = *(const f32x4*)(ct + 4), s0 = *(const f32x4*)st, s1 = *(const f32x4*)(st + 4), g0 = *(const f32x4*)gn, g1 = *(const f32x4*)(gn + 4);
    float v[8]; float s = 0.f;
#pragma unroll
    for (int i = 0; i < 8; ++i) { v[i] = (float)raw[i]; s += v[i] * v[i]; }
    s += __shfl_xor(s, 1); s += __shfl_xor(s, 2); s += __shfl_xor(s, 4);
    const float r = __builtin_amdgcn_rsqf(s * (1.f / 64.f) + EPS) * ((hh < 8) ? 0.125f * LOG2E : 1.f);
    const float sgn = (j8 < 4) ? -1.f : 1.f;
    f16x8 o;
#pragma unroll
    for (int i = 0; i < 8; ++i) { const float gi = (i < 4) ? g0[i & 3] : g1[i & 3]; const float ci = lat ? ((i < 4) ? c0[i & 3] : c1[i & 3]) : 1.f, si = lat ? ((i < 4) ? s0[i & 3] : s1[i & 3]) * sgn : 0.f;
        v[i] = v[i] * r * gi; const float ot = __shfl_xor(v[i], 4); o[i] = (f16)(v[i] * ci + ot * si); }
    if (hh < 8) *(f16x8*)(QN + (size_t)row * 512 + hh * 64 + 8 * j8) = o; else *(f16x8*)(KN + (size_t)row * 128 + (hh - 8) * 64 + 8 * j8) = o;
}

DI void pool_wave(const Params& p, int l, int item, LAS unsigned short* wl, int lane) {
    const int g = item & 3; const TileInfo ti = tile_info(item >> 2); const int w = 2 << g;
    const f16* P = (const f16*)(p.ws + WS_P); f16* MIX = (f16*)(p.ws + WS_MIX); const f16* PW = (const f16*)(p.ws + WS_POOLW) + ((size_t)l * 4 + g) * 4096;
    { const int c = lane & 7;
#pragma unroll
      for (int it = 0; it < 10; ++it) { const int row = 8 * it + (lane >> 3); const int t = ti.t0 - 8 + row; u32x4 v = (u32x4){0u, 0u, 0u, 0u};
          if (t >= 0 && t < ti.len) v = *(const u32x4*)(P + (size_t)(ti.seqrow0 + t) * INC + C_U + g * 64 + 8 * c);
          *(LAS u32x4*)(wl + row * 64 + ((c ^ (row & 7)) << 3)) = v; } }
    LGKM0();
    const int fr = lane & 15, fq = lane >> 4;
    f32x4 acc[4][4];
#pragma unroll
    for (int m = 0; m < 4; ++m)
#pragma unroll
        for (int n = 0; n < 4; ++n) acc[m][n] = (f32x4){0.f, 0.f, 0.f, 0.f};
#pragma unroll
    for (int ks = 0; ks < 2; ++ks) { f16x8 bfr[4];
#pragma unroll
        for (int n = 0; n < 4; ++n) bfr[n] = *(const f16x8*)(PW + (n * 16 + fr) * 64 + 32 * ks + 8 * fq);
#pragma unroll
        for (int m = 0; m < 4; ++m) { const int tk = 16 * m + fr, t = ti.t0 + tk; const int ch = 4 * ks + fq;
            float sum[8] = {0.f, 0.f, 0.f, 0.f, 0.f, 0.f, 0.f, 0.f}; int cnt = 0;
            for (int off = -((w - 1) / 2); off <= w / 2; ++off) { const int q = t + off; const int row = tk + off + 8;
                const f16x8 v = *(const LAS f16x8*)(wl + row * 64 + ((ch ^ (row & 7)) << 3)); const bool ok = (q >= 0 && q < ti.len); cnt += ok ? 1 : 0;
#pragma unroll
                for (int i = 0; i < 8; ++i) sum[i] += (float)v[i]; }
            const int row = tk + 8; const f16x8 cv = *(const LAS f16x8*)(wl + row * 64 + ((ch ^ (row & 7)) << 3)); const float ic = 1.f / (float)cnt;
            f16x8 a;
#pragma unroll
            for (int i = 0; i < 8; ++i) a[i] = (f16)(sum[i] * ic - (float)cv[i]);
#pragma unroll
            for (int n = 0; n < 4; ++n) acc[m][n] = mma_f16(a, bfr[n], acc[m][n]); } }
#pragma unroll
    for (int n = 0; n < 4; ++n) { const int d = g * 64 + n * 16 + fr; const float ps = p.pool_scale[l * 256 + d];
#pragma unroll
        for (int m = 0; m < 4; ++m)
#pragma unroll
            for (int i = 0; i < 4; ++i) MIX[(size_t)(ti.row0 + 16 * m + 4 * fq + i) * DM + d] = (f16)(acc[m][n][i] * ps); }
    LGKM0();
}

DI void qs_wave(const Params& p, int item, int lane) {
    const int h = item & 3; const TileInfo ti = tile_info(item >> 2);
    const f16* prow = (const f16*)(p.ws + WS_P) + (size_t)ti.row0 * INC + C_HQ + h * 64; f16* QS = (f16*)(p.ws + WS_QS) + (size_t)ti.row0 * 256 + h * 64; const int c = lane & 7;
    f16x8 qv[8];
#pragma unroll
    for (int it = 0; it < 8; ++it) qv[it] = *(const f16x8*)(prow + (size_t)(8 * it + (lane >> 3)) * INC + 8 * c);
#pragma unroll
    for (int it = 0; it < 8; ++it) { f16x8 o;
#pragma unroll
        for (int j = 0; j < 8; ++j) o[j] = (f16)siluf((float)qv[it][j]);
        *(f16x8*)(QS + (size_t)(8 * it + (lane >> 3)) * 256 + 8 * c) = o; }
}

DI void phase_prep_w(const Params& p, int l, ldsp lds, int lane, int wave, int vcu, int G) {
    LAS unsigned short* wl = (LAS unsigned short*)(lds + wave * 16384);
    LAS unsigned* ctr = (LAS unsigned*)(lds + MISC_OFF) + 20;
    __syncthreads();
    if (threadIdx.x < 4) ctr[threadIdx.x] = 0u;
    __syncthreads();
    const int nH = (528 * 8 - vcu + G - 1) / G, nP = (528 * 4 - vcu + G - 1) / G;
    const int nQ8 = TT * 10 / 8; const int nQ = (nQ8 - vcu + G - 1) / G; const int nQc = (nQ + 10) / 11;
#define PULL(k) ({ unsigned t_ = 0; if (lane == 0) t_ = __hip_atomic_fetch_add(ctr + (k), 1u, __ATOMIC_RELAXED, __HIP_MEMORY_SCOPE_WORKGROUP); __builtin_amdgcn_readfirstlane((int)t_); })
    for (int idx = PULL(0); idx < nH; idx = PULL(0)) hgrn_state_wave(p, l, vcu + idx * G, wl, lane);
    for (int idx = PULL(1); idx < nP; idx = PULL(1)) pool_wave(p, l, vcu + idx * G, wl, lane);
    for (int idx = PULL(3); idx < nP; idx = PULL(3)) qs_wave(p, vcu + idx * G, lane);
    for (int idx = PULL(2); idx < nQc; idx = PULL(2)) { const int c0 = idx * 11;
#pragma unroll
        for (int k = c0; k < c0 + 11; ++k) qk_wave(p, l, vcu + (k < nQ ? k : nQ - 1) * G, lane); }
#undef PULL
}

DI void hgrn_out_wave(const Params& p, int l, int item, LAS unsigned short* wl, LAS float* wx, int lane) {
    const int h = item & 3; const TileInfo ti = tile_info(item >> 2);
    const f16* P = (const f16*)(p.ws + WS_P); const unsigned short* HS = (const unsigned short*)(p.ws + WS_HSB); f16* MIX = (f16*)(p.ws + WS_MIX);
    LAS unsigned short* BA = wl; LAS unsigned short* BB = wl + 4096;
    const f16* prow = P + (size_t)ti.row0 * INC + h * 64;
    const int r32 = lane & 31, hi = lane >> 5;
    f32x16 o[2][2];
#pragma unroll
    for (int a = 0; a < 2; ++a)
#pragma unroll
        for (int b = 0; b < 2; ++b)
#pragma unroll
            for (int r = 0; r < 16; ++r) o[a][b][r] = 0.f;
#pragma unroll 1
    for (int dir = 0; dir < 2; ++dir) {
        wave_load_tile64(BA, prow + (dir ? C_HZB : C_HZF), INC, lane); wave_load_tile64(BB, (const f16*)(p.ws + WS_QS) + (size_t)ti.row0 * 256 + h * 64, 256, lane);
        u32x4 vreg[8], sreg[8];
        { const int pos = dir ? ti.chunkpos_b : ti.chunkpos_f; const char* hs = (const char*)(HS + ((size_t)((dir * NB + ti.b) * NPOS + pos) * 4 + h) * 4096); const char* vb = (const char*)(prow + C_HI);
          unsigned lov = (unsigned)((lane >> 3) * INC + 8 * (lane & 7)) * 2u, los = (unsigned)((lane >> 3) * 64 + 8 * (lane & 7)) * 2u; asm volatile("" : "+v"(lov), "+v"(los));
#pragma unroll
          for (int it = 0; it < 8; ++it) { vreg[it] = *(const u32x4*)(vb + (size_t)it * 8 * INC * 2 + lov); sreg[it] = *(const u32x4*)(hs + (size_t)it * 8 * 64 * 2 + los); } }
        const float* lbp = (const float*)(p.ws + WS_LB) + l * 512 + dir * 256 + h * 64;
        float er_mine = 0.f;
        LGKM0();
        const int s_ = dir ? 63 - lane : lane;
#pragma unroll 1
        for (int c = 0; c < 8; ++c) { float g[8], kk[8]; LAS f16x8* zp = (LAS f16x8*)(BA + s_ * 64 + ((c ^ (s_ & 7)) << 3)); LAS f16x8* qp = (LAS f16x8*)(BB + s_ * 64 + ((c ^ (s_ & 7)) << 3));
            const f16x8 zv = *zp, qv = *qp;
#pragma unroll
            for (int j = 0; j < 8; ++j) { const float lb = lbp[8 * c + j]; const float z = (float)zv[j]; const float sg = fast_rcp(1.f + __expf(-z)); g[j] = lb + (1.f - lb) * sg; kk[j] = (1.f - lb) * (1.f - sg); }
            wave_scan_mul8(g);
#pragma unroll
            for (int j = 0; j < 8; ++j) g[j] = fmaxf(g[j], 1e-37f);
            float kf_[8], qf_[8];
#pragma unroll
            for (int j = 0; j < 8; ++j) { const float r = fast_rcp(g[j]); const float pref = bcast_lane(g[j], 31), rpref = bcast_lane(r, 31);
                kf_[j] = kk[j] * pref * r; qf_[j] = (float)qv[j] * g[j] * rpref; er_mine = (lane == 8 * c + j) ? pref : er_mine; }
            u32x4 ko, qo;
#pragma unroll
            for (int j = 0; j < 4; ++j) { ko[j] = cvt_pk_bf16(kf_[2 * j], kf_[2 * j + 1]); qo[j] = cvt_pk_bf16(qf_[2 * j], qf_[2 * j + 1]); }
            *(LAS u32x4*)zp = ko; *(LAS u32x4*)qp = qo; }
        wx[lane] = er_mine;
        LGKM0();
        s16x8 qf[2][4];
#pragma unroll
        for (int b = 0; b < 2; ++b)
#pragma unroll
            for (int d0 = 0; d0 < 4; ++d0) { const int row = 32 * b + r32, ch = 2 * d0 + hi; qf[b][d0] = *(const LAS s16x8*)(BB + row * 64 + ((ch ^ (row & 7)) << 3)); }
        LGKM0();
        { const int c = lane & 7;
#pragma unroll
          for (int it = 0; it < 8; ++it) { const int row = 8 * it + (lane >> 3); *(LAS u32x4*)(BB + row * 64 + ((c ^ (row & 7)) << 3)) = vreg[it]; } }
        LGKM0();
#pragma unroll
        for (int tb = 0; tb < 2; ++tb)
#pragma unroll
            for (int sb = 0; sb < 2; ++sb) {
                const bool diag = (sb == tb); const bool full = dir ? (sb > tb) : (sb < tb);
                if (!diag && !full) continue;
                f32x16 pt;
#pragma unroll
                for (int r = 0; r < 16; ++r) pt[r] = 0.f;
#pragma unroll
                for (int d0 = 0; d0 < 4; ++d0) { const int row = 32 * sb + r32, ch = 2 * d0 + hi; const s16x8 kf = *(const LAS s16x8*)(BA + row * 64 + ((ch ^ (row & 7)) << 3));
                    pt = __builtin_amdgcn_mfma_f32_32x32x16_bf16(kf, qf[tb][d0], pt, 0, 0, 0); }
                if (diag) {
#pragma unroll
                    for (int r = 0; r < 16; ++r) { const int sl = crow(r, hi); const bool keep = dir ? (sl >= r32) : (sl <= r32); pt[r] = keep ? pt[r] : 0.f; } }
                f16x8 pw[2];
#pragma unroll
                for (int j = 0; j < 8; ++j) { pw[0][j] = (f16)pt[j]; pw[1][j] = (f16)pt[8 + j]; }
#pragma unroll
                for (int dvb = 0; dvb < 2; ++dvb)
#pragma unroll
                    for (int ss = 0; ss < 2; ++ss) { const int i16 = lane & 15, g1 = (lane >> 4) & 1; const int r0 = 32 * sb + 16 * ss + 4 * hi + (i16 >> 2), c0 = 32 * dvb + 16 * g1 + 4 * (i16 & 3);
                        const s16x4 a = tr_read(BB + swz(r0, c0)), b = tr_read(BB + swz(r0 + 8, c0));
                        const s16x8 vf = (s16x8){a[0], a[1], a[2], a[3], b[0], b[1], b[2], b[3]};
                        o[dvb][tb] = __builtin_amdgcn_mfma_f32_32x32x16_f16(__builtin_bit_cast(f16x8, vf), pw[ss], o[dvb][tb], 0, 0, 0); }
            }
        LGKM0();
        { const int c8 = lane & 7; const f32x4 er0 = *(const LAS f32x4*)(wx + 8 * c8), er1 = *(const LAS f32x4*)(wx + 8 * c8 + 4);
#pragma unroll
          for (int it = 0; it < 8; ++it) { const int row = 8 * it + (lane >> 3); const u32x4 sv = sreg[it];
              u32x4 w4;
#pragma unroll
              for (int q = 0; q < 4; ++q) { const float lo = __builtin_bit_cast(float, sv[q] << 16), hi2 = __builtin_bit_cast(float, sv[q] & 0xffff0000u);
                  const float e0 = (q < 2) ? er0[2 * q] : er1[2 * q - 4], e1 = (q < 2) ? er0[2 * q + 1] : er1[2 * q - 3]; w4[q] = cvt_pk_bf16(lo * e0, hi2 * e1); }
              *(LAS u32x4*)(BA + row * 64 + ((c8 ^ (row & 7)) << 3)) = w4; } }
        LGKM0();
#pragma unroll
        for (int dvb = 0; dvb < 2; ++dvb)
#pragma unroll
            for (int d0 = 0; d0 < 4; ++d0) { const int row = 32 * dvb + r32, ch = 2 * d0 + hi; const s16x8 sf = *(const LAS s16x8*)(BA + row * 64 + ((ch ^ (row & 7)) << 3));
#pragma unroll
                for (int tb = 0; tb < 2; ++tb) o[dvb][tb] = __builtin_amdgcn_mfma_f32_32x32x16_bf16(sf, qf[tb][d0], o[dvb][tb], 0, 0, 0); }
        LGKM0();
    }
    const float* gn = p.hgrn_norm_g + l * 64;
#pragma unroll
    for (int tb = 0; tb < 2; ++tb) { float ss = 0.f;
#pragma unroll
        for (int dvb = 0; dvb < 2; ++dvb)
#pragma unroll
            for (int r = 0; r < 16; ++r) ss += o[dvb][tb][r] * o[dvb][tb][r];
        ss += __shfl_xor(ss, 32); const float rn = __builtin_amdgcn_rsqf(ss * (1.f / 64.f) + EPS);
        const size_t row = (size_t)ti.row0 + 32 * tb + r32;
#pragma unroll
        for (int dvb = 0; dvb < 2; ++dvb)
#pragma unroll
            for (int g4 = 0; g4 < 4; ++g4) { const int dv0 = 32 * dvb + 8 * g4 + 4 * hi; const f16x4 gt = *(const f16x4*)(P + row * INC + C_HG + h * 64 + dv0); const f32x4 gg = *(const f32x4*)(gn + dv0);
                f16x4 ov;
#pragma unroll
                for (int i = 0; i < 4; ++i) ov[i] = (f16)(o[dvb][tb][4 * g4 + i] * rn * gg[i] * siluf((float)gt[i]));
                *(f16x4*)(MIX + row * DM + 768 + h * 64 + dv0) = ov; } }
}
DI void phase_hgrn_out_w(const Params& p, int l, ldsp lds, int lane, int wave, int vcu, int G) {
    LAS unsigned short* wl = (LAS unsigned short*)(lds + wave * 16384); LAS float* wx = (LAS float*)(lds + BLK_OFF + 1024 + wave * 512);
    const int gw = vcu * 8 + wave, NGW = G * 8;
    const int nit = (l == DEPTH - 1) ? 512 * 4 : 528 * 4;
    for (int it = gw; it < nit; it += NGW) hgrn_out_wave(p, l, it, wl, wx, lane);
}

DI void phase_scan(const Params& p, int tid, int vcu, int G, int dry) {
    const float* HS = (const float*)(p.ws + WS_HS); const float* HA = (const float*)(p.ws + WS_HA); unsigned short* HSB = (unsigned short*)(p.ws + (dry ? WS_DUMMY : WS_HSB));
    for (int gid = vcu * 512 + tid; gid < 2 * NB * 4 * 4096; gid += G * 512) {
        const int el = gid & 4095, h = (gid >> 12) & 3, db = gid >> 14;
        const size_t hoff = ((size_t)db * NPOS * 4 + h) * 4096 + el; const float* hs = HS + hoff; unsigned short* hso = HSB + hoff; const float* ha = HA + ((size_t)db * NPOS * 4 + h) * 64 + (el & 63);
        float S = 0.f;
        for (int pos = 0; pos < NPOS; pos += 12) { float u[12], a[12];
#pragma unroll
            for (int j = 0; j < 12; ++j) { u[j] = hs[(size_t)(pos + j) * 4 * 4096]; a[j] = ha[(size_t)(pos + j) * 4 * 64]; }
#pragma unroll
            for (int j = 0; j < 12; ++j) { hso[(size_t)(pos + j) * 4 * 4096] = f2bf(S); S = a[j] * S + u[j]; } }
    }
}

DI void attn_item(const Params& p, int l, int idx, ldsp lds, int tid, int lane, int wave) {
    const f16* P = (const f16*)(p.ws + WS_P); const f16* QN = (const f16*)(p.ws + WS_QN); const f16* KN = (const f16*)(p.ws + WS_KN); f16* MIX = (f16*)(p.ws + WS_MIX);
    int b, kvh, qb, isctx;
    if (idx < 1024) { b = idx >> 8; kvh = (idx >> 7) & 1; qb = idx & 127; isctx = 0; } else { const int j = idx - 1024; b = j >> 3; kvh = (j >> 2) & 1; qb = j & 3; isctx = 1; }
    const int q0 = qb * 64; const int qrowbase = isctx ? TL + b * CTXL : b * SEQ;
    const int r32 = lane & 31, hi = lane >> 5; const int hq = kvh * 4 + (wave >> 1); const int qpos = q0 + (wave & 1) * 32 + r32; const size_t qrow = (size_t)qrowbase + qpos;
    LAS f16* KB = (LAS f16*)lds;
    LAS f16* VTB = KB + 2 * 64 * TP;
    f16x8 qr[4];
#pragma unroll
    for (int d0 = 0; d0 < 4; ++d0) qr[d0] = *(const f16x8*)(QN + qrow * 512 + hq * 64 + 16 * d0 + 8 * hi);
    float lsum = hi ? 0.f : __builtin_amdgcn_exp2f(p.attn_sink[l * 8 + hq] * LOG2E - 4.f);
    f32x16 o[2];
#pragma unroll
    for (int r = 0; r < 16; ++r) { o[0][r] = 0.f; o[1][r] = 0.f; }
    const int srow = tid >> 3, sc8 = tid & 7;
    const int ntile = isctx ? 4 : 9;
    int cur = 0; bool have = false; f16x8 kreg, vreg;
    int tix = 0;
#define TILE_VALID(t) (isctx || (t) >= 5 || ((q0 - 128 + 64 * (t)) >= 0 && (q0 - 128 + 64 * (t)) < SEQ))
#define TILE_ROW(t) ((isctx || (t) >= 5) ? (TL + b * CTXL + 64 * (isctx ? (t) : (t) - 5)) : (b * SEQ + q0 - 128 + 64 * (t)))
    while (tix < ntile && !TILE_VALID(tix)) ++tix;
    { const size_t kr = (size_t)TILE_ROW(tix) + srow; kreg = *(const f16x8*)(KN + kr * 128 + kvh * 64 + 8 * sc8); vreg = *(const f16x8*)(P + kr * INC + C_V + kvh * 64 + 8 * sc8); }
    __syncthreads();
    { *(LAS f16x8*)(KB + srow * TP + 8 * sc8) = kreg;
#pragma unroll
      for (int i = 0; i < 8; ++i) VTB[(8 * sc8 + i) * TP + srow] = vreg[i]; }
    __syncthreads();
    while (tix < ntile) {
        int nx = tix + 1; while (nx < ntile && !TILE_VALID(nx)) ++nx;
        have = nx < ntile;
        if (have) { const size_t kr = (size_t)TILE_ROW(nx) + srow; kreg = *(const f16x8*)(KN + kr * 128 + kvh * 64 + 8 * sc8); vreg = *(const f16x8*)(P + kr * INC + C_V + kvh * 64 + 8 * sc8); }
        const LAS f16* Kc = KB + cur * 64 * TP; const LAS f16* Vc = VTB + cur * 64 * TP;
        f32x16 p0, p1;
#pragma unroll
        for (int r = 0; r < 16; ++r) { p0[r] = -4.f; p1[r] = -4.f; }
#pragma unroll
        for (int d0 = 0; d0 < 4; ++d0) { const f16x8 k0 = *(const LAS f16x8*)(Kc + r32 * TP + 16 * d0 + 8 * hi); const f16x8 k1 = *(const LAS f16x8*)(Kc + (32 + r32) * TP + 16 * d0 + 8 * hi);
            p0 = __builtin_amdgcn_mfma_f32_32x32x16_f16(k0, qr[d0], p0, 0, 0, 0); p1 = __builtin_amdgcn_mfma_f32_32x32x16_f16(k1, qr[d0], p1, 0, 0, 0); }
        if (!isctx && (tix == 0 || tix == 4)) { const int kstart = q0 - 128 + 64 * tix;
#pragma unroll
            for (int r = 0; r < 16; ++r) { const int d0_ = qpos - (kstart + crow(r, hi)); if (d0_ > 128 || d0_ < -128) p0[r] = -INFINITY; const int d1_ = d0_ - 32; if (d1_ > 128 || d1_ < -128) p1[r] = -INFINITY; } }
        float ps = 0.f;
#pragma unroll
        for (int r = 0; r < 16; ++r) { p0[r] = __builtin_amdgcn_exp2f(p0[r]); p1[r] = __builtin_amdgcn_exp2f(p1[r]); ps += p0[r] + p1[r]; }
        lsum += ps;
        f16x8 pw[4];
#pragma unroll
        for (int j = 0; j < 8; ++j) { pw[0][j] = (f16)p0[j]; pw[1][j] = (f16)p0[8 + j]; pw[2][j] = (f16)p1[j]; pw[3][j] = (f16)p1[8 + j]; }
#pragma unroll
        for (int s_ = 0; s_ < 4; ++s_) pw[s_] = __builtin_elementwise_min(pw[s_], (f16x8){(f16)65504.f, (f16)65504.f, (f16)65504.f, (f16)65504.f, (f16)65504.f, (f16)65504.f, (f16)65504.f, (f16)65504.f});
#pragma unroll
        for (int d1 = 0; d1 < 2; ++d1)
#pragma unroll
            for (int s = 0; s < 4; ++s) { const LAS f16* vp = Vc + (32 * d1 + r32) * TP + 16 * s + 4 * hi; const f16x4 lo = *(const LAS f16x4*)vp, hv = *(const LAS f16x4*)(vp + 8);
                const f16x8 vf = (f16x8){lo[0], lo[1], lo[2], lo[3], hv[0], hv[1], hv[2], hv[3]};
                o[d1] = __builtin_amdgcn_mfma_f32_32x32x16_f16(vf, pw[s], o[d1], 0, 0, 0); }
        if (have) { LAS f16* Kn = KB + (cur ^ 1) * 64 * TP; LAS f16* Vn = VTB + (cur ^ 1) * 64 * TP;
            *(LAS f16x8*)(Kn + srow * TP + 8 * sc8) = kreg;
#pragma unroll
            for (int i = 0; i < 8; ++i) Vn[(8 * sc8 + i) * TP + srow] = vreg[i]; }
        __syncthreads();
        cur ^= 1; tix = nx;
    }
#undef TILE_VALID
#undef TILE_ROW
    const float lt = lsum + __shfl_xor(lsum, 32); const float il = 1.f / lt;
    f16* orow = MIX + qrow * DM + 256 + hq * 64;
#pragma unroll
    for (int d1 = 0; d1 < 2; ++d1)
#pragma unroll
        for (int g = 0; g < 4; ++g) { f16x4 v;
#pragma unroll
            for (int i = 0; i < 4; ++i) v[i] = (f16)(o[d1][4 * g + i] * il);
            *(f16x4*)(orow + 32 * d1 + 8 * g + 4 * hi) = v; }
}
DI void phase_attn(const Params& p, int l, ldsp lds, int tid, int lane, int wave, int vcu, int G, int rep) {
    unsigned* qc = (unsigned*)(p.ws + WS_CTL) + CW_QUEUE + (l * 2 + rep) * 64; volatile LAS unsigned* slot = (volatile LAS unsigned*)(lds + MISC_OFF) + 16;
    const int nitems = (l == DEPTH - 1) ? 1024 : 1056;
    __syncthreads();
    if (tid == 0) slot[0] = atomicAdd(qc, 1u);
    __syncthreads();
    unsigned it = slot[0];
    while (it < (unsigned)nitems) {
        __syncthreads();
        if (tid == 0) slot[0] = atomicAdd(qc, 1u);
        attn_item(p, l, (int)it, lds, tid, lane, wave);
        __syncthreads();
        it = slot[0];
    }
    __syncthreads();
}

DI void phase_outproj_ctx(const Params& p, int l, int lane, int wave, int vcu, int G, int dry) {
    const f16* MIX = (const f16*)(p.ws + WS_MIX) + (size_t)TL * DM; const f16* W = (const f16*)(p.ws + WS_WOUT) + (size_t)l * DM * DM;
    f16* xd = (f16*)(p.ws + (dry ? WS_DUMMY + 136 * MiB : WS_DELTA)) + (dry ? 0 : (size_t)TL * DM);
    const float* g1 = (const float*)(p.ws + WS_MOD) + ((size_t)l * 5 + 4) * 6144 + 2 * 1024;
    const int fr = lane & 15, fq = lane >> 4;
    for (int it = vcu; it < 256; it += G) { const int r0 = (it >> 4) * 64 + 16 * (wave & 3), c0 = (it & 15) * 64 + 32 * (wave >> 2);
        f32x4 acc[2] = {(f32x4){0.f, 0.f, 0.f, 0.f}, (f32x4){0.f, 0.f, 0.f, 0.f}};
        const f16* ap = MIX + (size_t)(r0 + fr) * DM + 8 * fq; const f16* bp = W + (size_t)(c0 + fr) * DM + 8 * fq;
#pragma unroll 8
        for (int ks = 0; ks < 32; ++ks) { const f16x8 a = *(const f16x8*)(ap + 32 * ks); const f16x8 b0 = *(const f16x8*)(bp + 32 * ks), b1 = *(const f16x8*)(bp + 16 * DM + 32 * ks);
            acc[0] = mma_f16(a, b0, acc[0]); acc[1] = mma_f16(a, b1, acc[1]); }
#pragma unroll
        for (int n = 0; n < 2; ++n) { const int col = c0 + 16 * n + fr; const float gv = g1[col];
#pragma unroll
            for (int i = 0; i < 4; ++i) xd[(size_t)(r0 + 4 * fq + i) * DM + col] = (f16)(gv * acc[n][i]); } }
}

DI void phase_router(const Params& p, int l, ldsp lds, int tid, int lane, int wave, int vcu, int G, int dry) {
    const float* MOD = (const float*)(p.ws + WS_MOD); f16* H = (f16*)(p.ws + (dry ? WS_DUMMY : WS_H)); const float* XC = (const float*)(p.ws + WS_XC); const f16* WRH = (const f16*)(p.ws + WS_WR) + (size_t)l * 48 * 1024; const f16* WRL = WRH + (size_t)DEPTH * 48 * 1024;
    int* SLOT = (int*)(p.ws + (dry ? WS_DUMMY + 88 * MiB : WS_SLOT)); float* GT = (float*)(p.ws + (dry ? WS_DUMMY + 80 * MiB : WS_GATES)); int* LIST = (int*)(p.ws + (dry ? WS_DUMMY + 96 * MiB : WS_LIST)); unsigned* CNT = (unsigned*)(p.ws + WS_CTL) + CW_CNT + l * 32 * 16 + (dry ? 4096 : 0);
    constexpr int XP = 1028;
    LAS float* XT = (LAS float*)lds;
    LAS float* PART = XT + 16 * XP;
    LAS float* LG = PART + 8 * 16 * 48;
    const int fr = lane & 15, fq = lane >> 4;
    f16x8 wh[4][3], wl_[4][3];
#pragma unroll
    for (int ks = 0; ks < 4; ++ks)
#pragma unroll
        for (int n = 0; n < 3; ++n) { const size_t o = (size_t)(16 * n + fr) * 1024 + wave * 128 + 32 * ks + 8 * fq; wh[ks][n] = *(const f16x8*)(WRH + o); wl_[ks][n] = *(const f16x8*)(WRL + o); }
    const int ntiles = (l == DEPTH - 1 ? TL : TT) / 16;
    LAS int* SEL = (LAS int*)(LG + 16 * 48);
    LAS int* BASE = SEL + 64;
    f32x4 v[2][4];
    const float* xsl = (l == 0) ? p.x : p.out; const float* xsc = (l == 0) ? p.ctx : XC; const f16* DL = (const f16*)(p.ws + WS_DELTA);
    float* xwl = dry ? (float*)(p.ws + WS_DUMMY + 8 * MiB) : p.out; float* xwc = dry ? (float*)(p.ws + WS_DUMMY + 8 * MiB) : (float*)(p.ws + WS_XC);
    f16x4 dv[2][4];
#define RT_LOAD(tile_) do { _Pragma("unroll") for (int q = 0; q < 2; ++q) { const int row = (tile_) * 16 + wave + 8 * q; const float* xr_ = (row < TL) ? xsl + (size_t)row * DM : xsc + (size_t)(row - TL) * DM; \
        _Pragma("unroll") for (int j = 0; j < 4; ++j) { v[q][j] = *(const f32x4*)(xr_ + 256 * j + 4 * lane); dv[q][j] = *(const f16x4*)(DL + (size_t)row * DM + 256 * j + 4 * lane); } } } while (0)
#define RT_FLUSH(buf_, row0_) do { if (tid < 32) { const int e = SEL[(buf_) * 32 + tid]; int rank = 0; \
        _Pragma("unroll") for (int j = 0; j < 32; ++j) rank += (j < tid && SEL[(buf_) * 32 + j] == e) ? 1 : 0; \
        const int pos_ = BASE[(buf_) * 32 + e] + rank; const int ent_ = ((row0_) + (tid >> 1)) * 2 + (tid & 1); LIST[(size_t)e * TT + pos_] = ent_; SLOT[ent_] = (e << 20) | pos_; } } while (0)
    int tile = vcu; int cur = 0; int prev_row0 = -1; unsigned pend = 0u; bool pend_valid = false;
    if (tile < ntiles) RT_LOAD(tile);
    for (; tile < ntiles; tile += G, cur ^= 1) {
        const int row0 = tile * 16;
        { float ssum[2];
#pragma unroll
          for (int q = 0; q < 2; ++q) { float s = 0.f; const int row = row0 + wave + 8 * q; float* xw_ = (row < TL) ? xwl + (size_t)(dry ? (row & 1023) : row) * DM : xwc + (size_t)(row - TL) * DM;
#pragma unroll
              for (int j = 0; j < 4; ++j) {
#pragma unroll
                  for (int i = 0; i < 4; ++i) v[q][j][i] += (float)dv[q][j][i];
                  s += v[q][j][0] * v[q][j][0] + v[q][j][1] * v[q][j][1] + v[q][j][2] * v[q][j][2] + v[q][j][3] * v[q][j][3]; }
              ssum[q] = s; }
#pragma unroll
          for (int o = 1; o < 64; o <<= 1) { ssum[0] += __shfl_xor(ssum[0], o); ssum[1] += __shfl_xor(ssum[1], o); }
          const int b = modb_of_row(row0); const float* m2 = MOD + ((size_t)l * 5 + b) * 6144; const float* gn = p.norm2_g + l * DM;
#pragma unroll
          for (int j = 0; j < 4; ++j) { const int c = 256 * j + 4 * lane; const f32x4 g = *(const f32x4*)(gn + c), sh = *(const f32x4*)(m2 + 3 * 1024 + c), sc = *(const f32x4*)(m2 + 4 * 1024 + c);
#pragma unroll
              for (int q = 0; q < 2; ++q) { const int rr = wave + 8 * q; const float r = __builtin_amdgcn_rsqf(ssum[q] * (1.f / DM) + EPS); f32x4 hv; f16x4 o;
#pragma unroll
                  for (int i = 0; i < 4; ++i) { hv[i] = v[q][j][i] * r * g[i] * (1.f + sc[i]) + sh[i]; o[i] = (f16)hv[i]; }
                  *(f16x4*)(H + (size_t)(row0 + rr) * DM + c) = o; *(LAS f32x4*)(XT + rr * XP + c) = hv; } } }
        if (pend_valid) BASE[(cur ^ 1) * 32 + tid] = (int)pend;
        __syncthreads();
        if (tile + G < ntiles) RT_LOAD(tile + G);
        if (prev_row0 >= 0) RT_FLUSH(cur ^ 1, prev_row0);
        { f32x4 acc[3];
#pragma unroll
          for (int n = 0; n < 3; ++n) acc[n] = (f32x4){0.f, 0.f, 0.f, 0.f};
#pragma unroll
          for (int ks = 0; ks < 4; ++ks) { const LAS float* xp = XT + fr * XP + wave * 128 + 32 * ks + 8 * fq; const f32x4 x0 = *(const LAS f32x4*)xp, x1 = *(const LAS f32x4*)(xp + 4);
              f16x8 ah, al;
#pragma unroll
              for (int j = 0; j < 4; ++j) { ah[j] = (f16)x0[j]; al[j] = (f16)(x0[j] - (float)ah[j]); ah[4 + j] = (f16)x1[j]; al[4 + j] = (f16)(x1[j] - (float)ah[4 + j]); }
#pragma unroll
              for (int n = 0; n < 3; ++n) { acc[n] = mma_f16(ah, wh[ks][n], acc[n]); acc[n] = mma_f16(ah, wl_[ks][n], acc[n]); acc[n] = mma_f16(al, wh[ks][n], acc[n]); } }
#pragma unroll
          for (int n = 0; n < 3; ++n)
#pragma unroll
              for (int i = 0; i < 4; ++i) PART[(wave * 16 + 4 * fq + i) * 48 + 16 * n + fr] = acc[n][i] * (1.f / 1024.f); }
        __syncthreads();
        for (int i = tid; i < 16 * 36; i += 512) { const int tk = i / 36, o = i % 36; float s = 0.f;
#pragma unroll
            for (int w = 0; w < 8; ++w) s += PART[(w * 16 + tk) * 48 + o];
            LG[tk * 48 + o] = s + (o < 4 ? p.rgb[l * 4 + o] : p.reb[l * 32 + (o - 4)]); }
        __syncthreads();
        if (tid < 16) { const int row = row0 + tid; const LAS float* lg = LG + tid * 48;
            int g = 0; float gm = lg[0];
#pragma unroll
            for (int j = 1; j < 4; ++j) if (lg[j] > gm) { gm = lg[j]; g = j; }
            float den = 0.f;
#pragma unroll
            for (int j = 0; j < 4; ++j) den += expf(lg[j] - gm);
            const float pg = 1.f / den;
            const LAS float* le = lg + 4 + 8 * g; int e0 = 0; float m0 = le[0];
#pragma unroll
            for (int j = 1; j < 8; ++j) if (le[j] > m0) { m0 = le[j]; e0 = j; }
            int e1 = -1; float m1 = -INFINITY;
#pragma unroll
            for (int j = 0; j < 8; ++j) if (j != e0 && le[j] > m1) { m1 = le[j]; e1 = j; }
            const float w0 = 1.f / (1.f + expf(m1 - m0)), w1 = 1.f - w0;
            *(f32x2*)(GT + row * 2) = (f32x2){pg * w0, pg * w1};
            SEL[cur * 32 + tid * 2] = 8 * g + e0; SEL[cur * 32 + tid * 2 + 1] = 8 * g + e1; }
        __syncthreads();
        pend_valid = false;
        if (tid < 32) { int c = 0;
#pragma unroll
            for (int j = 0; j < 32; ++j) c += (SEL[cur * 32 + j] == tid) ? 1 : 0;
            if (c > 0) { pend = atomicAdd(CNT + tid * 16, (unsigned)c); pend_valid = true; } }
        prev_row0 = row0;
    }
    if (pend_valid) BASE[(cur ^ 1) * 32 + tid] = (int)pend;
    __syncthreads();
    if (prev_row0 >= 0) RT_FLUSH(cur ^ 1, prev_row0);
    __syncthreads();
#undef RT_LOAD
#undef RT_FLUSH
}

DI int moe_setup(const Params& p, int l, ldsp lds, int tid, int G, int bx) {
    LAS int* blk = (LAS int*)(lds + BLK_OFF); LAS int* cnt = blk + 40; LAS int* utab = blk + 80;
    const unsigned* CNT = (const unsigned*)(p.ws + WS_CTL) + CW_CNT + l * 32 * 16;
    if (tid < 32) cnt[tid] = (int)__hip_atomic_load(CNT + tid * 16, __ATOMIC_RELAXED, __HIP_MEMORY_SCOPE_AGENT);
    __syncthreads();
    if (tid == 0) { int a = 0; for (int e = 0; e < 32; ++e) { blk[e] = a; a += (cnt[e] + 255) >> 8; } blk[32] = a; }
    __syncthreads();
    if (tid < 16) { const int Lq = pg8::moe_unit(tid, G, bx, blk[32] * 4); const int L = Lq < 0 ? 0 : Lq; const int rb = L >> 2; int e = 0;
        for (int j = 1; j < NEXP; ++j) e = (blk[j] <= rb) ? j : e;
        utab[tid] = (e << 16) | ((rb - blk[e]) & 0xffff); }
    __syncthreads();
    return blk[32];
}


#if defined(__HIP_DEVICE_COMPILE__)
#define LOADP() Params p; { const __attribute__((address_space(4))) Params* kp_ = (const __attribute__((address_space(4))) Params*)__builtin_amdgcn_kernarg_segment_ptr(); asm volatile("" : "+s"(kp_)); \
    __builtin_memcpy(&p, (const Params*)kp_, sizeof(Params)); }
#else
#define LOADP() Params p = p_unused;
#endif
#define PV() int tid = tid0; asm volatile("" : "+v"(tid)); const int lane = tid & 63, wave = __builtin_amdgcn_readfirstlane(tid >> 6); int G = G0, bx = bx0; asm volatile("" : "+s"(G), "+s"(bx)); \
    const int vcu = (G % 8 == 0) ? (bx % 8) * (G / 8) + bx / 8 : bx; int l = l0; asm volatile("" : "+s"(l)); (void)lane; (void)wave; (void)vcu; (void)l;
#define AMP_T0(n) unsigned long long amp_t0_ = 0; if (AMP_PHASE == (n)) amp_t0_ = __builtin_amdgcn_s_memrealtime();
#define AMP_WAIT(n) if (AMP_PHASE == (n)) { const unsigned long long t1_ = __builtin_amdgcn_s_memrealtime(); const unsigned long long w_ = (t1_ - amp_t0_) * AMP_K; while (__builtin_amdgcn_s_memrealtime() - t1_ < w_) __builtin_amdgcn_s_sleep(8); }
template <int L0> DI void layer_body(const XcdBarrier& bar, ldsp lds, const int tid0, const int G0, const int bx0, const Params& p_unused) {
    constexpr int l0 = L0;


{ AMP_T0(2)
#ifndef SKIP_INPROJ
        for (int rep_ = 0; rep_ < (DUP_PHASE == 2 ? 2 : 1); ++rep_) { LOADP(); PV(); unsigned char* ws = p.ws; pg8::Gemm g{(const f16*)(ws + WS_H), (const f16*)(ws + WS_WIN) + (size_t)l * INC * DM, DM, 0}; pg8::StaticOrder S; S.init(TT, INC, G, bx);
          EpiP E{(f16*)(ws + WS_P), INC};
          pg8::gemm_phase<EpiP, pg8::StaticOrder, true, false>(lds, g, S, E, tid);
          if (l < DEPTH - 1 && rep_ == 0) { const int nu = (TT / 256) * (INC / 256); if ((nu - bx + G - 1) / G < (nu + G - 1) / G) convert_steal(p, l + 1, 2, lds, tid, lane, wave); } }
#endif

        xcd_barrier(bar); AMP_WAIT(2) }

{ AMP_T0(3)
#ifndef SKIP_PREP
        for (int rep_ = 0; rep_ < (DUP_PHASE == 3 ? 2 : 1); ++rep_) { LOADP(); PV(); phase_prep_w(p, l, lds, lane, wave, vcu, G); }
#endif

        xcd_barrier(bar); AMP_WAIT(3) }

{ AMP_T0(5)
#ifndef SKIP_SCAN
        for (int rep_ = (DUP_PHASE == 4 ? 1 : 0); rep_ >= 0; --rep_) { LOADP(); PV(); phase_scan(p, tid, vcu, G, rep_); }
#endif
        xcd_barrier(bar); AMP_WAIT(5) }
{ AMP_T0(6)
#ifndef SKIP_HOUT
        for (int rep_ = 0; rep_ < (DUP_PHASE == 6 ? 2 : 1); ++rep_) { LOADP(); PV(); phase_hgrn_out_w(p, l, lds, lane, wave, vcu, G); }
#endif
#ifndef SKIP_ATTN
        for (int rep_ = 0; rep_ < (DUP_PHASE == 5 ? 2 : 1); ++rep_) { LOADP(); PV(); phase_attn(p, l, lds, tid, lane, wave, vcu, G, rep_); }
#endif
        xcd_barrier(bar); AMP_WAIT(6) }

{ AMP_T0(7)
#ifndef SKIP_OUTPROJ
        for (int rep_ = (DUP_PHASE == 7 ? 1 : 0); rep_ >= 0; --rep_) { LOADP(); PV(); unsigned char* ws = p.ws; pg8::Gemm g{(const f16*)(ws + WS_MIX), (const f16*)(ws + WS_WOUT) + (size_t)l * DM * DM, DM, 0}; pg8::StaticOrder S; S.init(TL, DM, G, bx);
          EpiOut E{(f16*)(ws + (rep_ ? WS_DUMMY : WS_DELTA)), (const float*)(ws + WS_MOD) + (size_t)l * 5 * 6144};
          pg8::gemm_phase<EpiOut, pg8::StaticOrder, true, false>(lds, g, S, E, tid);
          if (l < DEPTH - 1) phase_outproj_ctx(p, l, lane, wave, vcu, G, rep_); }
#endif

        xcd_barrier(bar); AMP_WAIT(7) }

{ AMP_T0(8)
#ifndef SKIP_ROUTER
        for (int rep_ = (DUP_PHASE == 8 ? 1 : 0); rep_ >= 0; --rep_) { LOADP(); PV(); if (l > 0 && rep_ == 0) convert_steal(p, l, 1 << 20, lds, tid, lane, wave); phase_router(p, l, lds, tid, lane, wave, vcu, G, rep_); }
#endif

        xcd_barrier(bar); AMP_WAIT(8) }

{ AMP_T0(9)
#ifndef SKIP_MOE1
        for (int rep_ = 0; rep_ < (DUP_PHASE == 9 ? 2 : 1); ++rep_) { LOADP(); PV(); unsigned char* ws = p.ws; const int nblk = moe_setup(p, l, lds, tid, G, bx);
          pg8::Gemm g{(const f16*)(ws + WS_H), (const f16*)(ws + WS_WGU) + (size_t)l * NEXP * 1024 * 1024, DM, (size_t)1024 * 1024};
          pg8::MoeOrder S{G, bx, nblk, (const LAS int*)(lds + BLK_OFF), (const LAS int*)(lds + BLK_OFF) + 40, (const int*)(ws + WS_LIST), DM * 2, (const LAS int*)(lds + BLK_OFF) + 80};
          EpiMoe1 E{(f16*)(ws + WS_HID)};
          pg8::gemm_phase<EpiMoe1, pg8::MoeOrder, true, true>(lds, g, S, E, tid);
          if (l < DEPTH - 1 && rep_ == 0) { const int nu = nblk * 4; if (pg8::moe_unit((nu + G - 1) / G - 1, G, bx, nu) < 0) convert_steal(p, l + 1, 2, lds, tid, lane, wave); } }
#endif

        xcd_barrier(bar); AMP_WAIT(9) }

{ AMP_T0(10)
#ifndef SKIP_MOE2
        for (int rep_ = 0; rep_ < (DUP_PHASE == 10 ? 2 : 1); ++rep_) { LOADP(); PV(); unsigned char* ws = p.ws; const int nblk = ((const LAS int*)(lds + BLK_OFF))[32];
          pg8::Gemm g{(const f16*)(ws + WS_HID), (const f16*)(ws + WS_WD) + (size_t)l * NEXP * 1024 * 512, EH, (size_t)1024 * 512};
          pg8::MoeOrder S{G, bx, nblk, (const LAS int*)(lds + BLK_OFF), (const LAS int*)(lds + BLK_OFF) + 40, (const int*)(ws + WS_LIST), EH * 2, (const LAS int*)(lds + BLK_OFF) + 80};
          EpiMoe2 E{(f16*)(ws + WS_Y2)};
          pg8::gemm_phase<EpiMoe2, pg8::MoeOrder, true, false>(lds, g, S, E, tid);
          if (l < DEPTH - 1 && rep_ == 0) { const int nu = nblk * 4; if (pg8::moe_unit((nu + G - 1) / G - 1, G, bx, nu) < 0) convert_steal(p, l + 1, 1, lds, tid, lane, wave); } }
#endif

        xcd_barrier(bar); AMP_WAIT(10) }

{ AMP_T0(11)
#ifndef SKIP_COMBINE
        for (int rep_ = (DUP_PHASE == 11 ? 1 : 0); rep_ >= 0; --rep_) { LOADP(); PV(); phase_combine(p, l, lds, lane, wave, vcu, G, rep_); }
#endif

        if (l0 < DEPTH - 1) xcd_barrier(bar); AMP_WAIT(11) }
        if (DUP_PHASE == 13) { for (int q_ = 0; q_ < 8; ++q_) xcd_barrier(bar); }

}

__global__ void __launch_bounds__(512, 2) fwd_kernel(Params p_unused) {
    extern __shared__ __attribute__((aligned(16))) unsigned char lds_raw[];
    ldsp lds = (ldsp)lds_raw;
    const int tid0 = threadIdx.x; const int G0 = gridDim.x; const int bx0 = blockIdx.x;
    const int tid = tid0;
    volatile LAS unsigned* MISC = (volatile LAS unsigned*)(lds + MISC_OFF);
    for (int u = tid; u < (LDS_BYTES - MISC_OFF) / 4; u += 512) ((LAS unsigned*)(lds + MISC_OFF))[u] = 0u;
    __syncthreads();
    XcdBarrier bar;
    { LOADP(); bar = xcd_barrier_post((unsigned*)(p.ws + WS_CTL) + CW_BAR, MISC + 8); }


    const int l0 = 0;
#ifndef SKIP_PROLOGUE
    for (int rep_ = 0; rep_ < (DUP_PHASE == 1 ? 2 : 1); ++rep_) { LOADP(); PV(); phase_prologue(p, lds, tid, lane, wave, vcu, G); __syncthreads(); }
#endif

    xcd_barrier(bar);

#ifndef SKIP_MOD0
        for (int rep_ = 0; rep_ < (DUP_PHASE == 12 ? 2 : 1); ++rep_) { LOADP(); PV(); phase_mod0(p, lane, wave, vcu, G); }
#endif

    xcd_barrier(bar);
    layer_body<0>(bar, lds, tid0, G0, bx0, p_unused); layer_body<1>(bar, lds, tid0, G0, bx0, p_unused); layer_body<2>(bar, lds, tid0, G0, bx0, p_unused); layer_body<3>(bar, lds, tid0, G0, bx0, p_unused);
}

extern "C" void kernel_launch(void* const* d_in, const int* in_sizes, int n_in, void* d_out, int out_size, void* d_ws, size_t ws_size, hipStream_t stream) {
    static int grid = 0;
    if (grid == 0) {
        if (n_in != 24 || out_size != TL * DM || ws_size < WS_END) { fprintf(stderr, "kernel_launch: unexpected shapes (n_in %d, out %d, ws %zu < %zu)\n", n_in, out_size, ws_size, (size_t)WS_END); grid = -1; return; }
        int dev = 0, cus = 0, per_cu = 0;
        if (hipGetDevice(&dev) != hipSuccess || hipDeviceGetAttribute(&cus, hipDeviceAttributeMultiprocessorCount, dev) != hipSuccess) { grid = -1; return; }
        if (hipFuncSetAttribute((const void*)fwd_kernel, hipFuncAttributeMaxDynamicSharedMemorySize, LDS_BYTES) != hipSuccess) { fprintf(stderr, "kernel_launch: hipFuncSetAttribute failed\n"); grid = -1; return; }
        if (hipOccupancyMaxActiveBlocksPerMultiprocessor(&per_cu, (const void*)fwd_kernel, 512, LDS_BYTES) != hipSuccess || per_cu < 1) { fprintf(stderr, "kernel_launch: occupancy query reports %d\n", per_cu); }
        (void)hipGetLastError();
        grid = cus;
    }
    if (grid < 0) return;
    (void)hipMemsetAsync((char*)d_ws + WS_CTL, 0, CTL_ZERO_BYTES, stream);
    Params p{};
    const float** pp = (const float**)&p;
    for (int i = 0; i < 24; ++i) pp[i] = (const float*)d_in[i];
    p.out = (float*)d_out; p.ws = (unsigned char*)d_ws;
    hipLaunchKernelGGL(fwd_kernel, dim3(grid), dim3(512), LDS_BYTES, stream, p);
}
```

```cpp
#include <hip/hip_runtime.h>
#include <cstdio>
#include <cstdint>

#define DI __device__ __forceinline__
#ifndef AMP_PHASE
#define AMP_PHASE 0
#endif
#define AMP_K 4
#ifndef DUP_PHASE
#define DUP_PHASE 0
#endif
#define LAS __attribute__((address_space(3)))
#define GAS __attribute__((address_space(1)))
typedef _Float16 f16;
typedef _Float16 f16x8 __attribute__((ext_vector_type(8)));
typedef _Float16 f16x4 __attribute__((ext_vector_type(4)));
typedef _Float16 f16x2 __attribute__((ext_vector_type(2)));
typedef short s16x8 __attribute__((ext_vector_type(8)));
typedef short s16x4 __attribute__((ext_vector_type(4)));
typedef float f32x4 __attribute__((ext_vector_type(4)));
typedef float f32x2 __attribute__((ext_vector_type(2)));
typedef float f32x16 __attribute__((ext_vector_type(16)));
typedef unsigned u32x4 __attribute__((ext_vector_type(4)));
typedef unsigned u32x2 __attribute__((ext_vector_type(2)));
typedef LAS unsigned char* ldsp;

constexpr int DM = 1024, NB = 4, SEQ = 8192, CTXL = 256, DEPTH = 4;
constexpr int TL = NB * SEQ, TC = NB * CTXL, TT = TL + TC;
constexpr int INC = 2304;
constexpr int C_U = 0, C_Q = 256, C_K = 768, C_V = 896, C_HQ = 1024, C_HI = 1280, C_HZF = 1536, C_HZB = 1792, C_HG = 2048;
constexpr int NEXP = 32, EH = 512;
constexpr int NPOS = 132;
constexpr float EPS = 1e-6f;
constexpr float LOG2E = 1.4426950408889634f;
constexpr int MAXBLK = 296;

constexpr size_t MiB = 1u << 20;
constexpr size_t WS_CTL = 0, CTL_ZERO_BYTES = 1 * MiB;
constexpr size_t WS_WIN = 1 * MiB;
constexpr size_t WS_WOUT = WS_WIN + (size_t)DEPTH * INC * DM * 2;
constexpr size_t WS_WGU = WS_WOUT + (size_t)DEPTH * DM * DM * 2;
constexpr size_t WS_WD = WS_WGU + (size_t)DEPTH * NEXP * 1024 * 1024 * 2;
constexpr size_t WS_POOLW = WS_WD + (size_t)DEPTH * NEXP * 1024 * 512 * 2;
constexpr size_t WS_WR = WS_POOLW + (size_t)DEPTH * 4 * 64 * 64 * 2;
constexpr size_t WS_MOD = WS_WR + (size_t)DEPTH * 1024 * 48 * 4;
constexpr size_t WS_LB = WS_MOD + (size_t)DEPTH * 5 * 6144 * 4;
constexpr size_t WS_ROPE = WS_LB + (size_t)DEPTH * 2 * 256 * 4;
constexpr size_t WS_XC = WS_ROPE + (size_t)(2 * 128 * 16 + 2 * 64 * 16) * 4;
constexpr size_t WS_GATES = WS_XC + (size_t)TC * DM * 4;
constexpr size_t WS_SLOT = WS_GATES + (size_t)TT * 2 * 4;
constexpr size_t WS_LIST = WS_SLOT + (size_t)TT * 2 * 4;
constexpr size_t WS_H = WS_LIST + (size_t)NEXP * TT * 4;
constexpr size_t WS_P = WS_H + (size_t)TT * DM * 2;
constexpr size_t WS_Y2 = WS_P;

constexpr size_t WS_QN = WS_P + (size_t)TT * INC * 2;
constexpr size_t WS_KN = WS_QN + (size_t)TT * 512 * 2;
constexpr size_t WS_MIX = WS_KN + (size_t)TT * 128 * 2;
constexpr size_t WS_HS = WS_MIX + (size_t)TT * DM * 2;
constexpr size_t WS_HA = WS_HS + (size_t)2 * NB * NPOS * 4 * 4096 * 4;
constexpr size_t WS_HSB = WS_HA + (size_t)2 * NB * NPOS * 4 * 64 * 4;
constexpr size_t WS_QS = WS_HSB + (size_t)2 * NB * NPOS * 4 * 4096 * 2;
constexpr size_t WS_DELTA = WS_QS + (size_t)TT * 256 * 2;
constexpr size_t WS_END0 = WS_DELTA + (size_t)TT * DM * 2;
constexpr size_t WS_HID = WS_QN;
constexpr size_t WS_DUMMY = WS_END0;
constexpr size_t WS_END = WS_END0 + (DUP_PHASE ? 144 * MiB : 0);
static_assert((size_t)2 * TT * DM * 2 <= (size_t)TT * INC * 2, "Y2 fits in P");
static_assert(WS_HID + (size_t)MAXBLK * 256 * EH * 2 <= WS_END0, "HID fits in its overlay");
static_assert(WS_WIN % 256 == 0 && WS_H % 256 == 0 && WS_P % 256 == 0 && WS_QN % 256 == 0 && WS_KN % 256 == 0 && WS_MIX % 256 == 0 && WS_HS % 256 == 0 && WS_HA % 256 == 0 && WS_XC % 256 == 0 && WS_LIST % 256 == 0 && WS_GATES % 256 == 0, "alignment");
constexpr int CW_BAR = 4096;
constexpr int CW_QUEUE = 12288;
constexpr int CW_CVQ = 13312;
constexpr int CW_CNT = 16384;
constexpr int RING_BYTES = 131072;
constexpr int MISC_OFF = RING_BYTES;
constexpr int BLK_OFF = MISC_OFF + 512;
constexpr int LDS_BYTES = 147456;

struct Params {
    const float *x, *c, *ctx, *c_ctx, *norm1_g, *norm2_g, *ada_w, *ada_b, *w_in, *w_out, *pool_w, *pool_scale, *q_norm_g, *k_norm_g, *attn_sink, *hgrn_lb,
        *hgrn_norm_g, *rgw, *rgb, *rew, *reb, *ewg, *ewu, *ewd;
    float* out; unsigned char* ws;
};

DI unsigned short f2bf(float f) { unsigned u = __builtin_bit_cast(unsigned, f); return (unsigned short)((u + 0x7fffu + ((u >> 16) & 1u)) >> 16); }
DI float wave_sum(float v) {
#pragma unroll
    for (int o = 1; o < 64; o <<= 1) v += __shfl_xor(v, o);
    return v;
}
DI float fast_rcp(float v) { return __builtin_amdgcn_rcpf(v); }
DI float siluf(float v) { return v * fast_rcp(1.f + __expf(-v)); }
DI unsigned cvt_pk_bf16(float lo, float hi) { unsigned r; asm volatile("v_cvt_pk_bf16_f32 %0, %1, %2" : "=v"(r) : "v"(lo), "v"(hi)); return r; }
DI int modb_of_row(int row) { return row < TL ? (row >> 13) : 4; }

#define XB_TMO      128
#define XB_XCNT(j)  (256  + 64 * (j))
#define XB_XSUB(j)  (1280 + 64 * (j))
#define XB_XGEN(j)  (2304 + 64 * (j))
#define XB_TOP      3328
#define XB_TOPGEN   3392
#define XCD_BAR_WORDS 3456
#define XB_SPIN_CAP (1u << 18)
__device__ __forceinline__ unsigned xb_ld(unsigned* p)              { return __hip_atomic_load(p, __ATOMIC_RELAXED, __HIP_MEMORY_SCOPE_AGENT); }
__device__ __forceinline__ unsigned xb_add(unsigned* p, unsigned v) { return __hip_atomic_fetch_add(p, v, __ATOMIC_RELAXED, __HIP_MEMORY_SCOPE_AGENT); }
__device__ __forceinline__ unsigned xb_xcc_id() { return (unsigned)__builtin_amdgcn_s_getreg((3 << 11) | 20) & 0xFu; }
#define XB_SPIN(cond, bar) do { unsigned _sp = 0; while (cond) { __builtin_amdgcn_s_sleep(1); \
    if ((++_sp & 255u) == 0u) { if (xb_ld(&(bar)[XB_TMO])) break; if (_sp > XB_SPIN_CAP) { atomicAdd(&(bar)[XB_TMO], 1u); break; } } } } while (0)
struct XcdBarrier { unsigned* bar; unsigned x; volatile LAS unsigned* st; };
__device__ __forceinline__ XcdBarrier xcd_barrier_post(unsigned* bar, volatile LAS unsigned* st) {
    XcdBarrier b; b.bar = bar; b.x = xb_xcc_id(); b.st = st;
    if (threadIdx.x == 0) (void)xb_add(&bar[XB_XCNT(b.x)], 1u);
    return b;
}
__device__ __forceinline__ void xcd_barrier_complete(unsigned* bar, unsigned x, unsigned& nloc, unsigned& nx) {
    const unsigned G = gridDim.x * gridDim.y * gridDim.z;
    unsigned sum, cnt, mine, sp = 0u;
    for (;;) {
        sum = 0u; cnt = 0u; mine = 0u;
#pragma unroll 1
        for (unsigned j = 0; j < 16; ++j) { const unsigned c = xb_ld(&bar[XB_XCNT(j)]); sum += c; cnt += (c > 0u) ? 1u : 0u; mine = (j == x) ? c : mine; }
        if (sum == G) break;
        __builtin_amdgcn_s_sleep(1);
        if ((++sp & 255u) == 0u) { if (xb_ld(&bar[XB_TMO])) break; if (sp > XB_SPIN_CAP) { atomicAdd(&bar[XB_TMO], 1u); break; } }
    }
    nloc = mine > 0u ? mine : 1u; nx = cnt > 0u ? cnt : 1u;
}
__device__ __forceinline__ void xcd_barrier(const XcdBarrier& b) {
    asm volatile("s_waitcnt vmcnt(0)" ::: "memory");
    __syncthreads();
    if (threadIdx.x == 0) {
        unsigned* bar = b.bar;
        __builtin_amdgcn_s_waitcnt(0);
        unsigned nloc = b.st[0], nx = b.st[1];
        if (nloc == 0u) { xcd_barrier_complete(bar, b.x, nloc, nx); b.st[0] = nloc; b.st[1] = nx; }
        const unsigned old = xb_add(&bar[XB_XSUB(b.x)], 1u);
        const unsigned gen = old / nloc;
        if (old + 1u == (gen + 1u) * nloc) {
            __builtin_amdgcn_fence(__ATOMIC_RELEASE, "agent");
            asm volatile("s_waitcnt vmcnt(0)" ::: "memory");
            const unsigned og = xb_add(&bar[XB_TOP], 1u);
            const unsigned tg = og / nx;
            if (og + 1u == (tg + 1u) * nx) xb_add(&bar[XB_TOPGEN], 1u);
            else XB_SPIN(xb_ld(&bar[XB_TOPGEN]) == tg, bar);
            __builtin_amdgcn_fence(__ATOMIC_ACQUIRE, "agent");
            xb_add(&bar[XB_XGEN(b.x)], 1u);
            asm volatile("s_waitcnt vmcnt(0)" ::: "memory");
        } else {
            XB_SPIN(xb_ld(&bar[XB_XGEN(b.x)]) == gen, bar);
            __builtin_amdgcn_fence(__ATOMIC_ACQUIRE, "agent");
            asm volatile("s_waitcnt vmcnt(0)" ::: "memory");
        }
    }
    __syncthreads();
}

namespace pg8 {
constexpr int BM = 256, BK = 64, HALF = 128, HTB = HALF * BK * 2, STAGE_BYTES = 8 * HTB, NXCD = 8, WGM = 8;
DI int lds_byte(int r, int c) { const int st = (r >> 4) * 2 + (c >> 5), rr = r & 15, cc = c & 31, ob = rr * 64 + cc * 2; return st * 1024 + (ob ^ (((ob >> 9) & 1) << 5)); }
DI void stage_rc(int b, int& R, int& C) { const int st = b / 1024, sb = b % 1024, swz = sb ^ (((sb >> 9) & 1) << 5); R = (st >> 1) * 16 + swz / 64; C = (st & 1) * 32 + (swz % 64) / 2; }
DI int perm32(int rho) { const int n = rho >> 4, i = rho & 15; return 8 * (i >> 2) + 4 * n + (i & 3); }

struct Unit { int pm, pn, e, lrb; };
struct Gemm { const f16* A; const f16* Bt; int K; size_t bstride; };

struct StaticOrder {
    int nM, nN, nwg, G, c;
    DI void init(int M, int N, int G_, int c_) { nM = M / BM; nN = N / BM; nwg = nM * nN; G = G_; c = c_; }
    DI bool next(int i, Unit& u) const {
        const long L = (long)i * G + c; if (L >= nwg) return false;
        int wgid = (int)L; { const int q = nwg / NXCD, r = nwg % NXCD, xcd = wgid % NXCD, off = wgid / NXCD; wgid = (xcd < r ? xcd * (q + 1) : r * (q + 1) + (xcd - r) * q) + off; }
        const int nig = WGM * nN, gid = wgid / nig, fm = gid * WGM, gsz = (nM - fm) < WGM ? (nM - fm) : WGM;
        u.pm = fm + ((wgid % nig) % gsz); u.pn = (wgid % nig) / gsz; u.e = 0; u.lrb = 0; return true;
    }
    DI unsigned arow(const Unit&, int) const { return 0u; }
};
DI int moe_unit(int i, int G, int c, int U) {
    if (G % 8 != 0) { const int L = i * G + c; return L < U ? L : -1; }
    const int x = c & 7, j = c >> 3, W = G >> 3; const int lo = (int)(((long)U * x) >> 3), hi = (int)(((long)U * (x + 1)) >> 3); const int k = lo + i * W + j; return k < hi ? k : -1;
}
struct MoeOrder {
    int G, c, nblk; const LAS int* blk; const LAS int* cnt; const int* list; int rowbytes;
    const LAS int* utab;
    DI bool next(int i, Unit& u) const {
        const int L = moe_unit(i, G, c, nblk * 4); if (L < 0) return false;
        const int rb = L >> 2; u.pn = L & 3; u.pm = rb;
        const int t = utab[i]; u.e = t >> 16; u.lrb = t & 0xffff; return true;
    }
    DI unsigned arow(const Unit& u, int r) const {
        const int pos = u.lrb * 256 + r; const int ent = (pos < cnt[u.e]) ? list[(size_t)u.e * TT + pos] : 0;
        return (unsigned)(ent >> 1) * (unsigned)rowbytes;
    }
};

template <class Epi, class Sched, bool ALIGN_EPI, bool GATHER>
DI void gemm_phase(ldsp lds, const Gemm g, const Sched& S, const Epi& E, const int tid) {
    const int wid = __builtin_amdgcn_readfirstlane(tid >> 6), lane = tid & 63, wr = wid >> 2, wc = wid & 3, fr = lane & 15, fq = lane >> 4;
    const int K = g.K, nt = K / BK;
    int Rr[2], Cc[2]; unsigned voffB[2], voffA[2];
#pragma unroll
    for (int i = 0; i < 2; ++i) { int R, C; stage_rc(tid * 16 + i * 8192, R, C); const int Rb = Epi::PERM ? ((R & ~31) + perm32(R & 31)) : R;
        Rr[i] = R; Cc[i] = C; voffB[i] = (unsigned)(Rb * K + C) * 2u; voffA[i] = (unsigned)(R * K + C) * 2u; }
    const size_t kstep = (size_t)(BK * 2);
    const size_t hstep = (size_t)HALF * K * 2;
    const size_t tstep = 2 * hstep;
    const unsigned ldsw = (unsigned)wid * 1024u;
    const int aoff = lds_byte(wr * 64 + fr, fq * 8), boff = lds_byte(wc * 32 + fr, fq * 8);
    const char* const Ab = (const char*)g.A;
#define PG8_SA(b, h) (((b) * 2 + (h)) * HTB)
#define PG8_SB(b, h) ((4 + (b) * 2 + (h)) * HTB)
#define PG8_STAGE(bufoff, gbase, voff) do { _Pragma("unroll") for (int _i = 0; _i < 2; ++_i) \
        __builtin_amdgcn_global_load_lds((const unsigned*)((const char*)(gbase) + (voff)[_i]), (LAS unsigned*)(lds + (bufoff) + ldsw + _i * 8192), 16, 0, 0); } while (0)
#define PG8_LDA(dst, b, h) do { _Pragma("unroll") for (int m = 0; m < 4; ++m) _Pragma("unroll") for (int k = 0; k < 2; ++k) dst[m][k] = *(const LAS f16x8*)(lds + PG8_SA(b, h) + aoff + m * 2048 + k * 1024); } while (0)
#define PG8_LDB(dst, b, h) do { _Pragma("unroll") for (int n = 0; n < 2; ++n) _Pragma("unroll") for (int k = 0; k < 2; ++k) dst[n][k] = *(const LAS f16x8*)(lds + PG8_SB(b, h) + boff + n * 2048 + k * 1024); } while (0)
#define PG8_MMA(ai, bj, At, Bt) do { __builtin_amdgcn_s_setprio(1); _Pragma("unroll") for (int m = 0; m < 4; ++m) _Pragma("unroll") for (int n = 0; n < 2; ++n) _Pragma("unroll") for (int k = 0; k < 2; ++k) \
        acc[ai][bj][m][n] = __builtin_amdgcn_mfma_f32_16x16x32_f16(Bt[n][k], At[m][k], acc[ai][bj][m][n], 0, 0, 0); __builtin_amdgcn_s_setprio(0); } while (0)
#define PG8_WAIT_V(n) asm volatile("s_waitcnt vmcnt(" #n ")" ::: "memory")
#define PG8_WAIT_L(n) asm volatile("s_waitcnt lgkmcnt(" #n ")" ::: "memory")
#define PG8_BAR __builtin_amdgcn_s_barrier()
#define PG8_SCHED __builtin_amdgcn_sched_barrier(0)
#define PG8_AOFF(dst, U) do { if constexpr (GATHER) { _Pragma("unroll") for (int _h = 0; _h < 2; ++_h) _Pragma("unroll") for (int _i = 0; _i < 2; ++_i) \
        dst[_h][_i] = S.arow(U, _h * HALF + Rr[_i]) + (unsigned)Cc[_i] * 2u; } } while (0)
#define PG8_STAGE_A(bufoff, kb, nx, h) do { if constexpr (GATHER) { if (nx) PG8_STAGE(bufoff, Ab + (kb), aon[h]); else PG8_STAGE(bufoff, Ab + (kb), aoc[h]); } \
        else { PG8_STAGE(bufoff, ((nx) ? nA : cA) + (kb) + (h) * hstep, voffA); } } while (0)
    Unit cur, nxt; int ui = 0;
    if (!S.next(0, cur)) return;
    f32x4 acc[2][2][4][2];
#pragma unroll
    for (int a = 0; a < 2; ++a)
#pragma unroll
        for (int b = 0; b < 2; ++b)
#pragma unroll
            for (int m = 0; m < 4; ++m)
#pragma unroll
                for (int n = 0; n < 2; ++n) acc[a][b][m][n] = (f32x4){0.f, 0.f, 0.f, 0.f};
    f16x8 At[4][2], B0[2][2], B1[2][2];
    unsigned aoc[2][2], aon[2][2];
    PG8_AOFF(aoc, cur);
    const char* cA = Ab + (GATHER ? (size_t)0 : (size_t)cur.pm * tstep); const char* nA = cA;
    const char* cB = (const char*)g.Bt + ((size_t)cur.e * g.bstride) * 2 + (size_t)cur.pn * tstep;
    PG8_STAGE(PG8_SB(0, 0), cB, voffB); PG8_STAGE(PG8_SB(0, 1), cB + hstep, voffB); PG8_STAGE_A(PG8_SA(0, 0), 0, 0, 0); PG8_STAGE_A(PG8_SA(0, 1), 0, 0, 1);
    if (wr == 1) PG8_BAR;
    PG8_WAIT_V(2); PG8_BAR;
    PG8_STAGE(PG8_SB(1, 0), cB + kstep, voffB); PG8_STAGE_A(PG8_SA(1, 0), kstep, 0, 0); PG8_STAGE(PG8_SB(1, 1), cB + hstep + kstep, voffB);
    PG8_WAIT_V(6); PG8_BAR;
    for (;;) {
        const bool has_next = S.next(ui + 1, nxt);
        if constexpr (GATHER) { if (has_next) { PG8_AOFF(aon, nxt); } else {
#pragma unroll
            for (int _h = 0; _h < 2; ++_h)
#pragma unroll
                for (int _i = 0; _i < 2; ++_i) aon[_h][_i] = aoc[_h][_i]; } }
        else { nA = has_next ? Ab + (size_t)nxt.pm * tstep : cA; }
        const char* nB = has_next ? (const char*)g.Bt + ((size_t)nxt.e * g.bstride) * 2 + (size_t)nxt.pn * tstep : cB;
        for (int t = 0; t < nt; t += 2) {
            const bool last = (t == nt - 2);
            const size_t k1 = (size_t)(t + 1) * kstep, k2 = last ? (size_t)0 : (size_t)(t + 2) * kstep, k3 = k2 + kstep;
            const char* b2 = last ? nB : cB + (size_t)(t + 2) * kstep; const char* b3 = b2 + kstep;
            PG8_LDB(B0, 0, 0); PG8_LDB(B1, 0, 1); PG8_SCHED; PG8_LDA(At, 0, 0); PG8_STAGE_A(PG8_SA(1, 1), k1, 0, 1);
            PG8_WAIT_V(8); PG8_WAIT_L(0); PG8_BAR; PG8_MMA(0, 0, At, B0); PG8_MMA(0, 1, At, B1); PG8_BAR; PG8_SCHED;
            PG8_LDA(At, 0, 1); PG8_STAGE(PG8_SB(0, 0), b2, voffB); PG8_STAGE(PG8_SB(0, 1), b2 + hstep, voffB); PG8_STAGE_A(PG8_SA(0, 0), k2, last, 0);
            PG8_WAIT_V(8); PG8_WAIT_L(0); PG8_BAR; PG8_MMA(1, 0, At, B0); PG8_MMA(1, 1, At, B1); PG8_BAR; PG8_SCHED;
            PG8_LDB(B0, 1, 0); PG8_LDB(B1, 1, 1); PG8_SCHED; PG8_LDA(At, 1, 0); PG8_STAGE_A(PG8_SA(0, 1), k2, last, 1);
            PG8_WAIT_V(8); PG8_WAIT_L(0); PG8_BAR; PG8_MMA(0, 0, At, B0); PG8_MMA(0, 1, At, B1); PG8_BAR; PG8_SCHED;
            PG8_LDA(At, 1, 1); PG8_STAGE(PG8_SB(1, 0), b3, voffB); PG8_STAGE(PG8_SB(1, 1), b3 + hstep, voffB); PG8_STAGE_A(PG8_SA(1, 0), k3, last, 0);
            PG8_WAIT_V(8); PG8_WAIT_L(0); PG8_BAR; PG8_MMA(1, 0, At, B0); PG8_MMA(1, 1, At, B1); PG8_BAR; PG8_SCHED;
        }
        if constexpr (ALIGN_EPI) { if (wr == 0) PG8_BAR; }
        E(acc, cur, wr, wc, fr, fq);
        if (!has_next) break;
#pragma unroll
        for (int a = 0; a < 2; ++a)
#pragma unroll
            for (int b = 0; b < 2; ++b)
#pragma unroll
                for (int m = 0; m < 4; ++m)
#pragma unroll
                    for (int n = 0; n < 2; ++n) acc[a][b][m][n] = (f32x4){0.f, 0.f, 0.f, 0.f};
        cur = nxt; cB = nB; cA = nA; ++ui;
        if constexpr (GATHER) {
#pragma unroll
        for (int _h = 0; _h < 2; ++_h)
#pragma unroll
            for (int _i = 0; _i < 2; ++_i) aoc[_h][_i] = aon[_h][_i]; }
        if constexpr (ALIGN_EPI) { if (wr == 1) PG8_BAR; }
    }
    PG8_WAIT_V(0);
    if constexpr (!ALIGN_EPI) { if (wr == 0) PG8_BAR; }
    PG8_BAR;
#undef PG8_SA
#undef PG8_SB
#undef PG8_STAGE
#undef PG8_LDA
#undef PG8_LDB
#undef PG8_MMA
#undef PG8_WAIT_V
#undef PG8_WAIT_L
#undef PG8_BAR
#undef PG8_SCHED
#undef PG8_AOFF
#undef PG8_STAGE_A
}
}

typedef f32x4 AccT[2][2][4][2];
DI u32x4 pack8_f16(f32x4 a, f32x4 b) {
    f16x8 h; h[0] = (f16)a[0]; h[1] = (f16)a[1]; h[2] = (f16)a[2]; h[3] = (f16)a[3]; h[4] = (f16)b[0]; h[5] = (f16)b[1]; h[6] = (f16)b[2]; h[7] = (f16)b[3];
    return __builtin_bit_cast(u32x4, h);
}
struct EpiP { static constexpr bool PERM = true; f16* O; int ldc;
    DI void operator()(const AccT& acc, const pg8::Unit& u, int wr, int wc, int fr, int fq) const {
        char* base = (char*)(O + (size_t)u.pm * 256 * ldc + u.pn * 256);
        unsigned loff = (unsigned)((wr * 64 + fr) * ldc + wc * 32 + 8 * fq) * 2u;
        asm volatile("" : "+v"(loff));
#pragma unroll
        for (int ai = 0; ai < 2; ++ai)
#pragma unroll
            for (int m = 0; m < 4; ++m) {
#pragma unroll
                for (int bj = 0; bj < 2; ++bj) *(u32x4*)(base + (size_t)((ai * 128 + m * 16) * ldc + bj * 128) * 2 + loff) = pack8_f16(acc[ai][bj][m][0], acc[ai][bj][m][1]); }
    }
};
struct EpiOut { static constexpr bool PERM = true; f16* D; const float* modl;
    DI void operator()(const AccT& acc, const pg8::Unit& u, int wr, int wc, int fr, int fq) const {
        char* base = (char*)(D + (size_t)u.pm * 256 * DM + u.pn * 256);
        const float* g1 = modl + (u.pm < 128 ? (u.pm >> 5) : 4) * 6144 + 2 * 1024 + u.pn * 256;
        unsigned loff = (unsigned)((wr * 64 + fr) * DM + wc * 32 + 8 * fq) * 2u, goff = (unsigned)(wc * 32 + 8 * fq);
        asm volatile("" : "+v"(loff), "+v"(goff));
#pragma unroll
        for (int bj = 0; bj < 2; ++bj) { const f32x4 g0 = *(const f32x4*)(g1 + goff + bj * 128), g4 = *(const f32x4*)(g1 + goff + bj * 128 + 4);
#pragma unroll
            for (int ai = 0; ai < 2; ++ai)
#pragma unroll
                for (int m = 0; m < 4; ++m) *(u32x4*)(base + (size_t)((ai * 128 + m * 16) * DM + bj * 128) * 2 + loff) = pack8_f16(acc[ai][bj][m][0] * g0, acc[ai][bj][m][1] * g4); }
    }
};
struct EpiMoe1 { static constexpr bool PERM = true; f16* HID;
    DI void operator()(const AccT& acc, const pg8::Unit& u, int wr, int wc, int fr, int fq) const {
        char* base = (char*)(HID + (size_t)u.pm * 256 * EH + u.pn * 128);
        unsigned loff = (unsigned)((wr * 64 + fr) * EH + wc * 32 + 8 * fq) * 2u;
        asm volatile("" : "+v"(loff));
#pragma unroll
        for (int ai = 0; ai < 2; ++ai)
#pragma unroll
            for (int m = 0; m < 4; ++m) { f32x4 h0, h1;
#pragma unroll
                for (int i = 0; i < 4; ++i) { h0[i] = siluf(acc[ai][0][m][0][i]) * acc[ai][1][m][0][i]; h1[i] = siluf(acc[ai][0][m][1][i]) * acc[ai][1][m][1][i]; }
                *(u32x4*)(base + (size_t)((ai * 128 + m * 16) * EH) * 2 + loff) = pack8_f16(h0, h1); }
    }
};
struct EpiMoe2 { static constexpr bool PERM = true; f16* Y2;
    DI void operator()(const AccT& acc, const pg8::Unit& u, int wr, int wc, int fr, int fq) const {
        char* base = (char*)(Y2 + (size_t)u.pm * 256 * DM + u.pn * 256);
        unsigned loff = (unsigned)((wr * 64 + fr) * DM + wc * 32 + 8 * fq) * 2u;
        asm volatile("" : "+v"(loff));
#pragma unroll
        for (int ai = 0; ai < 2; ++ai)
#pragma unroll
            for (int m = 0; m < 4; ++m) {
#pragma unroll
                for (int bj = 0; bj < 2; ++bj) *(u32x4*)(base + (size_t)((ai * 128 + m * 16) * DM + bj * 128) * 2 + loff) = pack8_f16(acc[ai][bj][m][0], acc[ai][bj][m][1]); }
    }
};

DI void p0_transpose_item(const float* W, int K, int N, f16* WT, int mode, LAS float* scr, int item, int lane) {
    const int nblk = N / 32, kb = item / nblk, nb = item % nblk, k0 = 64 * kb, n0 = 32 * nb;
    const int rbase = (mode == 0) ? n0 : (256 * (n0 >> 7) + (n0 & 127) + (mode == 2 ? 128 : 0));
#pragma unroll 8
    for (int i = 0; i < 32; ++i) { const int kk = 2 * i + (lane >> 5); scr[kk * 33 + (lane & 31)] = W[(size_t)(k0 + kk) * N + n0 + (lane & 31)]; }
    asm volatile("s_waitcnt lgkmcnt(0)" ::: "memory");
    const int c = lane & 7;
#pragma unroll
    for (int j = 0; j < 4; ++j) { const int n = (lane >> 3) + 8 * j; const LAS float* s = scr + (8 * c) * 33 + n;
        f16x8 o;
#pragma unroll
        for (int q = 0; q < 8; ++q) o[q] = (f16)s[q * 33];
        *(f16x8*)(WT + (size_t)(rbase + n) * K + k0 + 8 * c) = o; }
    asm volatile("s_waitcnt lgkmcnt(0)" ::: "memory");
}

constexpr int CV_CHUNKS = 768;
DI void expert_item(const Params& p, int l, int r, LAS float* scr, int lane) {
    unsigned char* ws = p.ws; const int e = r / 768, q = r % 768, which = q >> 8, item = q & 255; const size_t le = (size_t)l * NEXP + e;
    if (which == 0) p0_transpose_item(p.ewg + le * DM * EH, DM, EH, (f16*)(ws + WS_WGU) + le * 1024 * 1024, 1, scr, item, lane);
    else if (which == 1) p0_transpose_item(p.ewu + le * DM * EH, DM, EH, (f16*)(ws + WS_WGU) + le * 1024 * 1024, 2, scr, item, lane);
    else p0_transpose_item(p.ewd + le * EH * DM, EH, DM, (f16*)(ws + WS_WD) + le * 1024 * 512, 0, scr, item, lane);
}
DI void convert_steal(const Params& p, int l, int maxpull, ldsp lds, int tid, int lane, int wave) {
    unsigned* qh = (unsigned*)(p.ws + WS_CTL) + CW_CVQ + l * 64; volatile LAS unsigned* slot = (volatile LAS unsigned*)(lds + MISC_OFF) + 24;
    LAS float* scr = (LAS float*)(lds + wave * 16384);
    for (int k = 0; k < maxpull; ++k) {
        __syncthreads();
        if (tid == 0) slot[0] = atomicAdd(qh, 1u);
        __syncthreads();
        const unsigned c = slot[0];
        if (c >= (unsigned)CV_CHUNKS) break;
#pragma unroll 1
        for (int j = 0; j < 4; ++j) expert_item(p, l, (int)c * 32 + wave * 4 + j, scr, lane);
    }
    __syncthreads();
}

DI void phase_prologue(const Params& p, ldsp lds, int tid, int lane, int wave, int vcu, int G) {
    unsigned char* ws = p.ws;
    LAS float* scr = (LAS float*)(lds + wave * 16384);
    const int gw = vcu * 8 + wave, NGW = G * 8;
    constexpr int PER_L = 1152 + 512;
    constexpr int NW_ITEMS = DEPTH * PER_L;
    for (int it = gw; it < NW_ITEMS + 32; it += NGW) {
        if (it >= NW_ITEMS) { const int j = it - NW_ITEMS, mat = j >> 1;
            p0_transpose_item(p.pool_w + (size_t)mat * 4096, 64, 64, (f16*)(ws + WS_POOLW) + (size_t)mat * 4096, 0, scr, j & 1, lane); continue; }
        const int l = it / PER_L; int r = it % PER_L;
        if (r < 1152) { p0_transpose_item(p.w_in + (size_t)l * DM * INC, DM, INC, (f16*)(ws + WS_WIN) + (size_t)l * INC * DM, 0, scr, r, lane); continue; } r -= 1152;
        p0_transpose_item(p.w_out + (size_t)l * DM * DM, DM, DM, (f16*)(ws + WS_WOUT) + (size_t)l * DM * DM, 0, scr, r, lane);
    }
    for (int it = gw; it < 32 * 768; it += NGW) expert_item(p, 0, it, scr, lane);
    { f16* WRH = (f16*)(ws + WS_WR); f16* WRL = WRH + (size_t)DEPTH * 48 * 1024;
      for (int i = vcu * 512 + tid; i < DEPTH * 48 * 1024; i += G * 512) { const int k = i & 1023, o = (i >> 10) % 48, l = i / (48 * 1024);
          float v = 0.f; if (o < 4) v = p.rgw[((size_t)l * 1024 + k) * 4 + o]; else if (o < 36) v = p.rew[((size_t)l * 1024 + k) * 32 + (o - 4)];
          v *= 1024.f; const f16 hi = (f16)v; WRH[i] = hi; WRL[i] = (f16)(v - (float)hi); } }
    { float* RT = (float*)(ws + WS_ROPE);
      for (int i = vcu * 512 + tid; i < (128 + 64) * 16; i += G * 512) { const int m = i & 15, pos = i >> 4;
          const float inv = powf(10000.f, -(float)m / 16.f); const float ang = (float)(pos < 128 ? pos : pos - 128) * inv; float s, c; sincosf(ang, &s, &c);
          if (pos < 128) { RT[pos * 16 + m] = c; RT[2048 + pos * 16 + m] = s; } else { RT[4096 + (pos - 128) * 16 + m] = c; RT[4096 + 1024 + (pos - 128) * 16 + m] = s; } } }
    if (vcu == 0) { float* LB = (float*)(ws + WS_LB);
        const float a0 = p.hgrn_lb[tid], a1 = p.hgrn_lb[512 + tid], a2 = p.hgrn_lb[1024 + tid], a3 = p.hgrn_lb[1536 + tid];
        const float mx = fmaxf(fmaxf(a0, a1), fmaxf(a2, a3)); const float e0 = expf(a0 - mx), e1 = expf(a1 - mx), e2 = expf(a2 - mx), e3 = expf(a3 - mx); const float inv = 1.f / (e0 + e1 + e2 + e3);
        LB[tid] = 0.f; LB[512 + tid] = e1 * inv; LB[1024 + tid] = (e1 + e2) * inv; LB[1536 + tid] = (e1 + e2 + e3) * inv; }
    __syncthreads();
    { LAS float* sl = (LAS float*)lds;
      LAS float* red = (LAS float*)(lds + 32768);
      for (int i = tid; i < 5 * 1024; i += 512) { const int b = i >> 10, k = i & 1023; const float v = (b < 4) ? p.c[b * 1024 + k] : p.c_ctx[k]; sl[i] = siluf(v); }
      __syncthreads();
      float* MOD = (float*)(ws + WS_MOD);
      for (int it = vcu; it < DEPTH * 96; it += G) { const int l = it / 96, col = (it % 96) * 64 + lane;
          const float* W = p.ada_w + (size_t)l * 1024 * 6144 + col; float a[5] = {0.f, 0.f, 0.f, 0.f, 0.f};
#pragma unroll 8
          for (int k = wave * 128; k < wave * 128 + 128; ++k) { const float w = W[(size_t)k * 6144];
#pragma unroll
              for (int b = 0; b < 5; ++b) a[b] += sl[b * 1024 + k] * w; }
#pragma unroll
          for (int b = 0; b < 5; ++b) red[(wave * 5 + b) * 64 + lane] = a[b];
          __syncthreads();
          if (tid < 320) { const int b = tid >> 6, cc = tid & 63; float s = 0.f;
#pragma unroll
              for (int w = 0; w < 8; ++w) s += red[(w * 5 + b) * 64 + cc];
              const int c2 = (it % 96) * 64 + cc; MOD[((size_t)l * 5 + b) * 6144 + c2] = s + p.ada_b[l * 6144 + c2]; }
          __syncthreads(); } }
}

DI void modulate_row_store(const f32x4 (&v)[4], float r, const float* gn, const float* sh, const float* sc, f16* hrow, int lane) {
#pragma unroll
    for (int j = 0; j < 4; ++j) { const int c = 256 * j + 4 * lane; const f32x4 g = *(const f32x4*)(gn + c), s = *(const f32x4*)(sh + c), k = *(const f32x4*)(sc + c);
        f16x4 o;
#pragma unroll
        for (int i = 0; i < 4; ++i) o[i] = (f16)(v[j][i] * r * g[i] * (1.f + k[i]) + s[i]);
        *(f16x4*)(hrow + c) = o; }
}
DI void phase_mod0(const Params& p, int lane, int wave, int vcu, int G) {
    const float* MOD = (const float*)(p.ws + WS_MOD); f16* H = (f16*)(p.ws + WS_H);
    for (int row = vcu * 8 + wave; row < TT; row += G * 8) {
        const float* xr = (row < TL) ? p.x + (size_t)row * DM : p.ctx + (size_t)(row - TL) * DM; const int b = modb_of_row(row);
        f32x4 v[4]; float s = 0.f;
#pragma unroll
        for (int j = 0; j < 4; ++j) { v[j] = *(const f32x4*)(xr + 256 * j + 4 * lane); s += v[j][0] * v[j][0] + v[j][1] * v[j][1] + v[j][2] * v[j][2] + v[j][3] * v[j][3]; }
        const float r = __builtin_amdgcn_rsqf(wave_sum(s) * (1.f / DM) + EPS);
        modulate_row_store(v, r, p.norm1_g, MOD + (size_t)b * 6144, MOD + (size_t)b * 6144 + 1024, H + (size_t)row * DM, lane);
    }
}
DI void phase_combine(const Params& p, int l, ldsp lds, int lane, int wave, int vcu, int G, int dry) {
    const LAS int* blk = (const LAS int*)(lds + BLK_OFF); const int* SLOT = (const int*)(p.ws + WS_SLOT);
    const float* MOD = (const float*)(p.ws + WS_MOD); f16* H = (f16*)(p.ws + (dry ? WS_DUMMY + 64 * MiB : WS_H)); const f16* Y2 = (const f16*)(p.ws + WS_Y2); const float* GT = (const float*)(p.ws + WS_GATES);
    float* XC = (float*)(p.ws + WS_XC);
    const int nrows = (l == DEPTH - 1) ? TL : TT; const int NGW = G * 8;
    int sl[2][2]; float gt[2][2];
    { const int r0 = vcu * 8 + wave;
#pragma unroll
      for (int q = 0; q < 2; ++q) { const int rr = r0 + q * NGW; const int row = rr < nrows ? rr : r0; if (r0 < nrows) { sl[q][0] = SLOT[row * 2]; sl[q][1] = SLOT[row * 2 + 1]; gt[q][0] = GT[row * 2]; gt[q][1] = GT[row * 2 + 1]; } } }
    for (int row0 = vcu * 8 + wave; row0 < nrows; row0 += 2 * NGW) {
        f32x4 v[2][4]; f16x4 ya[2][4], yb[2][4], dv[2][4]; float ga[2], gb[2]; int rows[2]; bool ok[2];
#pragma unroll
        for (int q = 0; q < 2; ++q) { const int rr = row0 + q * NGW; ok[q] = rr < nrows; const int row = ok[q] ? rr : row0; rows[q] = row;
            const float* xr = (row < TL) ? (l == 0 ? p.x : p.out) + (size_t)row * DM : (l == 0 ? p.ctx : XC) + (size_t)(row - TL) * DM; const f16* dl = (const f16*)(p.ws + WS_DELTA) + (size_t)row * DM;
            const int s0 = sl[q][0], s1 = sl[q][1]; const f16* y0 = Y2 + ((size_t)blk[s0 >> 20] * 256 + (s0 & 0xfffff)) * DM; const f16* y1 = Y2 + ((size_t)blk[s1 >> 20] * 256 + (s1 & 0xfffff)) * DM;
            ga[q] = gt[q][0]; gb[q] = gt[q][1];
#pragma unroll
            for (int j = 0; j < 4; ++j) { const int c = 256 * j + 4 * lane; v[q][j] = *(const f32x4*)(xr + c); dv[q][j] = *(const f16x4*)(dl + c); ya[q][j] = *(const f16x4*)(y0 + c); yb[q][j] = *(const f16x4*)(y1 + c); } }
        { const int r0 = row0 + 2 * NGW;
          if (r0 < nrows) {
#pragma unroll
            for (int q = 0; q < 2; ++q) { const int rr = r0 + q * NGW; const int row = rr < nrows ? rr : r0; sl[q][0] = SLOT[row * 2]; sl[q][1] = SLOT[row * 2 + 1]; gt[q][0] = GT[row * 2]; gt[q][1] = GT[row * 2 + 1]; } } }
        float ssum[2];
#pragma unroll
        for (int q = 0; q < 2; ++q) { const int row = rows[q]; const int b = modb_of_row(row); const float* g2 = MOD + ((size_t)l * 5 + b) * 6144 + 5 * 1024;
            float* xr = (row < TL) ? p.out + (size_t)row * DM : XC + (size_t)(row - TL) * DM; float* xw = dry ? (float*)(p.ws + WS_DUMMY) + (size_t)(row & 8191) * DM : xr; float s = 0.f;
#pragma unroll
            for (int j = 0; j < 4; ++j) { const int c = 256 * j + 4 * lane; const f32x4 g = *(const f32x4*)(g2 + c);
#pragma unroll
                for (int i = 0; i < 4; ++i) v[q][j][i] = (v[q][j][i] + (float)dv[q][j][i]) + g[i] * (ga[q] * (float)ya[q][j][i] + gb[q] * (float)yb[q][j][i]);
                if (ok[q]) *(f32x4*)(xw + c) = v[q][j];
                s += v[q][j][0] * v[q][j][0] + v[q][j][1] * v[q][j][1] + v[q][j][2] * v[q][j][2] + v[q][j][3] * v[q][j][3]; }
            ssum[q] = s; }
        if (l < DEPTH - 1) {
#pragma unroll
            for (int o = 1; o < 64; o <<= 1) { ssum[0] += __shfl_xor(ssum[0], o); ssum[1] += __shfl_xor(ssum[1], o); }
#pragma unroll
            for (int q = 0; q < 2; ++q) if (ok[q]) { const int row = rows[q]; const int b = modb_of_row(row); const float r = __builtin_amdgcn_rsqf(ssum[q] * (1.f / DM) + EPS); const float* m1 = MOD + ((size_t)(l + 1) * 5 + b) * 6144;
                modulate_row_store(v[q], r, p.norm1_g + (l + 1) * DM, m1, m1 + 1024, H + (size_t)row * DM, lane); } }
    }
}

DI f32x4 mma_f16(f16x8 a, f16x8 b, f32x4 c) { return __builtin_amdgcn_mfma_f32_16x16x32_f16(a, b, c, 0, 0, 0); }
DI f32x4 mma_bf16(s16x8 a, s16x8 b, f32x4 c) { return __builtin_amdgcn_mfma_f32_16x16x32_bf16(a, b, c, 0, 0, 0); }

constexpr int TP = 72;
struct TileInfo { int row0, t0, seqrow0, len, b, isctx, chunkpos_f, chunkpos_b; };
DI TileInfo tile_info(int tt) {
    TileInfo ti;
    if (tt < 512) { ti.b = tt >> 7; ti.t0 = (tt & 127) * 64; ti.seqrow0 = ti.b * SEQ; ti.len = SEQ; ti.isctx = 0; ti.chunkpos_f = 4 + (tt & 127); ti.chunkpos_b = 4 + 127 - (tt & 127); }
    else { const int j = tt - 512; ti.b = j >> 2; ti.t0 = (j & 3) * 64; ti.seqrow0 = TL + ti.b * CTXL; ti.len = CTXL; ti.isctx = 1; ti.chunkpos_f = (j & 3); ti.chunkpos_b = 3 - (j & 3); }
    ti.row0 = ti.seqrow0 + ti.t0; return ti;
}

typedef short v4i16_t __attribute__((ext_vector_type(4)));
DI int crow(int r, int hi) { return (r & 3) + 8 * (r >> 2) + 4 * hi; }
DI int swz(int row, int col) { return row * 64 + ((((col >> 3) ^ (row & 7)) << 3) | (col & 7)); }
DI s16x4 tr_read(const LAS unsigned short* p) { return __builtin_bit_cast(s16x4, __builtin_amdgcn_ds_read_tr16_b64_v4i16((LAS v4i16_t*)p)); }
#define LGKM0() asm volatile("s_waitcnt lgkmcnt(0)" ::: "memory")
DI void wave_load_tile64(LAS unsigned short* T, const f16* src, int pitch, int lane) {
    const int c = lane & 7;
    unsigned lo = (unsigned)((lane >> 3) * pitch + 8 * c) * 2u;
    asm volatile("" : "+v"(lo));
    const char* base = (const char*)src;
#pragma unroll
    for (int it = 0; it < 8; ++it) { const int row = 8 * it + (lane >> 3); const u32x4 v = *(const u32x4*)(base + (size_t)it * 8 * pitch * 2 + lo); *(LAS u32x4*)(T + row * 64 + ((c ^ (row & 7)) << 3)) = v; }
}
DI s16x8 tr_frag16(const LAS unsigned short* T, int k0, int n0, int lane) {
    const int g = lane >> 4, i = lane & 15, q = i >> 2, pp = i & 3; const int r0 = k0 + 8 * g + q;
    const s16x4 a = tr_read(T + swz(r0, n0 + 4 * pp)), b = tr_read(T + swz(r0 + 4, n0 + 4 * pp));
    return (s16x8){a[0], a[1], a[2], a[3], b[0], b[1], b[2], b[3]};
}

template <int CTRL, int RMASK> DI float dpp_add0(float v) { return __builtin_bit_cast(float, __builtin_amdgcn_update_dpp(0, __builtin_bit_cast(int, v), CTRL, RMASK, 0xf, true)); }
DI float bcast_lane(float v, int srclane) { return __builtin_bit_cast(float, __builtin_amdgcn_readlane(__builtin_bit_cast(int, v), srclane)); }
template <int CTRL, int RMASK> DI float dpp_mul1(float v) { return __builtin_bit_cast(float, __builtin_amdgcn_update_dpp(0x3f800000, __builtin_bit_cast(int, v), CTRL, RMASK, 0xf, false)); }
DI float wave_scan_mul(float v) {
    v *= dpp_mul1<0x111, 0xf>(v); v *= dpp_mul1<0x112, 0xf>(v); v *= dpp_mul1<0x114, 0xf>(v); v *= dpp_mul1<0x118, 0xf>(v);
    v *= dpp_mul1<0x142, 0xa>(v); v *= dpp_mul1<0x143, 0xc>(v);
    return v;
}
#define SCAN8_STEP(ctrl) \
    "v_mul_f32_dpp %0, %0, %0 " ctrl "\n\tv_mul_f32_dpp %1, %1, %1 " ctrl "\n\tv_mul_f32_dpp %2, %2, %2 " ctrl "\n\tv_mul_f32_dpp %3, %3, %3 " ctrl "\n\t" \
    "v_mul_f32_dpp %4, %4, %4 " ctrl "\n\tv_mul_f32_dpp %5, %5, %5 " ctrl "\n\tv_mul_f32_dpp %6, %6, %6 " ctrl "\n\tv_mul_f32_dpp %7, %7, %7 " ctrl "\n\t"
DI void wave_scan_mul8(float (&g)[8]) {
    asm volatile("s_nop 1\n\t"
        SCAN8_STEP("row_shr:1 row_mask:0xf bank_mask:0xf") SCAN8_STEP("row_shr:2 row_mask:0xf bank_mask:0xf") SCAN8_STEP("row_shr:4 row_mask:0xf bank_mask:0xf")
        SCAN8_STEP("row_shr:8 row_mask:0xf bank_mask:0xf") SCAN8_STEP("row_bcast:15 row_mask:0xa bank_mask:0xf") SCAN8_STEP("row_bcast:31 row_mask:0xc bank_mask:0xf")
        "s_nop 1"
        : "+v"(g[0]), "+v"(g[1]), "+v"(g[2]), "+v"(g[3]), "+v"(g[4]), "+v"(g[5]), "+v"(g[6]), "+v"(g[7]));
}
DI void hgrn_state_wave(const Params& p, int l, int item, LAS unsigned short* wl, int lane) {
    const int dir = item & 1, h = (item >> 1) & 3; const TileInfo ti = tile_info(item >> 3);
    const f16* P = (const f16*)(p.ws + WS_P); float* HS = (float*)(p.ws + WS_HS); float* HA = (float*)(p.ws + WS_HA);
    LAS unsigned short* Z = wl; LAS unsigned short* V = wl + 4096;
    const f16* prow = P + (size_t)ti.row0 * INC + h * 64;
    wave_load_tile64(Z, prow + (dir ? C_HZB : C_HZF), INC, lane); wave_load_tile64(V, prow + C_HI, INC, lane);
    const float* lbp = (const float*)(p.ws + WS_LB) + l * 512 + dir * 256 + h * 64;
    const int pos = dir ? ti.chunkpos_b : ti.chunkpos_f; const size_t slot = (size_t)((dir * NB + ti.b) * NPOS + pos) * 4 + h;
    float amine = 0.f;
    const int s_ = dir ? 63 - lane : lane;
    LGKM0();
#pragma unroll 1
    for (int c = 0; c < 8; ++c) { float g[8], kk[8]; LAS f16x8* zp = (LAS f16x8*)(Z + s_ * 64 + ((c ^ (s_ & 7)) << 3)); const f16x8 zv = *zp;
#pragma unroll
        for (int j = 0; j < 8; ++j) { const float lb = lbp[8 * c + j]; const float z = (float)zv[j]; const float sg = fast_rcp(1.f + __expf(-z)); g[j] = lb + (1.f - lb) * sg; kk[j] = (1.f - lb) * (1.f - sg); }
        wave_scan_mul8(g);
#pragma unroll
        for (int j = 0; j < 8; ++j) g[j] = fmaxf(g[j], 1e-37f);
        f16x8 ko;
#pragma unroll
        for (int j = 0; j < 8; ++j) { const float pend = bcast_lane(g[j], 63); ko[j] = (f16)(kk[j] * pend * fast_rcp(g[j])); amine = (lane == 8 * c + j) ? pend : amine; }
        *zp = ko; }
    HA[slot * 64 + lane] = amine;
    LGKM0();
    f32x4 acc[4][4];
#pragma unroll
    for (int m = 0; m < 4; ++m)
#pragma unroll
        for (int n = 0; n < 4; ++n) acc[m][n] = (f32x4){0.f, 0.f, 0.f, 0.f};
#pragma unroll
    for (int ks = 0; ks < 2; ++ks) { s16x8 a[4], b[4];
#pragma unroll
        for (int m = 0; m < 4; ++m) { a[m] = tr_frag16(V, 32 * ks, 16 * m, lane); b[m] = tr_frag16(Z, 32 * ks, 16 * m, lane); }
#pragma unroll
        for (int m = 0; m < 4; ++m)
#pragma unroll
            for (int n = 0; n < 4; ++n) acc[m][n] = mma_f16(__builtin_bit_cast(f16x8, a[m]), __builtin_bit_cast(f16x8, b[n]), acc[m][n]); }
    float* dst = HS + slot * 4096; const int fr = lane & 15, fq = lane >> 4;
#pragma unroll
    for (int m = 0; m < 4; ++m)
#pragma unroll
        for (int n = 0; n < 4; ++n)
#pragma unroll
            for (int i = 0; i < 4; ++i) dst[(16 * m + 4 * fq + i) * 64 + 16 * n + fr] = acc[m][n][i];
    LGKM0();
}

DI void qk_wave(const Params& p, int l, int pair8, int lane) {
    const f16* P = (const f16*)(p.ws + WS_P); f16* QN = (f16*)(p.ws + WS_QN); f16* KN = (f16*)(p.ws + WS_KN); const float* RT = (const float*)(p.ws + WS_ROPE);
    const int j8 = lane & 7; const int pidx = pair8 * 8 + (lane >> 3); const int row = pidx / 10, hh = pidx % 10;
    const f16x8 raw = *(const f16x8*)(P + (size_t)row * INC + C_Q + hh * 64 + 8 * j8);
    const bool lat = row < TL; const int t = lat ? (row & (SEQ - 1)) : 0; const int prow = t >> 6, pcol = t & 63; const int a0 = (8 * j8) & 31;
    const float* ct = (a0 < 16) ? RT + prow * 16 + a0 : RT + 4096 + pcol * 16 + (a0 - 16);
    const float* st = (a0 < 16) ? RT + 2048 + prow * 16 + a0 : RT + 4096 + 1024 + pcol * 16 + (a0 - 16);
    const float* gn = (hh < 8 ? p.q_norm_g : p.k_norm_g) + l * 64 + 8 * j8;
    const f32x4 c0 = *(const f32x4*)ct, c1 = *(const f32x4*)(ct + 4), s0 = *(const f32x4*)st, s1 = *(const f32x4*)(st + 4), g0 = *(const f32x4*)gn, g1 = *(const f32x4*)(gn + 4);
    float v[8]; float s = 0.f;
#pragma unroll
    for (int i = 0; i < 8; ++i) { v[i] = (float)raw[i]; s += v[i] * v[i]; }
    s += __shfl_xor(s, 1); s += __shfl_xor(s, 2); s += __shfl_xor(s, 4);
    const float r = __builtin_amdgcn_rsqf(s * (1.f / 64.f) + EPS) * ((hh < 8) ? 0.125f * LOG2E : 1.f);
    const float sgn = (j8 < 4) ? -1.f : 1.f;
    f16x8 o;
#pragma unroll
    for (int i = 0; i < 8; ++i) { const float gi = (i < 4) ? g0[i & 3] : g1[i & 3]; const float ci = lat ? ((i < 4) ? c0[i & 3] : c1[i & 3]) : 1.f, si = lat ? ((i < 4) ? s0[i & 3] : s1[i & 3]) * sgn : 0.f;
        v[i] = v[i] * r * gi; const float ot = __shfl_xor(v[i], 4); o[i] = (f16)(v[i] * ci + ot * si); }
    if (hh < 8) *(f16x8*)(QN + (size_t)row * 512 + hh * 64 + 8 * j8) = o; else *(f16x8*)(KN + (size_t)row * 128 + (hh - 8) * 64 + 8 * j8) = o;
}

DI void pool_wave(const Params& p, int l, int item, LAS unsigned short* wl, int lane) {
    const int g = item & 3; const TileInfo ti = tile_info(item >> 2); const int w = 2 << g;
    const f16* P = (const f16*)(p.ws + WS_P); f16* MIX = (f16*)(p.ws + WS_MIX); const f16* PW = (const f16*)(p.ws + WS_POOLW) + ((size_t)l * 4 + g) * 4096;
    { const int c = lane & 7;
#pragma unroll
      for (int it = 0; it < 10; ++it) { const int row = 8 * it + (lane >> 3); const int t = ti.t0 - 8 + row; u32x4 v = (u32x4){0u, 0u, 0u, 0u};
          if (t >= 0 && t < ti.len) v = *(const u32x4*)(P + (size_t)(ti.seqrow0 + t) * INC + C_U + g * 64 + 8 * c);
          *(LAS u32x4*)(wl + row * 64 + ((c ^ (row & 7)) << 3)) = v; } }
    LGKM0();
    const int fr = lane & 15, fq = lane >> 4;
    f32x4 acc[4][4];
#pragma unroll
    for (int m = 0; m < 4; ++m)
#pragma unroll
        for (int n = 0; n < 4; ++n) acc[m][n] = (f32x4){0.f, 0.f, 0.f, 0.f};
#pragma unroll
    for (int ks = 0; ks < 2; ++ks) { f16x8 bfr[4];
#pragma unroll
        for (int n = 0; n < 4; ++n) bfr[n] = *(const f16x8*)(PW + (n * 16 + fr) * 64 + 32 * ks + 8 * fq);
#pragma unroll
        for (int m = 0; m < 4; ++m) { const int tk = 16 * m + fr, t = ti.t0 + tk; const int ch = 4 * ks + fq;
            float sum[8] = {0.f, 0.f, 0.f, 0.f, 0.f, 0.f, 0.f, 0.f}; int cnt = 0;
            for (int off = -((w - 1) / 2); off <= w / 2; ++off) { const int q = t + off; const int row = tk + off + 8;
                const f16x8 v = *(const LAS f16x8*)(wl + row * 64 + ((ch ^ (row & 7)) << 3)); const bool ok = (q >= 0 && q < ti.len); cnt += ok ? 1 : 0;
#pragma unroll
                for (int i = 0; i < 8; ++i) sum[i] += (float)v[i]; }
            const int row = tk + 8; const f16x8 cv = *(const LAS f16x8*)(wl + row * 64 + ((ch ^ (row & 7)) << 3)); const float ic = 1.f / (float)cnt;
            f16x8 a;
#pragma unroll
            for (int i = 0; i < 8; ++i) a[i] = (f16)(sum[i] * ic - (float)cv[i]);
#pragma unroll
            for (int n = 0; n < 4; ++n) acc[m][n] = mma_f16(a, bfr[n], acc[m][n]); } }
#pragma unroll
    for (int n = 0; n < 4; ++n) { const int d = g * 64 + n * 16 + fr; const float ps = p.pool_scale[l * 256 + d];
#pragma unroll
        for (int m = 0; m < 4; ++m)
#pragma unroll
            for (int i = 0; i < 4; ++i) MIX[(size_t)(ti.row0 + 16 * m + 4 * fq + i) * DM + d] = (f16)(acc[m][n][i] * ps); }
    LGKM0();
}

DI void qs_wave(const Params& p, int item, int lane) {
    const int h = item & 3; const TileInfo ti = tile_info(item >> 2);
    const f16* prow = (const f16*)(p.ws + WS_P) + (size_t)ti.row0 * INC + C_HQ + h * 64; f16* QS = (f16*)(p.ws + WS_QS) + (size_t)ti.row0 * 256 + h * 64; const int c = lane & 7;
    f16x8 qv[8];
#pragma unroll
    for (int it = 0; it < 8; ++it) qv[it] = *(const f16x8*)(prow + (size_t)(8 * it + (lane >> 3)) * INC + 8 * c);
#pragma unroll
    for (int it = 0; it < 8; ++it) { f16x8 o;
#pragma unroll
        for (int j = 0; j < 8; ++j) o[j] = (f16)siluf((float)qv[it][j]);
        *(f16x8*)(QS + (size_t)(8 * it + (lane >> 3)) * 256 + 8 * c) = o; }
}

DI void phase_prep_w(const Params& p, int l, ldsp lds, int lane, int wave, int vcu, int G) {
    LAS unsigned short* wl = (LAS unsigned short*)(lds + wave * 16384);
    LAS unsigned* ctr = (LAS unsigned*)(lds + MISC_OFF) + 20;
    __syncthreads();
    if (threadIdx.x < 4) ctr[threadIdx.x] = 0u;
    __syncthreads();
    const int nH = (528 * 8 - vcu + G - 1) / G, nP = (528 * 4 - vcu + G - 1) / G;
    const int nQ8 = TT * 10 / 8; const int nQ = (nQ8 - vcu + G - 1) / G; const int nQc = (nQ + 10) / 11;
#define PULL(k) ({ unsigned t_ = 0; if (lane == 0) t_ = __hip_atomic_fetch_add(ctr + (k), 1u, __ATOMIC_RELAXED, __HIP_MEMORY_SCOPE_WORKGROUP); __builtin_amdgcn_readfirstlane((int)t_); })
    for (int idx = PULL(0); idx < nH; idx = PULL(0)) hgrn_state_wave(p, l, vcu + idx * G, wl, lane);
    for (int idx = PULL(1); idx < nP; idx = PULL(1)) pool_wave(p, l, vcu + idx * G, wl, lane);
    for (int idx = PULL(3); idx < nP; idx = PULL(3)) qs_wave(p, vcu + idx * G, lane);
    for (int idx = PULL(2); idx < nQc; idx = PULL(2)) { const int c0 = idx * 11;
#pragma unroll
        for (int k = c0; k < c0 + 11; ++k) qk_wave(p, l, vcu + (k < nQ ? k : nQ - 1) * G, lane); }
#undef PULL
}

DI void hgrn_out_wave(const Params& p, int l, int item, LAS unsigned short* wl, LAS float* wx, int lane) {
    const int h = item & 3; const TileInfo ti = tile_info(item >> 2);
    const f16* P = (const f16*)(p.ws + WS_P); const unsigned short* HS = (const unsigned short*)(p.ws + WS_HSB); f16* MIX = (f16*)(p.ws + WS_MIX);
    LAS unsigned short* BA = wl; LAS unsigned short* BB = wl + 4096;
    const f16* prow = P + (size_t)ti.row0 * INC + h * 64;
    const int r32 = lane & 31, hi = lane >> 5;
    f32x16 o[2][2];
#pragma unroll
    for (int a = 0; a < 2; ++a)
#pragma unroll
        for (int b = 0; b < 2; ++b)
#pragma unroll
            for (int r = 0; r < 16; ++r) o[a][b][r] = 0.f;
#pragma unroll 1
    for (int dir = 0; dir < 2; ++dir) {
        wave_load_tile64(BA, prow + (dir ? C_HZB : C_HZF), INC, lane); wave_load_tile64(BB, (const f16*)(p.ws + WS_QS) + (size_t)ti.row0 * 256 + h * 64, 256, lane);
        u32x4 vreg[8], sreg[8];
        { const int pos = dir ? ti.chunkpos_b : ti.chunkpos_f; const char* hs = (const char*)(HS + ((size_t)((dir * NB + ti.b) * NPOS + pos) * 4 + h) * 4096); const char* vb = (const char*)(prow + C_HI);
          unsigned lov = (unsigned)((lane >> 3) * INC + 8 * (lane & 7)) * 2u, los = (unsigned)((lane >> 3) * 64 + 8 * (lane & 7)) * 2u; asm volatile("" : "+v"(lov), "+v"(los));
#pragma unroll
          for (int it = 0; it < 8; ++it) { vreg[it] = *(const u32x4*)(vb + (size_t)it * 8 * INC * 2 + lov); sreg[it] = *(const u32x4*)(hs + (size_t)it * 8 * 64 * 2 + los); } }
        const float* lbp = (const float*)(p.ws + WS_LB) + l * 512 + dir * 256 + h * 64;
        float er_mine = 0.f;
        LGKM0();
        const int s_ = dir ? 63 - lane : lane;
#pragma unroll 1
        for (int c = 0; c < 8; ++c) { float g[8], kk[8]; LAS f16x8* zp = (LAS f16x8*)(BA + s_ * 64 + ((c ^ (s_ & 7)) << 3)); LAS f16x8* qp = (LAS f16x8*)(BB + s_ * 64 + ((c ^ (s_ & 7)) << 3));
            const f16x8 zv = *zp, qv = *qp;
#pragma unroll
            for (int j = 0; j < 8; ++j) { const float lb = lbp[8 * c + j]; const float z = (float)zv[j]; const float sg = fast_rcp(1.f + __expf(-z)); g[j] = lb + (1.f - lb) * sg; kk[j] = (1.f - lb) * (1.f - sg); }
            wave_scan_mul8(g);
#pragma unroll
            for (int j = 0; j < 8; ++j) g[j] = fmaxf(g[j], 1e-37f);
            float kf_[8], qf_[8];
#pragma unroll
            for (int j = 0; j < 8; ++j) { const float r = fast_rcp(g[j]); const float pref = bcast_lane(g[j], 31), rpref = bcast_lane(r, 31);
                kf_[j] = kk[j] * pref * r; qf_[j] = (float)qv[j] * g[j] * rpref; er_mine = (lane == 8 * c + j) ? pref : er_mine; }
            u32x4 ko, qo;
#pragma unroll
            for (int j = 0; j < 4; ++j) { ko[j] = cvt_pk_bf16(kf_[2 * j], kf_[2 * j + 1]); qo[j] = cvt_pk_bf16(qf_[2 * j], qf_[2 * j + 1]); }
            *(LAS u32x4*)zp = ko; *(LAS u32x4*)qp = qo; }
        wx[lane] = er_mine;
        LGKM0();
        s16x8 qf[2][4];
#pragma unroll
        for (int b = 0; b < 2; ++b)
#pragma unroll
            for (int d0 = 0; d0 < 4; ++d0) { const int row = 32 * b + r32, ch = 2 * d0 + hi; qf[b][d0] = *(const LAS s16x8*)(BB + row * 64 + ((ch ^ (row & 7)) << 3)); }
        LGKM0();
        { const int c = lane & 7;
#pragma unroll
          for (int it = 0; it < 8; ++it) { const int row = 8 * it + (lane >> 3); *(LAS u32x4*)(BB + row * 64 + ((c ^ (row & 7)) << 3)) = vreg[it]; } }
        LGKM0();
#pragma unroll
        for (int tb = 0; tb < 2; ++tb)
#pragma unroll
            for (int sb = 0; sb < 2; ++sb) {
                const bool diag = (sb == tb); const bool full = dir ? (sb > tb) : (sb < tb);
                if (!diag && !full) continue;
                f32x16 pt;
#pragma unroll
                for (int r = 0; r < 16; ++r) pt[r] = 0.f;
#pragma unroll
                for (int d0 = 0; d0 < 4; ++d0) { const int row = 32 * sb + r32, ch = 2 * d0 + hi; const s16x8 kf = *(const LAS s16x8*)(BA + row * 64 + ((ch ^ (row & 7)) << 3));
                    pt = __builtin_amdgcn_mfma_f32_32x32x16_bf16(kf, qf[tb][d0], pt, 0, 0, 0); }
                if (diag) {
#pragma unroll
                    for (int r = 0; r < 16; ++r) { const int sl = crow(r, hi); const bool keep = dir ? (sl >= r32) : (sl <= r32); pt[r] = keep ? pt[r] : 0.f; } }
                f16x8 pw[2];
#pragma unroll
                for (int j = 0; j < 8; ++j) { pw[0][j] = (f16)pt[j]; pw[1][j] = (f16)pt[8 + j]; }
#pragma unroll
                for (int dvb = 0; dvb < 2; ++dvb)
#pragma unroll
                    for (int ss = 0; ss < 2; ++ss) { const int i16 = lane & 15, g1 = (lane >> 4) & 1; const int r0 = 32 * sb + 16 * ss + 4 * hi + (i16 >> 2), c0 = 32 * dvb + 16 * g1 + 4 * (i16 & 3);
                        const s16x4 a = tr_read(BB + swz(r0, c0)), b = tr_read(BB + swz(r0 + 8, c0));
                        const s16x8 vf = (s16x8){a[0], a[1], a[2], a[3], b[0], b[1], b[2], b[3]};
                        o[dvb][tb] = __builtin_amdgcn_mfma_f32_32x32x16_f16(__builtin_bit_cast(f16x8, vf), pw[ss], o[dvb][tb], 0, 0, 0); }
            }
        LGKM0();
        { const int c8 = lane & 7; const f32x4 er0 = *(const LAS f32x4*)(wx + 8 * c8), er1 = *(const LAS f32x4*)(wx + 8 * c8 + 4);
#pragma unroll
          for (int it = 0; it < 8; ++it) { const int row = 8 * it + (lane >> 3); const u32x4 sv = sreg[it];
              u32x4 w4;
#pragma unroll
              for (int q = 0; q < 4; ++q) { const float lo = __builtin_bit_cast(float, sv[q] << 16), hi2 = __builtin_bit_cast(float, sv[q] & 0xffff0000u);
                  const float e0 = (q < 2) ? er0[2 * q] : er1[2 * q - 4], e1 = (q < 2) ? er0[2 * q + 1] : er1[2 * q - 3]; w4[q] = cvt_pk_bf16(lo * e0, hi2 * e1); }
              *(LAS u32x4*)(BA + row * 64 + ((c8 ^ (row & 7)) << 3)) = w4; } }
        LGKM0();
#pragma unroll
        for (int dvb = 0; dvb < 2; ++dvb)
#pragma unroll
            for (int d0 = 0; d0 < 4; ++d0) { const int row = 32 * dvb + r32, ch = 2 * d0 + hi; const s16x8 sf = *(const LAS s16x8*)(BA + row * 64 + ((ch ^ (row & 7)) << 3));
#pragma unroll
                for (int tb = 0; tb < 2; ++tb) o[dvb][tb] = __builtin_amdgcn_mfma_f32_32x32x16_bf16(sf, qf[tb][d0], o[dvb][tb], 0, 0, 0); }
        LGKM0();
    }
    const float* gn = p.hgrn_norm_g + l * 64;
#pragma unroll
    for (int tb = 0; tb < 2; ++tb) { float ss = 0.f;
#pragma unroll
        for (int dvb = 0; dvb < 2; ++dvb)
#pragma unroll
            for (int r = 0; r < 16; ++r) ss += o[dvb][tb][r] * o[dvb][tb][r];
        ss += __shfl_xor(ss, 32); const float rn = __builtin_amdgcn_rsqf(ss * (1.f / 64.f) + EPS);
        const size_t row = (size_t)ti.row0 + 32 * tb + r32;
#pragma unroll
        for (int dvb = 0; dvb < 2; ++dvb)
#pragma unroll
            for (int g4 = 0; g4 < 4; ++g4) { const int dv0 = 32 * dvb + 8 * g4 + 4 * hi; const f16x4 gt = *(const f16x4*)(P + row * INC + C_HG + h * 64 + dv0); const f32x4 gg = *(const f32x4*)(gn + dv0);
                f16x4 ov;
#pragma unroll
                for (int i = 0; i < 4; ++i) ov[i] = (f16)(o[dvb][tb][4 * g4 + i] * rn * gg[i] * siluf((float)gt[i]));
                *(f16x4*)(MIX + row * DM + 768 + h * 64 + dv0) = ov; } }
}
DI void phase_hgrn_out_w(const Params& p, int l, ldsp lds, int lane, int wave, int vcu, int G) {
    LAS unsigned short* wl = (LAS unsigned short*)(lds + wave * 16384); LAS float* wx = (LAS float*)(lds + BLK_OFF + 1024 + wave * 512);
    const int gw = vcu * 8 + wave, NGW = G * 8;
    const int nit = (l == DEPTH - 1) ? 512 * 4 : 528 * 4;
    for (int it = gw; it < nit; it += NGW) hgrn_out_wave(p, l, it, wl, wx, lane);
}

DI void phase_scan(const Params& p, int tid, int vcu, int G, int dry) {
    const float* HS = (const float*)(p.ws + WS_HS); const float* HA = (const float*)(p.ws + WS_HA); unsigned short* HSB = (unsigned short*)(p.ws + (dry ? WS_DUMMY : WS_HSB));
    for (int gid = vcu * 512 + tid; gid < 2 * NB * 4 * 4096; gid += G * 512) {
        const int el = gid & 4095, h = (gid >> 12) & 3, db = gid >> 14;
        const size_t hoff = ((size_t)db * NPOS * 4 + h) * 4096 + el; const float* hs = HS + hoff; unsigned short* hso = HSB + hoff; const float* ha = HA + ((size_t)db * NPOS * 4 + h) * 64 + (el & 63);
        float S = 0.f;
        for (int pos = 0; pos < NPOS; pos += 12) { float u[12], a[12];
#pragma unroll
            for (int j = 0; j < 12; ++j) { u[j] = hs[(size_t)(pos + j) * 4 * 4096]; a[j] = ha[(size_t)(pos + j) * 4 * 64]; }
#pragma unroll
            for (int j = 0; j < 12; ++j) { hso[(size_t)(pos + j) * 4 * 4096] = f2bf(S); S = a[j] * S + u[j]; } }
    }
}

DI void attn_item(const Params& p, int l, int idx, ldsp lds, int tid, int lane, int wave) {
    const f16* P = (const f16*)(p.ws + WS_P); const f16* QN = (const f16*)(p.ws + WS_QN); const f16* KN = (const f16*)(p.ws + WS_KN); f16* MIX = (f16*)(p.ws + WS_MIX);
    int b, kvh, qb, isctx;
    if (idx < 1024) { b = idx >> 8; kvh = (idx >> 7) & 1; qb = idx & 127; isctx = 0; } else { const int j = idx - 1024; b = j >> 3; kvh = (j >> 2) & 1; qb = j & 3; isctx = 1; }
    const int q0 = qb * 64; const int qrowbase = isctx ? TL + b * CTXL : b * SEQ;
    const int r32 = lane & 31, hi = lane >> 5; const int hq = kvh * 4 + (wave >> 1); const int qpos = q0 + (wave & 1) * 32 + r32; const size_t qrow = (size_t)qrowbase + qpos;
    LAS f16* KB = (LAS f16*)lds;
    LAS f16* VTB = KB + 2 * 64 * TP;
    f16x8 qr[4];
#pragma unroll
    for (int d0 = 0; d0 < 4; ++d0) qr[d0] = *(const f16x8*)(QN + qrow * 512 + hq * 64 + 16 * d0 + 8 * hi);
    float lsum = hi ? 0.f : __builtin_amdgcn_exp2f(p.attn_sink[l * 8 + hq] * LOG2E - 4.f);
    f32x16 o[2];
#pragma unroll
    for (int r = 0; r < 16; ++r) { o[0][r] = 0.f; o[1][r] = 0.f; }
    const int srow = tid >> 3, sc8 = tid & 7;
    const int ntile = isctx ? 4 : 9;
    int cur = 0; bool have = false; f16x8 kreg, vreg;
    int tix = 0;
#define TILE_VALID(t) (isctx || (t) >= 5 || ((q0 - 128 + 64 * (t)) >= 0 && (q0 - 128 + 64 * (t)) < SEQ))
#define TILE_ROW(t) ((isctx || (t) >= 5) ? (TL + b * CTXL + 64 * (isctx ? (t) : (t) - 5)) : (b * SEQ + q0 - 128 + 64 * (t)))
    while (tix < ntile && !TILE_VALID(tix)) ++tix;
    { const size_t kr = (size_t)TILE_ROW(tix) + srow; kreg = *(const f16x8*)(KN + kr * 128 + kvh * 64 + 8 * sc8); vreg = *(const f16x8*)(P + kr * INC + C_V + kvh * 64 + 8 * sc8); }
    __syncthreads();
    { *(LAS f16x8*)(KB + srow * TP + 8 * sc8) = kreg;
#pragma unroll
      for (int i = 0; i < 8; ++i) VTB[(8 * sc8 + i) * TP + srow] = vreg[i]; }
    __syncthreads();
    while (tix < ntile) {
        int nx = tix + 1; while (nx < ntile && !TILE_VALID(nx)) ++nx;
        have = nx < ntile;
        if (have) { const size_t kr = (size_t)TILE_ROW(nx) + srow; kreg = *(const f16x8*)(KN + kr * 128 + kvh * 64 + 8 * sc8); vreg = *(const f16x8*)(P + kr * INC + C_V + kvh * 64 + 8 * sc8); }
        const LAS f16* Kc = KB + cur * 64 * TP; const LAS f16* Vc = VTB + cur * 64 * TP;
        f32x16 p0, p1;
#pragma unroll
        for (int r = 0; r < 16; ++r) { p0[r] = -4.f; p1[r] = -4.f; }
#pragma unroll
        for (int d0 = 0; d0 < 4; ++d0) { const f16x8 k0 = *(const LAS f16x8*)(Kc + r32 * TP + 16 * d0 + 8 * hi); const f16x8 k1 = *(const LAS f16x8*)(Kc + (32 + r32) * TP + 16 * d0 + 8 * hi);
            p0 = __builtin_amdgcn_mfma_f32_32x32x16_f16(k0, qr[d0], p0, 0, 0, 0); p1 = __builtin_amdgcn_mfma_f32_32x32x16_f16(k1, qr[d0], p1, 0, 0, 0); }
        if (!isctx && (tix == 0 || tix == 4)) { const int kstart = q0 - 128 + 64 * tix;
#pragma unroll
            for (int r = 0; r < 16; ++r) { const int d0_ = qpos - (kstart + crow(r, hi)); if (d0_ > 128 || d0_ < -128) p0[r] = -INFINITY; const int d1_ = d0_ - 32; if (d1_ > 128 || d1_ < -128) p1[r] = -INFINITY; } }
        float ps = 0.f;
#pragma unroll
        for (int r = 0; r < 16; ++r) { p0[r] = __builtin_amdgcn_exp2f(p0[r]); p1[r] = __builtin_amdgcn_exp2f(p1[r]); ps += p0[r] + p1[r]; }
        lsum += ps;
        f16x8 pw[4];
#pragma unroll
        for (int j = 0; j < 8; ++j) { pw[0][j] = (f16)p0[j]; pw[1][j] = (f16)p0[8 + j]; pw[2][j] = (f16)p1[j]; pw[3][j] = (f16)p1[8 + j]; }
#pragma unroll
        for (int s_ = 0; s_ < 4; ++s_) pw[s_] = __builtin_elementwise_min(pw[s_], (f16x8){(f16)65504.f, (f16)65504.f, (f16)65504.f, (f16)65504.f, (f16)65504.f, (f16)65504.f, (f16)65504.f, (f16)65504.f});
#pragma unroll
        for (int d1 = 0; d1 < 2; ++d1)
#pragma unroll
            for (int s = 0; s < 4; ++s) { const LAS f16* vp = Vc + (32 * d1 + r32) * TP + 16 * s + 4 * hi; const f16x4 lo = *(const LAS f16x4*)vp, hv = *(const LAS f16x4*)(vp + 8);
                const f16x8 vf = (f16x8){lo[0], lo[1], lo[2], lo[3], hv[0], hv[1], hv[2], hv[3]};
                o[d1] = __builtin_amdgcn_mfma_f32_32x32x16_f16(vf, pw[s], o[d1], 0, 0, 0); }
        if (have) { LAS f16* Kn = KB + (cur ^ 1) * 64 * TP; LAS f16* Vn = VTB + (cur ^ 1) * 64 * TP;
            *(LAS f16x8*)(Kn + srow * TP + 8 * sc8) = kreg;
#pragma unroll
            for (int i = 0; i < 8; ++i) Vn[(8 * sc8 + i) * TP + srow] = vreg[i]; }
        __syncthreads();
        cur ^= 1; tix = nx;
    }
#undef TILE_VALID
#undef TILE_ROW
    const float lt = lsum + __shfl_xor(lsum, 32); const float il = 1.f / lt;
    f16* orow = MIX + qrow * DM + 256 + hq * 64;
#pragma unroll
    for (int d1 = 0; d1 < 2; ++d1)
#pragma unroll
        for (int g = 0; g < 4; ++g) { f16x4 v;
#pragma unroll
            for (int i = 0; i < 4; ++i) v[i] = (f16)(o[d1][4 * g + i] * il);
            *(f16x4*)(orow + 32 * d1 + 8 * g + 4 * hi) = v; }
}
DI void phase_attn(const Params& p, int l, ldsp lds, int tid, int lane, int wave, int vcu, int G, int rep) {
    unsigned* qc = (unsigned*)(p.ws + WS_CTL) + CW_QUEUE + (l * 2 + rep) * 64; volatile LAS unsigned* slot = (volatile LAS unsigned*)(lds + MISC_OFF) + 16;
    const int nitems = (l == DEPTH - 1) ? 1024 : 1056;
    __syncthreads();
    if (tid == 0) slot[0] = atomicAdd(qc, 1u);
    __syncthreads();
    unsigned it = slot[0];
    while (it < (unsigned)nitems) {
        __syncthreads();
        if (tid == 0) slot[0] = atomicAdd(qc, 1u);
        attn_item(p, l, (int)it, lds, tid, lane, wave);
        __syncthreads();
        it = slot[0];
    }
    __syncthreads();
}

DI void phase_outproj_ctx(const Params& p, int l, int lane, int wave, int vcu, int G, int dry) {
    const f16* MIX = (const f16*)(p.ws + WS_MIX) + (size_t)TL * DM; const f16* W = (const f16*)(p.ws + WS_WOUT) + (size_t)l * DM * DM;
    f16* xd = (f16*)(p.ws + (dry ? WS_DUMMY + 136 * MiB : WS_DELTA)) + (dry ? 0 : (size_t)TL * DM);
    const float* g1 = (const float*)(p.ws + WS_MOD) + ((size_t)l * 5 + 4) * 6144 + 2 * 1024;
    const int fr = lane & 15, fq = lane >> 4;
    for (int it = vcu; it < 256; it += G) { const int r0 = (it >> 4) * 64 + 16 * (wave & 3), c0 = (it & 15) * 64 + 32 * (wave >> 2);
        f32x4 acc[2] = {(f32x4){0.f, 0.f, 0.f, 0.f}, (f32x4){0.f, 0.f, 0.f, 0.f}};
        const f16* ap = MIX + (size_t)(r0 + fr) * DM + 8 * fq; const f16* bp = W + (size_t)(c0 + fr) * DM + 8 * fq;
#pragma unroll 8
        for (int ks = 0; ks < 32; ++ks) { const f16x8 a = *(const f16x8*)(ap + 32 * ks); const f16x8 b0 = *(const f16x8*)(bp + 32 * ks), b1 = *(const f16x8*)(bp + 16 * DM + 32 * ks);
            acc[0] = mma_f16(a, b0, acc[0]); acc[1] = mma_f16(a, b1, acc[1]); }
#pragma unroll
        for (int n = 0; n < 2; ++n) { const int col = c0 + 16 * n + fr; const float gv = g1[col];
#pragma unroll
            for (int i = 0; i < 4; ++i) xd[(size_t)(r0 + 4 * fq + i) * DM + col] = (f16)(gv * acc[n][i]); } }
}

DI void phase_router(const Params& p, int l, ldsp lds, int tid, int lane, int wave, int vcu, int G, int dry) {
    const float* MOD = (const float*)(p.ws + WS_MOD); f16* H = (f16*)(p.ws + (dry ? WS_DUMMY : WS_H)); const float* XC = (const float*)(p.ws + WS_XC); const f16* WRH = (const f16*)(p.ws + WS_WR) + (size_t)l * 48 * 1024; const f16* WRL = WRH + (size_t)DEPTH * 48 * 1024;
    int* SLOT = (int*)(p.ws + (dry ? WS_DUMMY + 88 * MiB : WS_SLOT)); float* GT = (float*)(p.ws + (dry ? WS_DUMMY + 80 * MiB : WS_GATES)); int* LIST = (int*)(p.ws + (dry ? WS_DUMMY + 96 * MiB : WS_LIST)); unsigned* CNT = (unsigned*)(p.ws + WS_CTL) + CW_CNT + l * 32 * 16 + (dry ? 4096 : 0);
    constexpr int XP = 1028;
    LAS float* XT = (LAS float*)lds;
    LAS float* PART = XT + 16 * XP;
    LAS float* LG = PART + 8 * 16 * 48;
    const int fr = lane & 15, fq = lane >> 4;
    f16x8 wh[4][3], wl_[4][3];
#pragma unroll
    for (int ks = 0; ks < 4; ++ks)
#pragma unroll
        for (int n = 0; n < 3; ++n) { const size_t o = (size_t)(16 * n + fr) * 1024 + wave * 128 + 32 * ks + 8 * fq; wh[ks][n] = *(const f16x8*)(WRH + o); wl_[ks][n] = *(const f16x8*)(WRL + o); }
    const int ntiles = (l == DEPTH - 1 ? TL : TT) / 16;
    LAS int* SEL = (LAS int*)(LG + 16 * 48);
    LAS int* BASE = SEL + 64;
    f32x4 v[2][4];
    const float* xsl = (l == 0) ? p.x : p.out; const float* xsc = (l == 0) ? p.ctx : XC; const f16* DL = (const f16*)(p.ws + WS_DELTA);
    float* xwl = dry ? (float*)(p.ws + WS_DUMMY + 8 * MiB) : p.out; float* xwc = dry ? (float*)(p.ws + WS_DUMMY + 8 * MiB) : (float*)(p.ws + WS_XC);
    f16x4 dv[2][4];
#define RT_LOAD(tile_) do { _Pragma("unroll") for (int q = 0; q < 2; ++q) { const int row = (tile_) * 16 + wave + 8 * q; const float* xr_ = (row < TL) ? xsl + (size_t)row * DM : xsc + (size_t)(row - TL) * DM; \
        _Pragma("unroll") for (int j = 0; j < 4; ++j) { v[q][j] = *(const f32x4*)(xr_ + 256 * j + 4 * lane); dv[q][j] = *(const f16x4*)(DL + (size_t)row * DM + 256 * j + 4 * lane); } } } while (0)
#define RT_FLUSH(buf_, row0_) do { if (tid < 32) { const int e = SEL[(buf_) * 32 + tid]; int rank = 0; \
        _Pragma("unroll") for (int j = 0; j < 32; ++j) rank += (j < tid && SEL[(buf_) * 32 + j] == e) ? 1 : 0; \
        const int pos_ = BASE[(buf_) * 32 + e] + rank; const int ent_ = ((row0_) + (tid >> 1)) * 2 + (tid & 1); LIST[(size_t)e * TT + pos_] = ent_; SLOT[ent_] = (e << 20) | pos_; } } while (0)
    int tile = vcu; int cur = 0; int prev_row0 = -1; unsigned pend = 0u; bool pend_valid = false;
    if (tile < ntiles) RT_LOAD(tile);
    for (; tile < ntiles; tile += G, cur ^= 1) {
        const int row0 = tile * 16;
        { float ssum[2];
#pragma unroll
          for (int q = 0; q < 2; ++q) { float s = 0.f; const int row = row0 + wave + 8 * q; float* xw_ = (row < TL) ? xwl + (size_t)(dry ? (row & 1023) : row) * DM : xwc + (size_t)(row - TL) * DM;
#pragma unroll
              for (int j = 0; j < 4; ++j) {
#pragma unroll
                  for (int i = 0; i < 4; ++i) v[q][j][i] += (float)dv[q][j][i];
                  s += v[q][j][0] * v[q][j][0] + v[q][j][1] * v[q][j][1] + v[q][j][2] * v[q][j][2] + v[q][j][3] * v[q][j][3]; }
              ssum[q] = s; }
#pragma unroll
          for (int o = 1; o < 64; o <<= 1) { ssum[0] += __shfl_xor(ssum[0], o); ssum[1] += __shfl_xor(ssum[1], o); }
          const int b = modb_of_row(row0); const float* m2 = MOD + ((size_t)l * 5 + b) * 6144; const float* gn = p.norm2_g + l * DM;
#pragma unroll
          for (int j = 0; j < 4; ++j) { const int c = 256 * j + 4 * lane; const f32x4 g = *(const f32x4*)(gn + c), sh = *(const f32x4*)(m2 + 3 * 1024 + c), sc = *(const f32x4*)(m2 + 4 * 1024 + c);
#pragma unroll
              for (int q = 0; q < 2; ++q) { const int rr = wave + 8 * q; const float r = __builtin_amdgcn_rsqf(ssum[q] * (1.f / DM) + EPS); f32x4 hv; f16x4 o;
#pragma unroll
                  for (int i = 0; i < 4; ++i) { hv[i] = v[q][j][i] * r * g[i] * (1.f + sc[i]) + sh[i]; o[i] = (f16)hv[i]; }
                  *(f16x4*)(H + (size_t)(row0 + rr) * DM + c) = o; *(LAS f32x4*)(XT + rr * XP + c) = hv; } } }
        if (pend_valid) BASE[(cur ^ 1) * 32 + tid] = (int)pend;
        __syncthreads();
        if (tile + G < ntiles) RT_LOAD(tile + G);
        if (prev_row0 >= 0) RT_FLUSH(cur ^ 1, prev_row0);
        { f32x4 acc[3];
#pragma unroll
          for (int n = 0; n < 3; ++n) acc[n] = (f32x4){0.f, 0.f, 0.f, 0.f};
#pragma unroll
          for (int ks = 0; ks < 4; ++ks) { const LAS float* xp = XT + fr * XP + wave * 128 + 32 * ks + 8 * fq; const f32x4 x0 = *(const LAS f32x4*)xp, x1 = *(const LAS f32x4*)(xp + 4);
              f16x8 ah, al;
#pragma unroll
              for (int j = 0; j < 4; ++j) { ah[j] = (f16)x0[j]; al[j] = (f16)(x0[j] - (float)ah[j]); ah[4 + j] = (f16)x1[j]; al[4 + j] = (f16)(x1[j] - (float)ah[4 + j]); }
#pragma unroll
              for (int n = 0; n < 3; ++n) { acc[n] = mma_f16(ah, wh[ks][n], acc[n]); acc[n] = mma_f16(ah, wl_[ks][n], acc[n]); acc[n] = mma_f16(al, wh[ks][n], acc[n]); } }
#pragma unroll
          for (int n = 0; n < 3; ++n)
#pragma unroll
              for (int i = 0; i < 4; ++i) PART[(wave * 16 + 4 * fq + i) * 48 + 16 * n + fr] = acc[n][i] * (1.f / 1024.f); }
        __syncthreads();
        for (int i = tid; i < 16 * 36; i += 512) { const int tk = i / 36, o = i % 36; float s = 0.f;
#pragma unroll
            for (int w = 0; w < 8; ++w) s += PART[(w * 16 + tk) * 48 + o];
            LG[tk * 48 + o] = s + (o < 4 ? p.rgb[l * 4 + o] : p.reb[l * 32 + (o - 4)]); }
        __syncthreads();
        if (tid < 16) { const int row = row0 + tid; const LAS float* lg = LG + tid * 48;
            int g = 0; float gm = lg[0];
#pragma unroll
            for (int j = 1; j < 4; ++j) if (lg[j] > gm) { gm = lg[j]; g = j; }
            float den = 0.f;
#pragma unroll
            for (int j = 0; j < 4; ++j) den += expf(lg[j] - gm);
            const float pg = 1.f / den;
            const LAS float* le = lg + 4 + 8 * g; int e0 = 0; float m0 = le[0];
#pragma unroll
            for (int j = 1; j < 8; ++j) if (le[j] > m0) { m0 = le[j]; e0 = j; }
            int e1 = -1; float m1 = -INFINITY;
#pragma unroll
            for (int j = 0; j < 8; ++j) if (j != e0 && le[j] > m1) { m1 = le[j]; e1 = j; }
            const float w0 = 1.f / (1.f + expf(m1 - m0)), w1 = 1.f - w0;
            *(f32x2*)(GT + row * 2) = (f32x2){pg * w0, pg * w1};
            SEL[cur * 32 + tid * 2] = 8 * g + e0; SEL[cur * 32 + tid * 2 + 1] = 8 * g + e1; }
        __syncthreads();
        pend_valid = false;
        if (tid < 32) { int c = 0;
#pragma unroll
            for (int j = 0; j < 32; ++j) c += (SEL[cur * 32 + j] == tid) ? 1 : 0;
            if (c > 0) { pend = atomicAdd(CNT + tid * 16, (unsigned)c); pend_valid = true; } }
        prev_row0 = row0;
    }
    if (pend_valid) BASE[(cur ^ 1) * 32 + tid] = (int)pend;
    __syncthreads();
    if (prev_row0 >= 0) RT_FLUSH(cur ^ 1, prev_row0);
    __syncthreads();
#undef RT_LOAD
#undef RT_FLUSH
}

DI int moe_setup(const Params& p, int l, ldsp lds, int tid, int G, int bx) {
    LAS int* blk = (LAS int*)(lds + BLK_OFF); LAS int* cnt = blk + 40; LAS int* utab = blk + 80;
    const unsigned* CNT = (const unsigned*)(p.ws + WS_CTL) + CW_CNT + l * 32 * 16;
    if (tid < 32) cnt[tid] = (int)__hip_atomic_load(CNT + tid * 16, __ATOMIC_RELAXED, __HIP_MEMORY_SCOPE_AGENT);
    __syncthreads();
    if (tid == 0) { int a = 0; for (int e = 0; e < 32; ++e) { blk[e] = a; a += (cnt[e] + 255) >> 8; } blk[32] = a; }
    __syncthreads();
    if (tid < 16) { const int Lq = pg8::moe_unit(tid, G, bx, blk[32] * 4); const int L = Lq < 0 ? 0 : Lq; const int rb = L >> 2; int e = 0;
        for (int j = 1; j < NEXP; ++j) e = (blk[j] <= rb) ? j : e;
        utab[tid] = (e << 16) | ((rb - blk[e]) & 0xffff); }
    __syncthreads();
    return blk[32];
}


#if defined(__HIP_DEVICE_COMPILE__)
#define LOADP() Params p; { const __attribute__((address_space(4))) Params* kp_ = (const __attribute__((address_space(4))) Params*)__builtin_amdgcn_kernarg_segment_ptr(); asm volatile("" : "+s"(kp_)); \
    __builtin_memcpy(&p, (const Params*)kp_, sizeof(Params)); }
#else
#define LOADP() Params p = p_unused;
#endif
#define PV() int tid = tid0; asm volatile("" : "+v"(tid)); const int lane = tid & 63, wave = __builtin_amdgcn_readfirstlane(tid >> 6); int G = G0, bx = bx0; asm volatile("" : "+s"(G), "+s"(bx)); \
    const int vcu = (G % 8 == 0) ? (bx % 8) * (G / 8) + bx / 8 : bx; int l = l0; asm volatile("" : "+s"(l)); (void)lane; (void)wave; (void)vcu; (void)l;
#define AMP_T0(n) unsigned long long amp_t0_ = 0; if (AMP_PHASE == (n)) amp_t0_ = __builtin_amdgcn_s_memrealtime();
#define AMP_WAIT(n) if (AMP_PHASE == (n)) { const unsigned long long t1_ = __builtin_amdgcn_s_memrealtime(); const unsigned long long w_ = (t1_ - amp_t0_) * AMP_K; while (__builtin_amdgcn_s_memrealtime() - t1_ < w_) __builtin_amdgcn_s_sleep(8); }
template <int L0> DI void layer_body(const XcdBarrier& bar, ldsp lds, const int tid0, const int G0, const int bx0, const Params& p_unused) {
    constexpr int l0 = L0;


{ AMP_T0(2)
#ifndef SKIP_INPROJ
        for (int rep_ = 0; rep_ < (DUP_PHASE == 2 ? 2 : 1); ++rep_) { LOADP(); PV(); unsigned char* ws = p.ws; pg8::Gemm g{(const f16*)(ws + WS_H), (const f16*)(ws + WS_WIN) + (size_t)l * INC * DM, DM, 0}; pg8::StaticOrder S; S.init(TT, INC, G, bx);
          EpiP E{(f16*)(ws + WS_P), INC};
          pg8::gemm_phase<EpiP, pg8::StaticOrder, true, false>(lds, g, S, E, tid);
          if (l < DEPTH - 1 && rep_ == 0) { const int nu = (TT / 256) * (INC / 256); if ((nu - bx + G - 1) / G < (nu + G - 1) / G) convert_steal(p, l + 1, 2, lds, tid, lane, wave); } }
#endif

        xcd_barrier(bar); AMP_WAIT(2) }

{ AMP_T0(3)
#ifndef SKIP_PREP
        for (int rep_ = 0; rep_ < (DUP_PHASE == 3 ? 2 : 1); ++rep_) { LOADP(); PV(); phase_prep_w(p, l, lds, lane, wave, vcu, G); }
#endif

        xcd_barrier(bar); AMP_WAIT(3) }

{ AMP_T0(5)
#ifndef SKIP_SCAN
        for (int rep_ = (DUP_PHASE == 4 ? 1 : 0); rep_ >= 0; --rep_) { LOADP(); PV(); phase_scan(p, tid, vcu, G, rep_); }
#endif
        xcd_barrier(bar); AMP_WAIT(5) }
{ AMP_T0(6)
#ifndef SKIP_HOUT
        for (int rep_ = 0; rep_ < (DUP_PHASE == 6 ? 2 : 1); ++rep_) { LOADP(); PV(); phase_hgrn_out_w(p, l, lds, lane, wave, vcu, G); }
#endif
#ifndef SKIP_ATTN
        for (int rep_ = 0; rep_ < (DUP_PHASE == 5 ? 2 : 1); ++rep_) { LOADP(); PV(); phase_attn(p, l, lds, tid, lane, wave, vcu, G, rep_); }
#endif
        xcd_barrier(bar); AMP_WAIT(6) }

{ AMP_T0(7)
#ifndef SKIP_OUTPROJ
        for (int rep_ = (DUP_PHASE == 7 ? 1 : 0); rep_ >= 0; --rep_) { LOADP(); PV(); unsigned char* ws = p.ws; pg8::Gemm g{(const f16*)(ws + WS_MIX), (const f16*)(ws + WS_WOUT) + (size_t)l * DM * DM, DM, 0}; pg8::StaticOrder S; S.init(TL, DM, G, bx);
          EpiOut E{(f16*)(ws + (rep_ ? WS_DUMMY : WS_DELTA)), (const float*)(ws + WS_MOD) + (size_t)l * 5 * 6144};
          pg8::gemm_phase<EpiOut, pg8::StaticOrder, true, false>(lds, g, S, E, tid);
          if (l < DEPTH - 1) phase_outproj_ctx(p, l, lane, wave, vcu, G, rep_); }
#endif

        xcd_barrier(bar); AMP_WAIT(7) }

{ AMP_T0(8)
#ifndef SKIP_ROUTER
        for (int rep_ = (DUP_PHASE == 8 ? 1 : 0); rep_ >= 0; --rep_) { LOADP(); PV(); if (l > 0 && rep_ == 0) convert_steal(p, l, 1 << 20, lds, tid, lane, wave); phase_router(p, l, lds, tid, lane, wave, vcu, G, rep_); }
#endif

        xcd_barrier(bar); AMP_WAIT(8) }

{ AMP_T0(9)
#ifndef SKIP_MOE1
        for (int rep_ = 0; rep_ < (DUP_PHASE == 9 ? 2 : 1); ++rep_) { LOADP(); PV(); unsigned char* ws = p.ws; const int nblk = moe_setup(p, l, lds, tid, G, bx);
          pg8::Gemm g{(const f16*)(ws + WS_H), (const f16*)(ws + WS_WGU) + (size_t)l * NEXP * 1024 * 1024, DM, (size_t)1024 * 1024};
          pg8::MoeOrder S{G, bx, nblk, (const LAS int*)(lds + BLK_OFF), (const LAS int*)(lds + BLK_OFF) + 40, (const int*)(ws + WS_LIST), DM * 2, (const LAS int*)(lds + BLK_OFF) + 80};
          EpiMoe1 E{(f16*)(ws + WS_HID)};
          pg8::gemm_phase<EpiMoe1, pg8::MoeOrder, true, true>(lds, g, S, E, tid);
          if (l < DEPTH - 1 && rep_ == 0) { const int nu = nblk * 4; if (pg8::moe_unit((nu + G - 1) / G - 1, G, bx, nu) < 0) convert_steal(p, l + 1, 2, lds, tid, lane, wave); } }
#endif

        xcd_barrier(bar); AMP_WAIT(9) }

{ AMP_T0(10)
#ifndef SKIP_MOE2
        for (int rep_ = 0; rep_ < (DUP_PHASE == 10 ? 2 : 1); ++rep_) { LOADP(); PV(); unsigned char* ws = p.ws; const int nblk = ((const LAS int*)(lds + BLK_OFF))[32];
          pg8::Gemm g{(const f16*)(ws + WS_HID), (const f16*)(ws + WS_WD) + (size_t)l * NEXP * 1024 * 512, EH, (size_t)1024 * 512};
          pg8::MoeOrder S{G, bx, nblk, (const LAS int*)(lds + BLK_OFF), (const LAS int*)(lds + BLK_OFF) + 40, (const int*)(ws + WS_LIST), EH * 2, (const LAS int*)(lds + BLK_OFF) + 80};
          EpiMoe2 E{(f16*)(ws + WS_Y2)};
          pg8::gemm_phase<EpiMoe2, pg8::MoeOrder, true, false>(lds, g, S, E, tid);
          if (l < DEPTH - 1 && rep_ == 0) { const int nu = nblk * 4; if (pg8::moe_unit((nu + G - 1) / G - 1, G, bx, nu) < 0) convert_steal(p, l + 1, 1, lds, tid, lane, wave); } }
#endif

        xcd_barrier(bar); AMP_WAIT(10) }

{ AMP_T0(11)
#ifndef SKIP_COMBINE
        for (int rep_ = (DUP_PHASE == 11 ? 1 : 0); rep_ >= 0; --rep_) { LOADP(); PV(); phase_combine(p, l, lds, lane, wave, vcu, G, rep_); }
#endif

        if (l0 < DEPTH - 1) xcd_barrier(bar); AMP_WAIT(11) }
        if (DUP_PHASE == 13) { for (int q_ = 0; q_ < 8; ++q_) xcd_barrier(bar); }

}

__global__ void __launch_bounds__(512, 2) fwd_kernel(Params p_unused) {
    extern __shared__ __attribute__((aligned(16))) unsigned char lds_raw[];
    ldsp lds = (ldsp)lds_raw;
    const int tid0 = threadIdx.x; const int G0 = gridDim.x; const int bx0 = blockIdx.x;
    const int tid = tid0;
    volatile LAS unsigned* MISC = (volatile LAS unsigned*)(lds + MISC_OFF);
    for (int u = tid; u < (LDS_BYTES - MISC_OFF) / 4; u += 512) ((LAS unsigned*)(lds + MISC_OFF))[u] = 0u;
    __syncthreads();
    XcdBarrier bar;
    { LOADP(); bar = xcd_barrier_post((unsigned*)(p.ws + WS_CTL) + CW_BAR, MISC + 8); }


    const int l0 = 0;
#ifndef SKIP_PROLOGUE
    for (int rep_ = 0; rep_ < (DUP_PHASE == 1 ? 2 : 1); ++rep_) { LOADP(); PV(); phase_prologue(p, lds, tid, lane, wave, vcu, G); __syncthreads(); }
#endif

    xcd_barrier(bar);

#ifndef SKIP_MOD0
        for (int rep_ = 0; rep_ < (DUP_PHASE == 12 ? 2 : 1); ++rep_) { LOADP(); PV(); phase_mod0(p, lane, wave, vcu, G); }
#endif

    xcd_barrier(bar);
    layer_body<0>(bar, lds, tid0, G0, bx0, p_unused); layer_body<1>(bar, lds, tid0, G0, bx0, p_unused); layer_body<2>(bar, lds, tid0, G0, bx0, p_unused); layer_body<3>(bar, lds, tid0, G0, bx0, p_unused);
}

extern "C" void kernel_launch(void* const* d_in, const int* in_sizes, int n_in, void* d_out, int out_size, void* d_ws, size_t ws_size, hipStream_t stream) {
    static int grid = 0;
    if (grid == 0) {
        if (n_in != 24 || out_size != TL * DM || ws_size < WS_END) { fprintf(stderr, "kernel_launch: unexpected shapes (n_in %d, out %d, ws %zu < %zu)\n", n_in, out_size, ws_size, (size_t)WS_END); grid = -1; return; }
        int dev = 0, cus = 0, per_cu = 0;
        if (hipGetDevice(&dev) != hipSuccess || hipDeviceGetAttribute(&cus, hipDeviceAttributeMultiprocessorCount, dev) != hipSuccess) { grid = -1; return; }
        if (hipFuncSetAttribute((const void*)fwd_kernel, hipFuncAttributeMaxDynamicSharedMemorySize, LDS_BYTES) != hipSuccess) { fprintf(stderr, "kernel_launch: hipFuncSetAttribute failed\n"); grid = -1; return; }
        if (hipOccupancyMaxActiveBlocksPerMultiprocessor(&per_cu, (const void*)fwd_kernel, 512, LDS_BYTES) != hipSuccess || per_cu < 1) { fprintf(stderr, "kernel_launch: occupancy query reports %d\n", per_cu); }
        (void)hipGetLastError();
        grid = cus;
    }
    if (grid < 0) return;
    (void)hipMemsetAsync((char*)d_ws + WS_CTL, 0, CTL_ZERO_BYTES, stream);
    Params p{};
    const float** pp = (const float**)&p;
    for (int i = 0; i < 24; ++i) pp[i] = (const float*)d_in[i];
    p.out = (float*)d_out; p.ws = (unsigned char*)d_ws;
    hipLaunchKernelGGL(fwd_kernel, dim3(grid), dim3(512), LDS_BYTES, stream, p);
}
```

```cpp
#include <hip/hip_runtime.h>
#include <cstdio>
#include <cstdint>

#define DI __device__ __forceinline__
#ifndef AMP_PHASE
#define AMP_PHASE 0
#endif
#define AMP_K 4
#ifndef DUP_PHASE
#define DUP_PHASE 0
#endif
#define LAS __attribute__((address_space(3)))
#define GAS __attribute__((address_space(1)))
typedef _Float16 f16;
typedef _Float16 f16x8 __attribute__((ext_vector_type(8)));
typedef _Float16 f16x4 __attribute__((ext_vector_type(4)));
typedef _Float16 f16x2 __attribute__((ext_vector_type(2)));
typedef short s16x8 __attribute__((ext_vector_type(8)));
typedef short s16x4 __attribute__((ext_vector_type(4)));
typedef float f32x4 __attribute__((ext_vector_type(4)));
typedef float f32x2 __attribute__((ext_vector_type(2)));
typedef float f32x16 __attribute__((ext_vector_type(16)));
typedef unsigned u32x4 __attribute__((ext_vector_type(4)));
typedef unsigned u32x2 __attribute__((ext_vector_type(2)));
typedef LAS unsigned char* ldsp;

constexpr int DM = 1024, NB = 4, SEQ = 8192, CTXL = 256, DEPTH = 4;
constexpr int TL = NB * SEQ, TC = NB * CTXL, TT = TL + TC;
constexpr int INC = 2304;
constexpr int C_U = 0, C_Q = 256, C_K = 768, C_V = 896, C_HQ = 1024, C_HI = 1280, C_HZF = 1536, C_HZB = 1792, C_HG = 2048;
constexpr int NEXP = 32, EH = 512;
constexpr int NPOS = 132;
constexpr float EPS = 1e-6f;
constexpr float LOG2E = 1.4426950408889634f;
constexpr int MAXBLK = 296;

constexpr size_t MiB = 1u << 20;
constexpr size_t WS_CTL = 0, CTL_ZERO_BYTES = 1 * MiB;
constexpr size_t WS_WIN = 1 * MiB;
constexpr size_t WS_WOUT = WS_WIN + (size_t)DEPTH * INC * DM * 2;
constexpr size_t WS_WGU = WS_WOUT + (size_t)DEPTH * DM * DM * 2;
constexpr size_t WS_WD = WS_WGU + (size_t)DEPTH * NEXP * 1024 * 1024 * 2;
constexpr size_t WS_POOLW = WS_WD + (size_t)DEPTH * NEXP * 1024 * 512 * 2;
constexpr size_t WS_WR = WS_POOLW + (size_t)DEPTH * 4 * 64 * 64 * 2;
constexpr size_t WS_MOD = WS_WR + (size_t)DEPTH * 1024 * 48 * 4;
constexpr size_t WS_LB = WS_MOD + (size_t)DEPTH * 5 * 6144 * 4;
constexpr size_t WS_ROPE = WS_LB + (size_t)DEPTH * 2 * 256 * 4;
constexpr size_t WS_XC = WS_ROPE + (size_t)(2 * 128 * 16 + 2 * 64 * 16) * 4;
constexpr size_t WS_GATES = WS_XC + (size_t)TC * DM * 4;
constexpr size_t WS_SLOT = WS_GATES + (size_t)TT * 2 * 4;
constexpr size_t WS_LIST = WS_SLOT + (size_t)TT * 2 * 4;
constexpr size_t WS_H = WS_LIST + (size_t)NEXP * TT * 4;
constexpr size_t WS_P = WS_H + (size_t)TT * DM * 2;
constexpr size_t WS_Y2 = WS_P;

constexpr size_t WS_QN = WS_P + (size_t)TT * INC * 2;
constexpr size_t WS_KN = WS_QN + (size_t)TT * 512 * 2;
constexpr size_t WS_MIX = WS_KN + (size_t)TT * 128 * 2;
constexpr size_t WS_HS = WS_MIX + (size_t)TT * DM * 2;
constexpr size_t WS_HA = WS_HS + (size_t)2 * NB * NPOS * 4 * 4096 * 4;
constexpr size_t WS_HSB = WS_HA + (size_t)2 * NB * NPOS * 4 * 64 * 4;
constexpr size_t WS_QS = WS_HSB + (size_t)2 * NB * NPOS * 4 * 4096 * 2;
constexpr size_t WS_DELTA = WS_QS + (size_t)TT * 256 * 2;
constexpr size_t WS_END0 = WS_DELTA + (size_t)TT * DM * 2;
constexpr size_t WS_HID = WS_QN;
constexpr size_t WS_DUMMY = WS_END0;
constexpr size_t WS_END = WS_END0 + (DUP_PHASE ? 144 * MiB : 0);
static_assert((size_t)2 * TT * DM * 2 <= (size_t)TT * INC * 2, "Y2 fits in P");
static_assert(WS_HID + (size_t)MAXBLK * 256 * EH * 2 <= WS_END0, "HID fits in its overlay");
static_assert(WS_WIN % 256 == 0 && WS_H % 256 == 0 && WS_P % 256 == 0 && WS_QN % 256 == 0 && WS_KN % 256 == 0 && WS_MIX % 256 == 0 && WS_HS % 256 == 0 && WS_HA % 256 == 0 && WS_XC % 256 == 0 && WS_LIST % 256 == 0 && WS_GATES % 256 == 0, "alignment");
constexpr int CW_BAR = 4096;
constexpr int CW_QUEUE = 12288;
constexpr int CW_CVQ = 13312;
constexpr int CW_CNT = 16384;
constexpr int RING_BYTES = 131072;
constexpr int MISC_OFF = RING_BYTES;
constexpr int BLK_OFF = MISC_OFF + 512;
constexpr int LDS_BYTES = 147456;

struct Params {
    const float *x, *c, *ctx, *c_ctx, *norm1_g, *norm2_g, *ada_w, *ada_b, *w_in, *w_out, *pool_w, *pool_scale, *q_norm_g, *k_norm_g, *attn_sink, *hgrn_lb,
        *hgrn_norm_g, *rgw, *rgb, *rew, *reb, *ewg, *ewu, *ewd;
    float* out; unsigned char* ws;
};

DI unsigned short f2bf(float f) { unsigned u = __builtin_bit_cast(unsigned, f); return (unsigned short)((u + 0x7fffu + ((u >> 16) & 1u)) >> 16); }
DI float wave_sum(float v) {
#pragma unroll
    for (int o = 1; o < 64; o <<= 1) v += __shfl_xor(v, o);
    return v;
}
DI float fast_rcp(float v) { return __builtin_amdgcn_rcpf(v); }
DI float siluf(float v) { return v * fast_rcp(1.f + __expf(-v)); }
DI unsigned cvt_pk_bf16(float lo, float hi) { unsigned r; asm volatile("v_cvt_pk_bf16_f32 %0, %1, %2" : "=v"(r) : "v"(lo), "v"(hi)); return r; }
DI int modb_of_row(int row) { return row < TL ? (row >> 13) : 4; }

#define XB_TMO      128
#define XB_XCNT(j)  (256  + 64 * (j))
#define XB_XSUB(j)  (1280 + 64 * (j))
#define XB_XGEN(j)  (2304 + 64 * (j))
#define XB_TOP      3328
#define XB_TOPGEN   3392
#define XCD_BAR_WORDS 3456
#define XB_SPIN_CAP (1u << 18)
__device__ __forceinline__ unsigned xb_ld(unsigned* p)              { return __hip_atomic_load(p, __ATOMIC_RELAXED, __HIP_MEMORY_SCOPE_AGENT); }
__device__ __forceinline__ unsigned xb_add(unsigned* p, unsigned v) { return __hip_atomic_fetch_add(p, v, __ATOMIC_RELAXED, __HIP_MEMORY_SCOPE_AGENT); }
__device__ __forceinline__ unsigned xb_xcc_id() { return (unsigned)__builtin_amdgcn_s_getreg((3 << 11) | 20) & 0xFu; }
#define XB_SPIN(cond, bar) do { unsigned _sp = 0; while (cond) { __builtin_amdgcn_s_sleep(1); \
    if ((++_sp & 255u) == 0u) { if (xb_ld(&(bar)[XB_TMO])) break; if (_sp > XB_SPIN_CAP) { atomicAdd(&(bar)[XB_TMO], 1u); break; } } } } while (0)
struct XcdBarrier { unsigned* bar; unsigned x; volatile LAS unsigned* st; };
__device__ __forceinline__ XcdBarrier xcd_barrier_post(unsigned* bar, volatile LAS unsigned* st) {
    XcdBarrier b; b.bar = bar; b.x = xb_xcc_id(); b.st = st;
    if (threadIdx.x == 0) (void)xb_add(&bar[XB_XCNT(b.x)], 1u);
    return b;
}
__device__ __forceinline__ void xcd_barrier_complete(unsigned* bar, unsigned x, unsigned& nloc, unsigned& nx) {
    const unsigned G = gridDim.x * gridDim.y * gridDim.z;
    unsigned sum, cnt, mine, sp = 0u;
    for (;;) {
        sum = 0u; cnt = 0u; mine = 0u;
#pragma unroll 1
        for (unsigned j = 0; j < 16; ++j) { const unsigned c = xb_ld(&bar[XB_XCNT(j)]); sum += c; cnt += (c > 0u) ? 1u : 0u; mine = (j == x) ? c : mine; }
        if (sum == G) break;
        __builtin_amdgcn_s_sleep(1);
        if ((++sp & 255u) == 0u) { if (xb_ld(&bar[XB_TMO])) break; if (sp > XB_SPIN_CAP) { atomicAdd(&bar[XB_TMO], 1u); break; } }
    }
    nloc = mine > 0u ? mine : 1u; nx = cnt > 0u ? cnt : 1u;
}
__device__ __forceinline__ void xcd_barrier(const XcdBarrier& b) {
    asm volatile("s_waitcnt vmcnt(0)" ::: "memory");
    __syncthreads();
    if (threadIdx.x == 0) {
        unsigned* bar = b.bar;
        __builtin_amdgcn_s_waitcnt(0);
        unsigned nloc = b.st[0], nx = b.st[1];
        if (nloc == 0u) { xcd_barrier_complete(bar, b.x, nloc, nx); b.st[0] = nloc; b.st[1] = nx; }
        const unsigned old = xb_add(&bar[XB_XSUB(b.x)], 1u);
        const unsigned gen = old / nloc;
        if (old + 1u == (gen + 1u) * nloc) {
            __builtin_amdgcn_fence(__ATOMIC_RELEASE, "agent");
            asm volatile("s_waitcnt vmcnt(0)" ::: "memory");
            const unsigned og = xb_add(&bar[XB_TOP], 1u);
            const unsigned tg = og / nx;
            if (og + 1u == (tg + 1u) * nx) xb_add(&bar[XB_TOPGEN], 1u);
            else XB_SPIN(xb_ld(&bar[XB_TOPGEN]) == tg, bar);
            __builtin_amdgcn_fence(__ATOMIC_ACQUIRE, "agent");
            xb_add(&bar[XB_XGEN(b.x)], 1u);
            asm volatile("s_waitcnt vmcnt(0)" ::: "memory");
        } else {
            XB_SPIN(xb_ld(&bar[XB_XGEN(b.x)]) == gen, bar);
            __builtin_amdgcn_fence(__ATOMIC_ACQUIRE, "agent");
            asm volatile("s_waitcnt vmcnt(0)" ::: "memory");
        }
    }
    __syncthreads();
}

namespace pg8 {
constexpr int BM = 256, BK = 64, HALF = 128, HTB = HALF * BK * 2, STAGE_BYTES = 8 * HTB, NXCD = 8, WGM = 8;
DI int lds_byte(int r, int c) { const int st = (r >> 4) * 2 + (c >> 5), rr = r & 15, cc = c & 31, ob = rr * 64 + cc * 2; return st * 1024 + (ob ^ (((ob >> 9) & 1) << 5)); }
DI void stage_rc(int b, int& R, int& C) { const int st = b / 1024, sb = b % 1024, swz = sb ^ (((sb >> 9) & 1) << 5); R = (st >> 1) * 16 + swz / 64; C = (st & 1) * 32 + (swz % 64) / 2; }
DI int perm32(int rho) { const int n = rho >> 4, i = rho & 15; return 8 * (i >> 2) + 4 * n + (i & 3); }

struct Unit { int pm, pn, e, lrb; };
struct Gemm { const f16* A; const f16* Bt; int K; size_t bstride; };

struct StaticOrder {
    int nM, nN, nwg, G, c;
    DI void init(int M, int N, int G_, int c_) { nM = M / BM; nN = N / BM; nwg = nM * nN; G = G_; c = c_; }
    DI bool next(int i, Unit& u) const {
        const long L = (long)i * G + c; if (L >= nwg) return false;
        int wgid = (int)L; { const int q = nwg / NXCD, r = nwg % NXCD, xcd = wgid % NXCD, off = wgid / NXCD; wgid = (xcd < r ? xcd * (q + 1) : r * (q + 1) + (xcd - r) * q) + off; }
        const int nig = WGM * nN, gid = wgid / nig, fm = gid * WGM, gsz = (nM - fm) < WGM ? (nM - fm) : WGM;
        u.pm = fm + ((wgid % nig) % gsz); u.pn = (wgid % nig) / gsz; u.e = 0; u.lrb = 0; return true;
    }
    DI unsigned arow(const Unit&, int) const { return 0u; }
};
DI int moe_unit(int i, int G, int c, int U) {
    if (G % 8 != 0) { const int L = i * G + c; return L < U ? L : -1; }
    const int x = c & 7, j = c >> 3, W = G >> 3; const int lo = (int)(((long)U * x) >> 3), hi = (int)(((long)U * (x + 1)) >> 3); const int k = lo + i * W + j; return k < hi ? k : -1;
}
struct MoeOrder {
    int G, c, nblk; const LAS int* blk; const LAS int* cnt; const int* list; int rowbytes;
    const LAS int* utab;
    DI bool next(int i, Unit& u) const {
        const int L = moe_unit(i, G, c, nblk * 4); if (L < 0) return false;
        const int rb = L >> 2; u.pn = L & 3; u.pm = rb;
        const int t = utab[i]; u.e = t >> 16; u.lrb = t & 0xffff; return true;
    }
    DI unsigned arow(const Unit& u, int r) const {
        const int pos = u.lrb * 256 + r; const int ent = (pos < cnt[u.e]) ? list[(size_t)u.e * TT + pos] : 0;
        return (unsigned)(ent >> 1) * (unsigned)rowbytes;
    }
};

template <class Epi, class Sched, bool ALIGN_EPI, bool GATHER>
DI void gemm_phase(ldsp lds, const Gemm g, const Sched& S, const Epi& E, const int tid) {
    const int wid = __builtin_amdgcn_readfirstlane(tid >> 6), lane = tid & 63, wr = wid >> 2, wc = wid & 3, fr = lane & 15, fq = lane >> 4;
    const int K = g.K, nt = K / BK;
    int Rr[2], Cc[2]; unsigned voffB[2], voffA[2];
#pragma unroll
    for (int i = 0; i < 2; ++i) { int R, C; stage_rc(tid * 16 + i * 8192, R, C); const int Rb = Epi::PERM ? ((R & ~31) + perm32(R & 31)) : R;
        Rr[i] = R; Cc[i] = C; voffB[i] = (unsigned)(Rb * K + C) * 2u; voffA[i] = (unsigned)(R * K + C) * 2u; }
    const size_t kstep = (size_t)(BK * 2);
    const size_t hstep = (size_t)HALF * K * 2;
    const size_t tstep = 2 * hstep;
    const unsigned ldsw = (unsigned)wid * 1024u;
    const int aoff = lds_byte(wr * 64 + fr, fq * 8), boff = lds_byte(wc * 32 + fr, fq * 8);
    const char* const Ab = (const char*)g.A;
#define PG8_SA(b, h) (((b) * 2 + (h)) * HTB)
#define PG8_SB(b, h) ((4 + (b) * 2 + (h)) * HTB)
#define PG8_STAGE(bufoff, gbase, voff) do { _Pragma("unroll") for (int _i = 0; _i < 2; ++_i) \
        __builtin_amdgcn_global_load_lds((const unsigned*)((const char*)(gbase) + (voff)[_i]), (LAS unsigned*)(lds + (bufoff) + ldsw + _i * 8192), 16, 0, 0); } while (0)
#define PG8_LDA(dst, b, h) do { _Pragma("unroll") for (int m = 0; m < 4; ++m) _Pragma("unroll") for (int k = 0; k < 2; ++k) dst[m][k] = *(const LAS f16x8*)(lds + PG8_SA(b, h) + aoff + m * 2048 + k * 1024); } while (0)
#define PG8_LDB(dst, b, h) do { _Pragma("unroll") for (int n = 0; n < 2; ++n) _Pragma("unroll") for (int k = 0; k < 2; ++k) dst[n][k] = *(const LAS f16x8*)(lds + PG8_SB(b, h) + boff + n * 2048 + k * 1024); } while (0)
#define PG8_MMA(ai, bj, At, Bt) do { __builtin_amdgcn_s_setprio(1); _Pragma("unroll") for (int m = 0; m < 4; ++m) _Pragma("unroll") for (int n = 0; n < 2; ++n) _Pragma("unroll") for (int k = 0; k < 2; ++k) \
        acc[ai][bj][m][n] = __builtin_amdgcn_mfma_f32_16x16x32_f16(Bt[n][k], At[m][k], acc[ai][bj][m][n], 0, 0, 0); __builtin_amdgcn_s_setprio(0); } while (0)
#define PG8_WAIT_V(n) asm volatile("s_waitcnt vmcnt(" #n ")" ::: "memory")
#define PG8_WAIT_L(n) asm volatile("s_waitcnt lgkmcnt(" #n ")" ::: "memory")
#define PG8_BAR __builtin_amdgcn_s_barrier()
#define PG8_SCHED __builtin_amdgcn_sched_barrier(0)
#define PG8_AOFF(dst, U) do { if constexpr (GATHER) { _Pragma("unroll") for (int _h = 0; _h < 2; ++_h) _Pragma("unroll") for (int _i = 0; _i < 2; ++_i) \
        dst[_h][_i] = S.arow(U, _h * HALF + Rr[_i]) + (unsigned)Cc[_i] * 2u; } } while (0)
#define PG8_STAGE_A(bufoff, kb, nx, h) do { if constexpr (GATHER) { if (nx) PG8_STAGE(bufoff, Ab + (kb), aon[h]); else PG8_STAGE(bufoff, Ab + (kb), aoc[h]); } \
        else { PG8_STAGE(bufoff, ((nx) ? nA : cA) + (kb) + (h) * hstep, voffA); } } while (0)
    Unit cur, nxt; int ui = 0;
    if (!S.next(0, cur)) return;
    f32x4 acc[2][2][4][2];
#pragma unroll
    for (int a = 0; a < 2; ++a)
#pragma unroll
        for (int b = 0; b < 2; ++b)
#pragma unroll
            for (int m = 0; m < 4; ++m)
#pragma unroll
                for (int n = 0; n < 2; ++n) acc[a][b][m][n] = (f32x4){0.f, 0.f, 0.f, 0.f};
    f16x8 At[4][2], B0[2][2], B1[2][2];
    unsigned aoc[2][2], aon[2][2];
    PG8_AOFF(aoc, cur);
    const char* cA = Ab + (GATHER ? (size_t)0 : (size_t)cur.pm * tstep); const char* nA = cA;
    const char* cB = (const char*)g.Bt + ((size_t)cur.e * g.bstride) * 2 + (size_t)cur.pn * tstep;
    PG8_STAGE(PG8_SB(0, 0), cB, voffB); PG8_STAGE(PG8_SB(0, 1), cB + hstep, voffB); PG8_STAGE_A(PG8_SA(0, 0), 0, 0, 0); PG8_STAGE_A(PG8_SA(0, 1), 0, 0, 1);
    if (wr == 1) PG8_BAR;
    PG8_WAIT_V(2); PG8_BAR;
    PG8_STAGE(PG8_SB(1, 0), cB + kstep, voffB); PG8_STAGE_A(PG8_SA(1, 0), kstep, 0, 0); PG8_STAGE(PG8_SB(1, 1), cB + hstep + kstep, voffB);
    PG8_WAIT_V(6); PG8_BAR;
    for (;;) {
        const bool has_next = S.next(ui + 1, nxt);
        if constexpr (GATHER) { if (has_next) { PG8_AOFF(aon, nxt); } else {
#pragma unroll
            for (int _h = 0; _h < 2; ++_h)
#pragma unroll
                for (int _i = 0; _i < 2; ++_i) aon[_h][_i] = aoc[_h][_i]; } }
        else { nA = has_next ? Ab + (size_t)nxt.pm * tstep : cA; }
        const char* nB = has_next ? (const char*)g.Bt + ((size_t)nxt.e * g.bstride) * 2 + (size_t)nxt.pn * tstep : cB;
        for (int t = 0; t < nt; t += 2) {
            const bool last = (t == nt - 2);
            const size_t k1 = (size_t)(t + 1) * kstep, k2 = last ? (size_t)0 : (size_t)(t + 2) * kstep, k3 = k2 + kstep;
            const char* b2 = last ? nB : cB + (size_t)(t + 2) * kstep; const char* b3 = b2 + kstep;
            PG8_LDB(B0, 0, 0); PG8_LDB(B1, 0, 1); PG8_SCHED; PG8_LDA(At, 0, 0); PG8_STAGE_A(PG8_SA(1, 1), k1, 0, 1);
            PG8_WAIT_V(8); PG8_WAIT_L(0); PG8_BAR; PG8_MMA(0, 0, At, B0); PG8_MMA(0, 1, At, B1); PG8_BAR; PG8_SCHED;
            PG8_LDA(At, 0, 1); PG8_STAGE(PG8_SB(0, 0), b2, voffB); PG8_STAGE(PG8_SB(0, 1), b2 + hstep, voffB); PG8_STAGE_A(PG8_SA(0, 0), k2, last, 0);
            PG8_WAIT_V(8); PG8_WAIT_L(0); PG8_BAR; PG8_MMA(1, 0, At, B0); PG8_MMA(1, 1, At, B1); PG8_BAR; PG8_SCHED;
            PG8_LDB(B0, 1, 0); PG8_LDB(B1, 1, 1); PG8_SCHED; PG8_LDA(At, 1, 0); PG8_STAGE_A(PG8_SA(0, 1), k2, last, 1);
            PG8_WAIT_V(8); PG8_WAIT_L(0); PG8_BAR; PG8_MMA(0, 0, At, B0); PG8_MMA(0, 1, At, B1); PG8_BAR; PG8_SCHED;
            PG8_LDA(At, 1, 1); PG8_STAGE(PG8_SB(1, 0), b3, voffB); PG8_STAGE(PG8_SB(1, 1), b3 + hstep, voffB); PG8_STAGE_A(PG8_SA(1, 0), k3, last, 0);
            PG8_WAIT_V(8); PG8_WAIT_L(0); PG8_BAR; PG8_MMA(1, 0, At, B0); PG8_MMA(1, 1, At, B1); PG8_BAR; PG8_SCHED;
        }
        if constexpr (ALIGN_EPI) { if (wr == 0) PG8_BAR; }
        E(acc, cur, wr, wc, fr, fq);
        if (!has_next) break;
#pragma unroll
        for (int a = 0; a < 2; ++a)
#pragma unroll
            for (int b = 0; b < 2; ++b)
#pragma unroll
                for (int m = 0; m < 4; ++m)
#pragma unroll
                    for (int n = 0; n < 2; ++n) acc[a][b][m][n] = (f32x4){0.f, 0.f, 0.f, 0.f};
        cur = nxt; cB = nB; cA = nA; ++ui;
        if constexpr (GATHER) {
#pragma unroll
        for (int _h = 0; _h < 2; ++_h)
#pragma unroll
            for (int _i = 0; _i < 2; ++_i) aoc[_h][_i] = aon[_h][_i]; }
        if constexpr (ALIGN_EPI) { if (wr == 1) PG8_BAR; }
    }
    PG8_WAIT_V(0);
    if constexpr (!ALIGN_EPI) { if (wr == 0) PG8_BAR; }
    PG8_BAR;
#undef PG8_SA
#undef PG8_SB
#undef PG8_STAGE
#undef PG8_LDA
#undef PG8_LDB
#undef PG8_MMA
#undef PG8_WAIT_V
#undef PG8_WAIT_L
#undef PG8_BAR
#undef PG8_SCHED
#undef PG8_AOFF
#undef PG8_STAGE_A
}
}

typedef f32x4 AccT[2][2][4][2];
DI u32x4 pack8_f16(f32x4 a, f32x4 b) {
    f16x8 h; h[0] = (f16)a[0]; h[1] = (f16)a[1]; h[2] = (f16)a[2]; h[3] = (f16)a[3]; h[4] = (f16)b[0]; h[5] = (f16)b[1]; h[6] = (f16)b[2]; h[7] = (f16)b[3];
    return __builtin_bit_cast(u32x4, h);
}
struct EpiP { static constexpr bool PERM = true; f16* O; int ldc;
    DI void operator()(const AccT& acc, const pg8::Unit& u, int wr, int wc, int fr, int fq) const {
        char* base = (char*)(O + (size_t)u.pm * 256 * ldc + u.pn * 256);
        unsigned loff = (unsigned)((wr * 64 + fr) * ldc + wc * 32 + 8 * fq) * 2u;
        asm volatile("" : "+v"(loff));
#pragma unroll
        for (int ai = 0; ai < 2; ++ai)
#pragma unroll
            for (int m = 0; m < 4; ++m) {
#pragma unroll
                for (int bj = 0; bj < 2; ++bj) *(u32x4*)(base + (size_t)((ai * 128 + m * 16) * ldc + bj * 128) * 2 + loff) = pack8_f16(acc[ai][bj][m][0], acc[ai][bj][m][1]); }
    }
};
struct EpiOut { static constexpr bool PERM = true; f16* D; const float* modl;
    DI void operator()(const AccT& acc, const pg8::Unit& u, int wr, int wc, int fr, int fq) const {
        char* base = (char*)(D + (size_t)u.pm * 256 * DM + u.pn * 256);
        const float* g1 = modl + (u.pm < 128 ? (u.pm >> 5) : 4) * 6144 + 2 * 1024 + u.pn * 256;
        unsigned loff = (unsigned)((wr * 64 + fr) * DM + wc * 32 + 8 * fq) * 2u, goff = (unsigned)(wc * 32 + 8 * fq);
        asm volatile("" : "+v"(loff), "+v"(goff));
#pragma unroll
        for (int bj = 0; bj < 2; ++bj) { const f32x4 g0 = *(const f32x4*)(g1 + goff + bj * 128), g4 = *(const f32x4*)(g1 + goff + bj * 128 + 4);
#pragma unroll
            for (int ai = 0; ai < 2; ++ai)
#pragma unroll
                for (int m = 0; m < 4; ++m) *(u32x4*)(base + (size_t)((ai * 128 + m * 16) * DM + bj * 128) * 2 + loff) = pack8_f16(acc[ai][bj][m][0] * g0, acc[ai][bj][m][1] * g4); }
    }
};
struct EpiMoe1 { static constexpr bool PERM = true; f16* HID;
    DI void operator()(const AccT& acc, const pg8::Unit& u, int wr, int wc, int fr, int fq) const {
        char* base = (char*)(HID + (size_t)u.pm * 256 * EH + u.pn * 128);
        unsigned loff = (unsigned)((wr * 64 + fr) * EH + wc * 32 + 8 * fq) * 2u;
        asm volatile("" : "+v"(loff));
#pragma unroll
        for (int ai = 0; ai < 2; ++ai)
#pragma unroll
            for (int m = 0; m < 4; ++m) { f32x4 h0, h1;
#pragma unroll
                for (int i = 0; i < 4; ++i) { h0[i] = siluf(acc[ai][0][m][0][i]) * acc[ai][1][m][0][i]; h1[i] = siluf(acc[ai][0][m][1][i]) * acc[ai][1][m][1][i]; }
                *(u32x4*)(base + (size_t)((ai * 128 + m * 16) * EH) * 2 + loff) = pack8_f16(h0, h1); }
    }
};
struct EpiMoe2 { static constexpr bool PERM = true; f16* Y2;
    DI void operator()(const AccT& acc, const pg8::Unit& u, int wr, int wc, int fr, int fq) const {
        char* base = (char*)(Y2 + (size_t)u.pm * 256 * DM + u.pn * 256);
        unsigned loff = (unsigned)((wr * 64 + fr) * DM + wc * 32 + 8 * fq) * 2u;
        asm volatile("" : "+v"(loff));
#pragma unroll
        for (int ai = 0; ai < 2; ++ai)
#pragma unroll
            for (int m = 0; m < 4; ++m) {
#pragma unroll
                for (int bj = 0; bj < 2; ++bj) *(u32x4*)(base + (size_t)((ai * 128 + m * 16) * DM + bj * 128) * 2 + loff) = pack8_f16(acc[ai][bj][m][0], acc[ai][bj][m][1]); }
    }
};

DI void p0_transpose_item(const float* W, int K, int N, f16* WT, int mode, LAS float* scr, int item, int lane) {
    const int nblk = N / 32, kb = item / nblk, nb = item % nblk, k0 = 64 * kb, n0 = 32 * nb;
    const int rbase = (mode == 0) ? n0 : (256 * (n0 >> 7) + (n0 & 127) + (mode == 2 ? 128 : 0));
    float tv[32];
#pragma unroll
    for (int i = 0; i < 32; ++i) { const int kk = 2 * i + (lane >> 5); tv[i] = W[(size_t)(k0 + kk) * N + n0 + (lane & 31)]; }
#pragma unroll
    for (int i = 0; i < 32; ++i) { const int kk = 2 * i + (lane >> 5); scr[kk * 33 + (lane & 31)] = tv[i]; }
    asm volatile("s_waitcnt lgkmcnt(0)" ::: "memory");
    const int c = lane & 7;
#pragma unroll
    for (int j = 0; j < 4; ++j) { const int n = (lane >> 3) + 8 * j; const LAS float* s = scr + (8 * c) * 33 + n;
        f16x8 o;
#pragma unroll
        for (int q = 0; q < 8; ++q) o[q] = (f16)s[q * 33];
        *(f16x8*)(WT + (size_t)(rbase + n) * K + k0 + 8 * c) = o; }
    asm volatile("s_waitcnt lgkmcnt(0)" ::: "memory");
}

constexpr int CV_CHUNKS = 768;
DI void expert_item(const Params& p, int l, int r, LAS float* scr, int lane) {
    unsigned char* ws = p.ws; const int e = r / 768, q = r % 768, which = q >> 8, item = q & 255; const size_t le = (size_t)l * NEXP + e;
    if (which == 0) p0_transpose_item(p.ewg + le * DM * EH, DM, EH, (f16*)(ws + WS_WGU) + le * 1024 * 1024, 1, scr, item, lane);
    else if (which == 1) p0_transpose_item(p.ewu + le * DM * EH, DM, EH, (f16*)(ws + WS_WGU) + le * 1024 * 1024, 2, scr, item, lane);
    else p0_transpose_item(p.ewd + le * EH * DM, EH, DM, (f16*)(ws + WS_WD) + le * 1024 * 512, 0, scr, item, lane);
}
DI void convert_steal(const Params& p, int l, int maxpull, ldsp lds, int tid, int lane, int wave) {
    unsigned* qh = (unsigned*)(p.ws + WS_CTL) + CW_CVQ + l * 64; volatile LAS unsigned* slot = (volatile LAS unsigned*)(lds + MISC_OFF) + 24;
    LAS float* scr = (LAS float*)(lds + wave * 16384);
    for (int k = 0; k < maxpull; ++k) {
        __syncthreads();
        if (tid == 0) slot[0] = atomicAdd(qh, 1u);
        __syncthreads();
        const unsigned c = slot[0];
        if (c >= (unsigned)CV_CHUNKS) break;
#pragma unroll 1
        for (int j = 0; j < 4; ++j) expert_item(p, l, (int)c * 32 + wave * 4 + j, scr, lane);
    }
    __syncthreads();
}

DI void phase_prologue(const Params& p, ldsp lds, int tid, int lane, int wave, int vcu, int G) {
    unsigned char* ws = p.ws;
    LAS float* scr = (LAS float*)(lds + wave * 16384);
    const int gw = vcu * 8 + wave, NGW = G * 8;
    constexpr int PER_L = 1152 + 512;
    constexpr int NW_ITEMS = DEPTH * PER_L;
    for (int it = gw; it < NW_ITEMS + 32; it += NGW) {
        if (it >= NW_ITEMS) { const int j = it - NW_ITEMS, mat = j >> 1;
            p0_transpose_item(p.pool_w + (size_t)mat * 4096, 64, 64, (f16*)(ws + WS_POOLW) + (size_t)mat * 4096, 0, scr, j & 1, lane); continue; }
        const int l = it / PER_L; int r = it % PER_L;
        if (r < 1152) { p0_transpose_item(p.w_in + (size_t)l * DM * INC, DM, INC, (f16*)(ws + WS_WIN) + (size_t)l * INC * DM, 0, scr, r, lane); continue; } r -= 1152;
        p0_transpose_item(p.w_out + (size_t)l * DM * DM, DM, DM, (f16*)(ws + WS_WOUT) + (size_t)l * DM * DM, 0, scr, r, lane);
    }
    for (int it = gw; it < 32 * 768; it += NGW) expert_item(p, 0, it, scr, lane);
    { f16* WRH = (f16*)(ws + WS_WR); f16* WRL = WRH + (size_t)DEPTH * 48 * 1024;
      for (int i = vcu * 512 + tid; i < DEPTH * 48 * 1024; i += G * 512) { const int k = i & 1023, o = (i >> 10) % 48, l = i / (48 * 1024);
          float v = 0.f; if (o < 4) v = p.rgw[((size_t)l * 1024 + k) * 4 + o]; else if (o < 36) v = p.rew[((size_t)l * 1024 + k) * 32 + (o - 4)];
          v *= 1024.f; const f16 hi = (f16)v; WRH[i] = hi; WRL[i] = (f16)(v - (float)hi); } }
    { float* RT = (float*)(ws + WS_ROPE);
      for (int i = vcu * 512 + tid; i < (128 + 64) * 16; i += G * 512) { const int m = i & 15, pos = i >> 4;
          const float inv = powf(10000.f, -(float)m / 16.f); const float ang = (float)(pos < 128 ? pos : pos - 128) * inv; float s, c; sincosf(ang, &s, &c);
          if (pos < 128) { RT[pos * 16 + m] = c; RT[2048 + pos * 16 + m] = s; } else { RT[4096 + (pos - 128) * 16 + m] = c; RT[4096 + 1024 + (pos - 128) * 16 + m] = s; } } }
    if (vcu == 0) { float* LB = (float*)(ws + WS_LB);
        const float a0 = p.hgrn_lb[tid], a1 = p.hgrn_lb[512 + tid], a2 = p.hgrn_lb[1024 + tid], a3 = p.hgrn_lb[1536 + tid];
        const float mx = fmaxf(fmaxf(a0, a1), fmaxf(a2, a3)); const float e0 = expf(a0 - mx), e1 = expf(a1 - mx), e2 = expf(a2 - mx), e3 = expf(a3 - mx); const float inv = 1.f / (e0 + e1 + e2 + e3);
        LB[tid] = 0.f; LB[512 + tid] = e1 * inv; LB[1024 + tid] = (e1 + e2) * inv; LB[1536 + tid] = (e1 + e2 + e3) * inv; }
    __syncthreads();
    { LAS float* sl = (LAS float*)lds;
      LAS float* red = (LAS float*)(lds + 32768);
#pragma unroll
      for (int it_ = 0; it_ < 10; ++it_) { const int i = tid + 512 * it_; const int b = i >> 10, k = i & 1023; const float v = (b < 4) ? p.c[b * 1024 + k] : p.c_ctx[k]; sl[i] = siluf(v); }
      __syncthreads();
      float* MOD = (float*)(ws + WS_MOD);
      for (int it = vcu; it < DEPTH * 96; it += G) { const int l = it / 96, col = (it % 96) * 64 + lane;
          const float* W = p.ada_w + (size_t)l * 1024 * 6144 + col; float a[5] = {0.f, 0.f, 0.f, 0.f, 0.f};
#pragma unroll 32
          for (int k = wave * 128; k < wave * 128 + 128; ++k) { const float w = W[(size_t)k * 6144];
#pragma unroll
              for (int b = 0; b < 5; ++b) a[b] += sl[b * 1024 + k] * w; }
#pragma unroll
          for (int b = 0; b < 5; ++b) red[(wave * 5 + b) * 64 + lane] = a[b];
          __syncthreads();
          if (tid < 320) { const int b = tid >> 6, cc = tid & 63; float s = 0.f;
#pragma unroll
              for (int w = 0; w < 8; ++w) s += red[(w * 5 + b) * 64 + cc];
              const int c2 = (it % 96) * 64 + cc; MOD[((size_t)l * 5 + b) * 6144 + c2] = s + p.ada_b[l * 6144 + c2]; }
          __syncthreads(); } }
}

DI void modulate_row_store(const f32x4 (&v)[4], float r, const float* gn, const float* sh, const float* sc, f16* hrow, int lane) {
#pragma unroll
    for (int j = 0; j < 4; ++j) { const int c = 256 * j + 4 * lane; const f32x4 g = *(const f32x4*)(gn + c), s = *(const f32x4*)(sh + c), k = *(const f32x4*)(sc + c);
        f16x4 o;
#pragma unroll
        for (int i = 0; i < 4; ++i) o[i] = (f16)(v[j][i] * r * g[i] * (1.f + k[i]) + s[i]);
        *(f16x4*)(hrow + c) = o; }
}
DI void phase_mod0(const Params& p, int lane, int wave, int vcu, int G) {
    const float* MOD = (const float*)(p.ws + WS_MOD); f16* H = (f16*)(p.ws + WS_H);
    const int NGW = G * 8;
    for (int row0 = vcu * 8 + wave; row0 < TT; row0 += 2 * NGW) {
        f32x4 v[2][4]; float s[2]; int rows[2]; bool ok[2];
#pragma unroll
        for (int q = 0; q < 2; ++q) { const int rr = row0 + q * NGW; ok[q] = rr < TT; const int row = ok[q] ? rr : row0; rows[q] = row;
            const float* xr = (row < TL) ? p.x + (size_t)row * DM : p.ctx + (size_t)(row - TL) * DM;
#pragma unroll
            for (int j = 0; j < 4; ++j) v[q][j] = *(const f32x4*)(xr + 256 * j + 4 * lane); }
#pragma unroll
        for (int q = 0; q < 2; ++q) { float t = 0.f;
#pragma unroll
            for (int j = 0; j < 4; ++j) t += v[q][j][0] * v[q][j][0] + v[q][j][1] * v[q][j][1] + v[q][j][2] * v[q][j][2] + v[q][j][3] * v[q][j][3];
            s[q] = t; }
#pragma unroll
        for (int o = 1; o < 64; o <<= 1) { s[0] += __shfl_xor(s[0], o); s[1] += __shfl_xor(s[1], o); }
#pragma unroll
        for (int q = 0; q < 2; ++q) if (ok[q]) { const int row = rows[q]; const int b = modb_of_row(row); const float r = __builtin_amdgcn_rsqf(s[q] * (1.f / DM) + EPS);
            modulate_row_store(v[q], r, p.norm1_g, MOD + (size_t)b * 6144, MOD + (size_t)b * 6144 + 1024, H + (size_t)row * DM, lane); }
    }
}
DI void phase_combine(const Params& p, int l, ldsp lds, int lane, int wave, int vcu, int G, int dry) {
    const LAS int* blk = (const LAS int*)(lds + BLK_OFF); const int* SLOT = (const int*)(p.ws + WS_SLOT);
    const float* MOD = (const float*)(p.ws + WS_MOD); f16* H = (f16*)(p.ws + (dry ? WS_DUMMY + 64 * MiB : WS_H)); const f16* Y2 = (const f16*)(p.ws + WS_Y2); const float* GT = (const float*)(p.ws + WS_GATES);
    float* XC = (float*)(p.ws + WS_XC);
    const int nrows = (l == DEPTH - 1) ? TL : TT; const int NGW = G * 8;
    LAS float* MODC = (LAS float*)lds;
    { const int tid_ = wave * 64 + lane; const float* gn_ = p.norm1_g + (l < DEPTH - 1 ? l + 1 : l) * DM;
#pragma unroll
      for (int it_ = 0; it_ < 10; ++it_) { const int i = tid_ + 512 * it_; const int b_ = i >> 10, k_ = i & 1023; const float* mg_ = MOD + ((size_t)l * 5 + b_) * 6144; const float* m1_ = MOD + ((size_t)(l < DEPTH - 1 ? l + 1 : l) * 5 + b_) * 6144;
          MODC[b_ * 3072 + k_] = mg_[5 * 1024 + k_]; MODC[b_ * 3072 + 1024 + k_] = gn_[k_] * (1.f + m1_[1024 + k_]); MODC[b_ * 3072 + 2048 + k_] = m1_[k_]; } }
    __syncthreads();
    int sl[2][2]; float gt[2][2];
    { const int r0 = vcu * 8 + wave;
#pragma unroll
      for (int q = 0; q < 2; ++q) { const int rr = r0 + q * NGW; const int row = rr < nrows ? rr : r0; if (r0 < nrows) { sl[q][0] = SLOT[row * 2]; sl[q][1] = SLOT[row * 2 + 1]; gt[q][0] = GT[row * 2]; gt[q][1] = GT[row * 2 + 1]; } } }
    for (int row0 = vcu * 8 + wave; row0 < nrows; row0 += 2 * NGW) {
        f32x4 v[2][4]; f16x4 ya[2][4], yb[2][4], dv[2][4]; float ga[2], gb[2]; int rows[2]; bool ok[2];
#pragma unroll
        for (int q = 0; q < 2; ++q) { const int rr = row0 + q * NGW; ok[q] = rr < nrows; const int row = ok[q] ? rr : row0; rows[q] = row;
            const float* xr = (row < TL) ? (l == 0 ? p.x : p.out) + (size_t)row * DM : (l == 0 ? p.ctx : XC) + (size_t)(row - TL) * DM; const f16* dl = (const f16*)(p.ws + WS_DELTA) + (size_t)row * DM;
            const int s0 = sl[q][0], s1 = sl[q][1]; const f16* y0 = Y2 + ((size_t)blk[s0 >> 20] * 256 + (s0 & 0xfffff)) * DM; const f16* y1 = Y2 + ((size_t)blk[s1 >> 20] * 256 + (s1 & 0xfffff)) * DM;
            ga[q] = gt[q][0]; gb[q] = gt[q][1];
#pragma unroll
            for (int j = 0; j < 4; ++j) { const int c = 256 * j + 4 * lane; v[q][j] = *(const f32x4*)(xr + c); dv[q][j] = *(const f16x4*)(dl + c); ya[q][j] = *(const f16x4*)(y0 + c); yb[q][j] = *(const f16x4*)(y1 + c); } }
        { const int r0 = row0 + 2 * NGW;
          if (r0 < nrows) {
#pragma unroll
            for (int q = 0; q < 2; ++q) { const int rr = r0 + q * NGW; const int row = rr < nrows ? rr : r0; sl[q][0] = SLOT[row * 2]; sl[q][1] = SLOT[row * 2 + 1]; gt[q][0] = GT[row * 2]; gt[q][1] = GT[row * 2 + 1]; } } }
        float ssum[2];
#pragma unroll
        for (int q = 0; q < 2; ++q) { const int row = rows[q]; const int b = modb_of_row(row); const LAS float* g2 = MODC + b * 3072;
            float* xr = (row < TL) ? p.out + (size_t)row * DM : XC + (size_t)(row - TL) * DM; float* xw = dry ? (float*)(p.ws + WS_DUMMY) + (size_t)(row & 8191) * DM : xr; float s = 0.f;
#pragma unroll
            for (int j = 0; j < 4; ++j) { const int c = 256 * j + 4 * lane; const f32x4 g = *(const LAS f32x4*)(g2 + c);
#pragma unroll
                for (int i = 0; i < 4; ++i) v[q][j][i] = (v[q][j][i] + (float)dv[q][j][i]) + g[i] * (ga[q] * (float)ya[q][j][i] + gb[q] * (float)yb[q][j][i]);
                if (ok[q]) *(f32x4*)(xw + c) = v[q][j];
                s += v[q][j][0] * v[q][j][0] + v[q][j][1] * v[q][j][1] + v[q][j][2] * v[q][j][2] + v[q][j][3] * v[q][j][3]; }
            ssum[q] = s; }
        if (l < DEPTH - 1) {
#pragma unroll
            for (int o = 1; o < 64; o <<= 1) { ssum[0] += __shfl_xor(ssum[0], o); ssum[1] += __shfl_xor(ssum[1], o); }
#pragma unroll
            for (int q = 0; q < 2; ++q) if (ok[q]) { const int row = rows[q]; const int b = modb_of_row(row); const float r = __builtin_amdgcn_rsqf(ssum[q] * (1.f / DM) + EPS); const LAS float* ml = MODC + b * 3072 + 1024;
#pragma unroll
                for (int j = 0; j < 4; ++j) { const int c = 256 * j + 4 * lane; const f32x4 ga = *(const LAS f32x4*)(ml + c), sh = *(const LAS f32x4*)(ml + 1024 + c); f16x4 o;
#pragma unroll
                    for (int i = 0; i < 4; ++i) o[i] = (f16)(v[q][j][i] * r * ga[i] + sh[i]);
                    *(f16x4*)(H + (size_t)row * DM + c) = o; } } }
    }
}

DI f32x4 mma_f16(f16x8 a, f16x8 b, f32x4 c) { return __builtin_amdgcn_mfma_f32_16x16x32_f16(a, b, c, 0, 0, 0); }
DI f32x4 mma_bf16(s16x8 a, s16x8 b, f32x4 c) { return __builtin_amdgcn_mfma_f32_16x16x32_bf16(a, b, c, 0, 0, 0); }

constexpr int TP = 72;
struct TileInfo { int row0, t0, seqrow0, len, b, isctx, chunkpos_f, chunkpos_b; };
DI TileInfo tile_info(int tt) {
    TileInfo ti;
    if (tt < 512) { ti.b = tt >> 7; ti.t0 = (tt & 127) * 64; ti.seqrow0 = ti.b * SEQ; ti.len = SEQ; ti.isctx = 0; ti.chunkpos_f = 4 + (tt & 127); ti.chunkpos_b = 4 + 127 - (tt & 127); }
    else { const int j = tt - 512; ti.b = j >> 2; ti.t0 = (j & 3) * 64; ti.seqrow0 = TL + ti.b * CTXL; ti.len = CTXL; ti.isctx = 1; ti.chunkpos_f = (j & 3); ti.chunkpos_b = 3 - (j & 3); }
    ti.row0 = ti.seqrow0 + ti.t0; return ti;
}

typedef short v4i16_t __attribute__((ext_vector_type(4)));
DI int crow(int r, int hi) { return (r & 3) + 8 * (r >> 2) + 4 * hi; }
DI int swz(int row, int col) { return row * 64 + ((((col >> 3) ^ (row & 7)) << 3) | (col & 7)); }
DI s16x4 tr_read(const LAS unsigned short* p) { return __builtin_bit_cast(s16x4, __builtin_amdgcn_ds_read_tr16_b64_v4i16((LAS v4i16_t*)p)); }
#define LGKM0() asm volatile("s_waitcnt lgkmcnt(0)" ::: "memory")
DI void wave_load_tile64(LAS unsigned short* T, const f16* src, int pitch, int lane) {
    const int c = lane & 7;
    unsigned lo = (unsigned)((lane >> 3) * pitch + 8 * c) * 2u;
    asm volatile("" : "+v"(lo));
    const char* base = (const char*)src;
#pragma unroll
    for (int it = 0; it < 8; ++it) { const int row = 8 * it + (lane >> 3); const u32x4 v = *(const u32x4*)(base + (size_t)it * 8 * pitch * 2 + lo); *(LAS u32x4*)(T + row * 64 + ((c ^ (row & 7)) << 3)) = v; }
}
DI s16x8 tr_frag16(const LAS unsigned short* T, int k0, int n0, int lane) {
    const int g = lane >> 4, i = lane & 15, q = i >> 2, pp = i & 3; const int r0 = k0 + 8 * g + q;
    const s16x4 a = tr_read(T + swz(r0, n0 + 4 * pp)), b = tr_read(T + swz(r0 + 4, n0 + 4 * pp));
    return (s16x8){a[0], a[1], a[2], a[3], b[0], b[1], b[2], b[3]};
}

template <int CTRL, int RMASK> DI float dpp_add0(float v) { return __builtin_bit_cast(float, __builtin_amdgcn_update_dpp(0, __builtin_bit_cast(int, v), CTRL, RMASK, 0xf, true)); }
DI float bcast_lane(float v, int srclane) { return __builtin_bit_cast(float, __builtin_amdgcn_readlane(__builtin_bit_cast(int, v), srclane)); }
template <int CTRL, int RMASK> DI float dpp_mul1(float v) { return __builtin_bit_cast(float, __builtin_amdgcn_update_dpp(0x3f800000, __builtin_bit_cast(int, v), CTRL, RMASK, 0xf, false)); }
DI float wave_scan_mul(float v) {
    v *= dpp_mul1<0x111, 0xf>(v); v *= dpp_mul1<0x112, 0xf>(v); v *= dpp_mul1<0x114, 0xf>(v); v *= dpp_mul1<0x118, 0xf>(v);
    v *= dpp_mul1<0x142, 0xa>(v); v *= dpp_mul1<0x143, 0xc>(v);
    return v;
}
#define SCAN8_STEP(ctrl) \
    "v_mul_f32_dpp %0, %0, %0 " ctrl "\n\tv_mul_f32_dpp %1, %1, %1 " ctrl "\n\tv_mul_f32_dpp %2, %2, %2 " ctrl "\n\tv_mul_f32_dpp %3, %3, %3 " ctrl "\n\t" \
    "v_mul_f32_dpp %4, %4, %4 " ctrl "\n\tv_mul_f32_dpp %5, %5, %5 " ctrl "\n\tv_mul_f32_dpp %6, %6, %6 " ctrl "\n\tv_mul_f32_dpp %7, %7, %7 " ctrl "\n\t"
DI void wave_scan_mul8(float (&g)[8]) {
    asm volatile("s_nop 1\n\t"
        SCAN8_STEP("row_shr:1 row_mask:0xf bank_mask:0xf") SCAN8_STEP("row_shr:2 row_mask:0xf bank_mask:0xf") SCAN8_STEP("row_shr:4 row_mask:0xf bank_mask:0xf")
        SCAN8_STEP("row_shr:8 row_mask:0xf bank_mask:0xf") SCAN8_STEP("row_bcast:15 row_mask:0xa bank_mask:0xf") SCAN8_STEP("row_bcast:31 row_mask:0xc bank_mask:0xf")
        "s_nop 1"
        : "+v"(g[0]), "+v"(g[1]), "+v"(g[2]), "+v"(g[3]), "+v"(g[4]), "+v"(g[5]), "+v"(g[6]), "+v"(g[7]));
}
DI void hgrn_state_wave(const Params& p, int l, int item, LAS unsigned short* wl, int lane) {
    const int dir = item & 1, h = (item >> 1) & 3; const TileInfo ti = tile_info(item >> 3);
    const f16* P = (const f16*)(p.ws + WS_P); float* HS = (float*)(p.ws + WS_HS); float* HA = (float*)(p.ws + WS_HA);
    LAS unsigned short* Z = wl; LAS unsigned short* V = wl + 4096;
    const f16* prow = P + (size_t)ti.row0 * INC + h * 64;
    wave_load_tile64(Z, prow + (dir ? C_HZB : C_HZF), INC, lane); wave_load_tile64(V, prow + C_HI, INC, lane);
    const float* lbp = (const float*)(p.ws + WS_LB) + l * 512 + dir * 256 + h * 64;
    const int pos = dir ? ti.chunkpos_b : ti.chunkpos_f; const size_t slot = (size_t)((dir * NB + ti.b) * NPOS + pos) * 4 + h;
    float amine = 0.f;
    const float lbv = lbp[lane];
    const int s_ = dir ? 63 - lane : lane;
    LGKM0();
#pragma unroll 1
    for (int c = 0; c < 8; ++c) { float g[8], kk[8]; LAS f16x8* zp = (LAS f16x8*)(Z + s_ * 64 + ((c ^ (s_ & 7)) << 3)); const f16x8 zv = *zp;
#pragma unroll
        for (int j = 0; j < 8; ++j) { const float lb = __builtin_bit_cast(float, __builtin_amdgcn_readlane(__builtin_bit_cast(int, lbv), 8 * c + j)); const float z = (float)zv[j]; const float sg = fast_rcp(1.f + __expf(-z)); g[j] = lb + (1.f - lb) * sg; kk[j] = (1.f - lb) * (1.f - sg); }
        wave_scan_mul8(g);
#pragma unroll
        for (int j = 0; j < 8; ++j) g[j] = fmaxf(g[j], 1e-37f);
        f16x8 ko;
#pragma unroll
        for (int j = 0; j < 8; ++j) { const float pend = bcast_lane(g[j], 63); ko[j] = (f16)(kk[j] * pend * fast_rcp(g[j])); amine = (lane == 8 * c + j) ? pend : amine; }
        *zp = ko; }
    HA[slot * 64 + lane] = amine;
    LGKM0();
    f32x4 acc[4][4];
#pragma unroll
    for (int m = 0; m < 4; ++m)
#pragma unroll
        for (int n = 0; n < 4; ++n) acc[m][n] = (f32x4){0.f, 0.f, 0.f, 0.f};
#pragma unroll
    for (int ks = 0; ks < 2; ++ks) { s16x8 a[4], b[4];
#pragma unroll
        for (int m = 0; m < 4; ++m) { a[m] = tr_frag16(V, 32 * ks, 16 * m, lane); b[m] = tr_frag16(Z, 32 * ks, 16 * m, lane); }
#pragma unroll
        for (int m = 0; m < 4; ++m)
#pragma unroll
            for (int n = 0; n < 4; ++n) acc[m][n] = mma_f16(__builtin_bit_cast(f16x8, b[n]), __builtin_bit_cast(f16x8, a[m]), acc[m][n]); }
    float* dst = HS + slot * 4096; const int fr = lane & 15, fq = lane >> 4;
#pragma unroll
    for (int m = 0; m < 4; ++m)
#pragma unroll
        for (int n = 0; n < 4; ++n)
        *(f32x4*)(dst + (16 * m + fr) * 64 + 16 * n + 4 * fq) = acc[m][n];
    LGKM0();
}

DI void qk_wave(const Params& p, int l, int pair8, int lane) {
    const f16* P = (const f16*)(p.ws + WS_P); f16* QN = (f16*)(p.ws + WS_QN); f16* KN = (f16*)(p.ws + WS_KN); const float* RT = (const float*)(p.ws + WS_ROPE);
    const int j8 = lane & 7; const int pidx = pair8 * 8 + (lane >> 3); const int row = pidx >> 1, hh = 8 + (pidx & 1);
    const f16x8 raw = *(const f16x8*)(P + (size_t)row * INC + C_Q + hh * 64 + 8 * j8);
    const bool lat = row < TL; const int t = lat ? (row & (SEQ - 1)) : 0; const int prow = t >> 6, pcol = t & 63; const int a0 = (8 * j8) & 31;
    const float* ct = (a0 < 16) ? RT + prow * 16 + a0 : RT + 4096 + pcol * 16 + (a0 - 16);
    const float* st = (a0 < 16) ? RT + 2048 + prow * 16 + a0 : RT + 4096 + 1024 + pcol * 16 + (a0 - 16);
    const float* gn = (hh < 8 ? p.q_norm_g : p.k_norm_g) + l * 64 + 8 * j8;
    const f32x4 c0 = *(const f32x4*)ct, c1 = *(const f32x4*)(ct + 4), s0 = *(const f32x4*)st, s1 = *(const f32x4*)(st + 4), g0 = *(const f32x4*)gn, g1 = *(const f32x4*)(gn + 4);
    float v[8]; float s = 0.f;
#pragma unroll
    for (int i = 0; i < 8; ++i) { v[i] = (float)raw[i]; s += v[i] * v[i]; }
    s += __shfl_xor(s, 1); s += __shfl_xor(s, 2); s += __shfl_xor(s, 4);
    const float r = __builtin_amdgcn_rsqf(s * (1.f / 64.f) + EPS) * ((hh < 8) ? 0.125f * LOG2E : 1.f);
    const float sgn = (j8 < 4) ? -1.f : 1.f;
    f16x8 o;
#pragma unroll
    for (int i = 0; i < 8; ++i) { const float gi = (i < 4) ? g0[i & 3] : g1[i & 3]; const float ci = lat ? ((i < 4) ? c0[i & 3] : c1[i & 3]) : 1.f, si = lat ? ((i < 4) ? s0[i & 3] : s1[i & 3]) * sgn : 0.f;
        v[i] = v[i] * r * gi; const float ot = __shfl_xor(v[i], 4); o[i] = (f16)(v[i] * ci + ot * si); }
    if (hh < 8) *(f16x8*)(QN + (size_t)row * 512 + hh * 64 + 8 * j8) = o; else *(f16x8*)(KN + (size_t)row * 128 + (hh - 8) * 64 + 8 * j8) = o;
}

DI void pool_wave(const Params& p, int l, int item, LAS unsigned short* wl, int lane) {
    const int g = item & 3; const TileInfo ti = tile_info(item >> 2); const int w = 2 << g;
    const f16* P = (const f16*)(p.ws + WS_P); f16* MIX = (f16*)(p.ws + WS_MIX); const f16* PW = (const f16*)(p.ws + WS_POOLW) + ((size_t)l * 4 + g) * 4096;
    { const int c = lane & 7;
#pragma unroll
      for (int it = 0; it < 10; ++it) { const int row = 8 * it + (lane >> 3); const int t = ti.t0 - 8 + row; u32x4 v = (u32x4){0u, 0u, 0u, 0u};
          if (t >= 0 && t < ti.len) v = *(const u32x4*)(P + (size_t)(ti.seqrow0 + t) * INC + C_U + g * 64 + 8 * c);
          *(LAS u32x4*)(wl + row * 64 + ((c ^ (row & 7)) << 3)) = v; } }
    LGKM0();
    const int fr = lane & 15, fq = lane >> 4;
    f32x4 acc[4][4];
#pragma unroll
    for (int m = 0; m < 4; ++m)
#pragma unroll
        for (int n = 0; n < 4; ++n) acc[m][n] = (f32x4){0.f, 0.f, 0.f, 0.f};
#pragma unroll
    for (int ks = 0; ks < 2; ++ks) { f16x8 bfr[4];
#pragma unroll
        for (int n = 0; n < 4; ++n) bfr[n] = *(const f16x8*)(PW + (n * 16 + fr) * 64 + 32 * ks + 8 * fq);
#pragma unroll
        for (int m = 0; m < 4; ++m) { const int tk = 16 * m + fr, t = ti.t0 + tk; const int ch = 4 * ks + fq;
            float sum[8] = {0.f, 0.f, 0.f, 0.f, 0.f, 0.f, 0.f, 0.f}; int cnt = 0;
            for (int off = -((w - 1) / 2); off <= w / 2; ++off) { const int q = t + off; const int row = tk + off + 8;
                const f16x8 v = *(const LAS f16x8*)(wl + row * 64 + ((ch ^ (row & 7)) << 3)); const bool ok = (q >= 0 && q < ti.len); cnt += ok ? 1 : 0;
#pragma unroll
                for (int i = 0; i < 8; ++i) sum[i] += (float)v[i]; }
            const int row = tk + 8; const f16x8 cv = *(const LAS f16x8*)(wl + row * 64 + ((ch ^ (row & 7)) << 3)); const float ic = 1.f / (float)cnt;
            f16x8 a;
#pragma unroll
            for (int i = 0; i < 8; ++i) a[i] = (f16)(sum[i] * ic - (float)cv[i]);
#pragma unroll
            for (int n = 0; n < 4; ++n) acc[m][n] = mma_f16(a, bfr[n], acc[m][n]); } }
#pragma unroll
    for (int n = 0; n < 4; ++n) { const int d = g * 64 + n * 16 + fr; const float ps = p.pool_scale[l * 256 + d];
#pragma unroll
        for (int m = 0; m < 4; ++m)
#pragma unroll
            for (int i = 0; i < 4; ++i) MIX[(size_t)(ti.row0 + 16 * m + 4 * fq + i) * DM + d] = (f16)(acc[m][n][i] * ps); }
    LGKM0();
}

DI void qs_wave(const Params& p, int item, int lane) {
    const int h = item & 3; const TileInfo ti = tile_info(item >> 2);
    const f16* prow = (const f16*)(p.ws + WS_P) + (size_t)ti.row0 * INC + C_HQ + h * 64; f16* QS = (f16*)(p.ws + WS_QS) + (size_t)ti.row0 * 256 + h * 64; const int c = lane & 7;
    f16x8 qv[8];
#pragma unroll
    for (int it = 0; it < 8; ++it) qv[it] = *(const f16x8*)(prow + (size_t)(8 * it + (lane >> 3)) * INC + 8 * c);
#pragma unroll
    for (int it = 0; it < 8; ++it) { f16x8 o;
#pragma unroll
        for (int j = 0; j < 8; ++j) o[j] = (f16)siluf((float)qv[it][j]);
        *(f16x8*)(QS + (size_t)(8 * it + (lane >> 3)) * 256 + 8 * c) = o; }
}

DI void phase_prep_w(const Params& p, int l, ldsp lds, int lane, int wave, int vcu, int G) {
    LAS unsigned short* wl = (LAS unsigned short*)(lds + wave * 16384);
    LAS unsigned* ctr = (LAS unsigned*)(lds + MISC_OFF) + 20;
    __syncthreads();
    if (threadIdx.x < 4) ctr[threadIdx.x] = 0u;
    __syncthreads();
    const int nH = (528 * 8 - vcu + G - 1) / G, nP = (528 * 4 - vcu + G - 1) / G;
    const int nQ8 = TT * 2 / 8; const int nQ = (nQ8 - vcu + G - 1) / G; const int nQc = (nQ + 4) / 5;
#define PULL(k) ({ unsigned t_ = 0; if (lane == 0) t_ = __hip_atomic_fetch_add(ctr + (k), 1u, __ATOMIC_RELAXED, __HIP_MEMORY_SCOPE_WORKGROUP); __builtin_amdgcn_readfirstlane((int)t_); })
    for (int idx = PULL(0); idx < nH; idx = PULL(0)) hgrn_state_wave(p, l, vcu + idx * G, wl, lane);
    for (int idx = PULL(1); idx < nP; idx = PULL(1)) pool_wave(p, l, vcu + idx * G, wl, lane);
    for (int idx = PULL(3); idx < nP; idx = PULL(3)) qs_wave(p, vcu + idx * G, lane);
    for (int idx = PULL(2); idx < nQc; idx = PULL(2)) { const int c0 = idx * 5;
#pragma unroll
        for (int k = c0; k < c0 + 5; ++k) qk_wave(p, l, vcu + (k < nQ ? k : nQ - 1) * G, lane); }
#undef PULL
}

DI void hgrn_out_wave(const Params& p, int l, int item, LAS unsigned short* wl, LAS float* wx, int lane) {
    const int h = item & 3; const TileInfo ti = tile_info(item >> 2);
    const f16* P = (const f16*)(p.ws + WS_P); const unsigned short* HS = (const unsigned short*)(p.ws + WS_HSB); f16* MIX = (f16*)(p.ws + WS_MIX);
    LAS unsigned short* BA = wl; LAS unsigned short* BB = wl + 4096;
    const f16* prow = P + (size_t)ti.row0 * INC + h * 64;
    const int r32 = lane & 31, hi = lane >> 5;
    f32x16 o[2][2];
#pragma unroll
    for (int a = 0; a < 2; ++a)
#pragma unroll
        for (int b = 0; b < 2; ++b)
#pragma unroll
            for (int r = 0; r < 16; ++r) o[a][b][r] = 0.f;
    const float gnv = p.hgrn_norm_g[l * 64 + lane];
    f16x4 gpre[2][2][4];
#pragma unroll
    for (int tb = 0; tb < 2; ++tb)
#pragma unroll
        for (int dvb = 0; dvb < 2; ++dvb)
#pragma unroll
            for (int g4 = 0; g4 < 4; ++g4) gpre[tb][dvb][g4] = *(const f16x4*)(P + ((size_t)ti.row0 + 32 * tb + r32) * INC + C_HG + h * 64 + 32 * dvb + 8 * g4 + 4 * hi);
#pragma unroll 1
    for (int dir = 0; dir < 2; ++dir) {
        wave_load_tile64(BA, prow + (dir ? C_HZB : C_HZF), INC, lane); wave_load_tile64(BB, (const f16*)(p.ws + WS_QS) + (size_t)ti.row0 * 256 + h * 64, 256, lane);
        u32x4 vreg[8], sreg[8];
        { const int pos = dir ? ti.chunkpos_b : ti.chunkpos_f; const char* hs = (const char*)(HS + ((size_t)((dir * NB + ti.b) * NPOS + pos) * 4 + h) * 4096); const char* vb = (const char*)(prow + C_HI);
          unsigned lov = (unsigned)((lane >> 3) * INC + 8 * (lane & 7)) * 2u, los = (unsigned)((lane >> 3) * 64 + 8 * (lane & 7)) * 2u; asm volatile("" : "+v"(lov), "+v"(los));
#pragma unroll
          for (int it = 0; it < 8; ++it) { vreg[it] = *(const u32x4*)(vb + (size_t)it * 8 * INC * 2 + lov); sreg[it] = *(const u32x4*)(hs + (size_t)it * 8 * 64 * 2 + los); } }
        const float* lbp = (const float*)(p.ws + WS_LB) + l * 512 + dir * 256 + h * 64;
        float er_mine = 0.f;
        const float lbv = lbp[lane];
        LGKM0();
        const int s_ = dir ? 63 - lane : lane;
#pragma unroll 1
        for (int c = 0; c < 8; ++c) { float g[8], kk[8]; LAS f16x8* zp = (LAS f16x8*)(BA + s_ * 64 + ((c ^ (s_ & 7)) << 3)); LAS f16x8* qp = (LAS f16x8*)(BB + s_ * 64 + ((c ^ (s_ & 7)) << 3));
            const f16x8 zv = *zp, qv = *qp;
#pragma unroll
            for (int j = 0; j < 8; ++j) { const float lb = bcast_lane(lbv, 8 * c + j); const float z = (float)zv[j]; const float sg = fast_rcp(1.f + __expf(-z)); g[j] = lb + (1.f - lb) * sg; kk[j] = (1.f - lb) * (1.f - sg); }
            wave_scan_mul8(g);
#pragma unroll
            for (int j = 0; j < 8; ++j) g[j] = fmaxf(g[j], 1e-37f);
            float kf_[8], qf_[8];
#pragma unroll
            for (int j = 0; j < 8; ++j) { const float r = fast_rcp(g[j]); const float pref = bcast_lane(g[j], 31), rpref = bcast_lane(r, 31);
                kf_[j] = kk[j] * pref * r; qf_[j] = (float)qv[j] * g[j] * rpref; er_mine = (lane == 8 * c + j) ? pref : er_mine; }
            u32x4 ko, qo;
#pragma unroll
            for (int j = 0; j < 4; ++j) { ko[j] = cvt_pk_bf16(kf_[2 * j], kf_[2 * j + 1]); qo[j] = cvt_pk_bf16(qf_[2 * j], qf_[2 * j + 1]); }
            *(LAS u32x4*)zp = ko; *(LAS u32x4*)qp = qo; }
        wx[lane] = er_mine;
        LGKM0();
        s16x8 qf[2][4];
#pragma unroll
        for (int b = 0; b < 2; ++b)
#pragma unroll
            for (int d0 = 0; d0 < 4; ++d0) { const int row = 32 * b + r32, ch = 2 * d0 + hi; qf[b][d0] = *(const LAS s16x8*)(BB + row * 64 + ((ch ^ (row & 7)) << 3)); }
        LGKM0();
        { const int c = lane & 7;
#pragma unroll
          for (int it = 0; it < 8; ++it) { const int row = 8 * it + (lane >> 3); *(LAS u32x4*)(BB + row * 64 + ((c ^ (row & 7)) << 3)) = vreg[it]; } }
        LGKM0();
#pragma unroll
        for (int tb = 0; tb < 2; ++tb)
#pragma unroll
            for (int sb = 0; sb < 2; ++sb) {
                const bool diag = (sb == tb); const bool full = dir ? (sb > tb) : (sb < tb);
                if (!diag && !full) continue;
                f32x16 pt;
#pragma unroll
                for (int r = 0; r < 16; ++r) pt[r] = 0.f;
#pragma unroll
                for (int d0 = 0; d0 < 4; ++d0) { const int row = 32 * sb + r32, ch = 2 * d0 + hi; const s16x8 kf = *(const LAS s16x8*)(BA + row * 64 + ((ch ^ (row & 7)) << 3));
                    pt = __builtin_amdgcn_mfma_f32_32x32x16_bf16(kf, qf[tb][d0], pt, 0, 0, 0); }
                if (diag) {
#pragma unroll
                    for (int r = 0; r < 16; ++r) { const int sl = crow(r, hi); const bool keep = dir ? (sl >= r32) : (sl <= r32); pt[r] = keep ? pt[r] : 0.f; } }
                f16x8 pw[2];
#pragma unroll
                for (int j = 0; j < 8; ++j) { pw[0][j] = (f16)pt[j]; pw[1][j] = (f16)pt[8 + j]; }
#pragma unroll
                for (int dvb = 0; dvb < 2; ++dvb)
#pragma unroll
                    for (int ss = 0; ss < 2; ++ss) { const int i16 = lane & 15, g1 = (lane >> 4) & 1; const int r0 = 32 * sb + 16 * ss + 4 * hi + (i16 >> 2), c0 = 32 * dvb + 16 * g1 + 4 * (i16 & 3);
                        const s16x4 a = tr_read(BB + swz(r0, c0)), b = tr_read(BB + swz(r0 + 8, c0));
                        const s16x8 vf = (s16x8){a[0], a[1], a[2], a[3], b[0], b[1], b[2], b[3]};
                        o[dvb][tb] = __builtin_amdgcn_mfma_f32_32x32x16_f16(__builtin_bit_cast(f16x8, vf), pw[ss], o[dvb][tb], 0, 0, 0); }
            }
        LGKM0();
        { const int c8 = lane & 7; const f32x4 er0 = *(const LAS f32x4*)(wx + 8 * c8), er1 = *(const LAS f32x4*)(wx + 8 * c8 + 4);
#pragma unroll
          for (int it = 0; it < 8; ++it) { const int row = 8 * it + (lane >> 3); const u32x4 sv = sreg[it];
              u32x4 w4;
#pragma unroll
              for (int q = 0; q < 4; ++q) { const float lo = __builtin_bit_cast(float, sv[q] << 16), hi2 = __builtin_bit_cast(float, sv[q] & 0xffff0000u);
                  const float e0 = (q < 2) ? er0[2 * q] : er1[2 * q - 4], e1 = (q < 2) ? er0[2 * q + 1] : er1[2 * q - 3]; w4[q] = cvt_pk_bf16(lo * e0, hi2 * e1); }
              *(LAS u32x4*)(BA + row * 64 + ((c8 ^ (row & 7)) << 3)) = w4; } }
        LGKM0();
#pragma unroll
        for (int dvb = 0; dvb < 2; ++dvb)
#pragma unroll
            for (int d0 = 0; d0 < 4; ++d0) { const int row = 32 * dvb + r32, ch = 2 * d0 + hi; const s16x8 sf = *(const LAS s16x8*)(BA + row * 64 + ((ch ^ (row & 7)) << 3));
#pragma unroll
                for (int tb = 0; tb < 2; ++tb) o[dvb][tb] = __builtin_amdgcn_mfma_f32_32x32x16_bf16(sf, qf[tb][d0], o[dvb][tb], 0, 0, 0); }
        LGKM0();
    }
    wx[64 + lane] = gnv;
    LGKM0();
#pragma unroll
    for (int tb = 0; tb < 2; ++tb) { float ss = 0.f;
#pragma unroll
        for (int dvb = 0; dvb < 2; ++dvb)
#pragma unroll
            for (int r = 0; r < 16; ++r) ss += o[dvb][tb][r] * o[dvb][tb][r];
        ss += __shfl_xor(ss, 32); const float rn = __builtin_amdgcn_rsqf(ss * (1.f / 64.f) + EPS);
        const size_t row = (size_t)ti.row0 + 32 * tb + r32;
#pragma unroll
        for (int dvb = 0; dvb < 2; ++dvb)
#pragma unroll
            for (int g4 = 0; g4 < 4; ++g4) { const int dv0 = 32 * dvb + 8 * g4 + 4 * hi; const f16x4 gt = gpre[tb][dvb][g4]; const f32x4 gg = *(const LAS f32x4*)(wx + 64 + dv0);
                f16x4 ov;
#pragma unroll
                for (int i = 0; i < 4; ++i) ov[i] = (f16)(o[dvb][tb][4 * g4 + i] * rn * gg[i] * siluf((float)gt[i]));
                *(f16x4*)(MIX + row * DM + 768 + h * 64 + dv0) = ov; } }
}
DI void phase_hgrn_out_w(const Params& p, int l, ldsp lds, int lane, int wave, int vcu, int G) {
    LAS unsigned short* wl = (LAS unsigned short*)(lds + wave * 16384); LAS float* wx = (LAS float*)(lds + BLK_OFF + 1024 + wave * 512);
    const int gw = vcu * 8 + wave, NGW = G * 8;
    const int nit = (l == DEPTH - 1) ? 512 * 4 : 528 * 4;
    for (int it = gw; it < nit; it += NGW) hgrn_out_wave(p, l, it, wl, wx, lane);
}

DI void phase_scan(const Params& p, int tid, int vcu, int G, int dry) {
    const float* HS = (const float*)(p.ws + WS_HS); const float* HA = (const float*)(p.ws + WS_HA); unsigned short* HSB = (unsigned short*)(p.ws + (dry ? WS_DUMMY : WS_HSB));
    for (int gid = vcu * 512 + tid; gid < 2 * NB * 4 * 4096; gid += G * 512) {
        const int el = gid & 4095, h = (gid >> 12) & 3, db = gid >> 14;
        const size_t hoff = ((size_t)db * NPOS * 4 + h) * 4096 + el; const float* hs = HS + hoff; unsigned short* hso = HSB + hoff; const float* ha = HA + ((size_t)db * NPOS * 4 + h) * 64 + (el & 63);
        float S = 0.f;
        for (int pos = 0; pos < NPOS; pos += 12) { float u[12], a[12];
#pragma unroll
            for (int j = 0; j < 12; ++j) { u[j] = hs[(size_t)(pos + j) * 4 * 4096]; a[j] = ha[(size_t)(pos + j) * 4 * 64]; }
#pragma unroll
            for (int j = 0; j < 12; ++j) { hso[(size_t)(pos + j) * 4 * 4096] = f2bf(S); S = a[j] * S + u[j]; } }
    }
}

DI void attn_item(const Params& p, int l, int idx, ldsp lds, int tid, int lane, int wave) {
    const f16* P = (const f16*)(p.ws + WS_P); const f16* QN = (const f16*)(p.ws + WS_QN); const f16* KN = (const f16*)(p.ws + WS_KN); f16* MIX = (f16*)(p.ws + WS_MIX);
    int b, kvh, qb, isctx;
    if (idx < 1024) { b = idx >> 8; kvh = (idx >> 7) & 1; qb = idx & 127; isctx = 0; } else { const int j = idx - 1024; b = j >> 3; kvh = (j >> 2) & 1; qb = j & 3; isctx = 1; }
    const int q0 = qb * 64; const int qrowbase = isctx ? TL + b * CTXL : b * SEQ;
    const int r32 = lane & 31, hi = lane >> 5; const int hq = kvh * 4 + (wave >> 1); const int qpos = q0 + (wave & 1) * 32 + r32; const size_t qrow = (size_t)qrowbase + qpos;
    LAS f16* KB = (LAS f16*)lds;
    LAS f16* VTB = KB + 2 * 64 * TP;
    float lsum = hi ? 0.f : __builtin_amdgcn_exp2f(p.attn_sink[l * 8 + hq] * LOG2E - 4.f);
    f32x16 o[2];
#pragma unroll
    for (int r = 0; r < 16; ++r) { o[0][r] = 0.f; o[1][r] = 0.f; }
    const int srow = tid >> 3, sc8 = tid & 7;
    const int ntile = isctx ? 4 : 9;
    int cur = 0; bool have = false; f16x8 kreg, vreg;
    int tix = 0;
#define TILE_VALID(t) (isctx || (t) >= 5 || ((q0 - 128 + 64 * (t)) >= 0 && (q0 - 128 + 64 * (t)) < SEQ))
#define TILE_ROW(t) ((isctx || (t) >= 5) ? (TL + b * CTXL + 64 * (isctx ? (t) : (t) - 5)) : (b * SEQ + q0 - 128 + 64 * (t)))
    while (tix < ntile && !TILE_VALID(tix)) ++tix;
    { const size_t kr = (size_t)TILE_ROW(tix) + srow; kreg = *(const f16x8*)(KN + kr * 128 + kvh * 64 + 8 * sc8); vreg = *(const f16x8*)(P + kr * INC + C_V + kvh * 64 + 8 * sc8); }
    f16x8 qr[4];
    {
      const float* RT = (const float*)(p.ws + WS_ROPE); const f16* qp = P + qrow * INC + C_Q + hq * 64 + 8 * hi; const float* gq = p.q_norm_g + l * 64 + 8 * hi;
      f16x8 raw[4];
#pragma unroll
      for (int d0 = 0; d0 < 4; ++d0) raw[d0] = *(const f16x8*)(qp + 16 * d0);
      const int t = isctx ? 0 : qpos; const int prow = t >> 6, pcol = t & 63;
      const float* ctr = RT + prow * 16 + 8 * hi; const float* ctc = RT + 4096 + pcol * 16 + 8 * hi;
      f32x4 cs[2][2], sn[2][2], gg[4][2];
#pragma unroll
      for (int h2 = 0; h2 < 2; ++h2) { cs[0][h2] = *(const f32x4*)(ctr + 4 * h2); sn[0][h2] = *(const f32x4*)(ctr + 2048 + 4 * h2); cs[1][h2] = *(const f32x4*)(ctc + 4 * h2); sn[1][h2] = *(const f32x4*)(ctc + 1024 + 4 * h2); }
#pragma unroll
      for (int d0 = 0; d0 < 4; ++d0) { gg[d0][0] = *(const f32x4*)(gq + 16 * d0); gg[d0][1] = *(const f32x4*)(gq + 16 * d0 + 4); }
      float ss = 0.f;
#pragma unroll
      for (int d0 = 0; d0 < 4; ++d0)
#pragma unroll
          for (int j = 0; j < 8; ++j) { const float v_ = (float)raw[d0][j]; ss += v_ * v_; }
      ss += __shfl_xor(ss, 32);
      const float rq = __builtin_amdgcn_rsqf(ss * (1.f / 64.f) + EPS) * (0.125f * LOG2E);
#pragma unroll
      for (int d0 = 0; d0 < 2; ++d0)
#pragma unroll
          for (int j = 0; j < 8; ++j) { const float c_ = isctx ? 1.f : cs[d0][j >> 2][j & 3], s_ = isctx ? 0.f : sn[d0][j >> 2][j & 3];
              const float xl = (float)raw[d0][j] * rq * gg[d0][j >> 2][j & 3], xh = (float)raw[d0 + 2][j] * rq * gg[d0 + 2][j >> 2][j & 3];
              qr[d0][j] = (f16)(xl * c_ - xh * s_); qr[d0 + 2][j] = (f16)(xh * c_ + xl * s_); } }
    { *(LAS f16x8*)(KB + srow * TP + 8 * sc8) = kreg;
#pragma unroll
      for (int i = 0; i < 8; ++i) VTB[(8 * sc8 + i) * TP + srow] = vreg[i]; }
    __syncthreads();
    while (tix < ntile) {
        int nx = tix + 1; while (nx < ntile && !TILE_VALID(nx)) ++nx;
        have = nx < ntile;
        if (have) { const size_t kr = (size_t)TILE_ROW(nx) + srow; kreg = *(const f16x8*)(KN + kr * 128 + kvh * 64 + 8 * sc8); vreg = *(const f16x8*)(P + kr * INC + C_V + kvh * 64 + 8 * sc8); }
        const LAS f16* Kc = KB + cur * 64 * TP; const LAS f16* Vc = VTB + cur * 64 * TP;
        f32x16 p0, p1;
#pragma unroll
        for (int r = 0; r < 16; ++r) { p0[r] = -4.f; p1[r] = -4.f; }
#pragma unroll
        for (int d0 = 0; d0 < 4; ++d0) { const f16x8 k0 = *(const LAS f16x8*)(Kc + r32 * TP + 16 * d0 + 8 * hi); const f16x8 k1 = *(const LAS f16x8*)(Kc + (32 + r32) * TP + 16 * d0 + 8 * hi);
            p0 = __builtin_amdgcn_mfma_f32_32x32x16_f16(k0, qr[d0], p0, 0, 0, 0); p1 = __builtin_amdgcn_mfma_f32_32x32x16_f16(k1, qr[d0], p1, 0, 0, 0); }
        if (!isctx && (tix == 0 || tix == 4)) { const int kstart = q0 - 128 + 64 * tix;
#pragma unroll
            for (int r = 0; r < 16; ++r) { const int d0_ = qpos - (kstart + crow(r, hi)); if (d0_ > 128 || d0_ < -128) p0[r] = -INFINITY; const int d1_ = d0_ - 32; if (d1_ > 128 || d1_ < -128) p1[r] = -INFINITY; } }
        float ps = 0.f;
#pragma unroll
        for (int r = 0; r < 16; ++r) { p0[r] = __builtin_amdgcn_exp2f(p0[r]); p1[r] = __builtin_amdgcn_exp2f(p1[r]); ps += p0[r] + p1[r]; }
        lsum += ps;
        f16x8 pw[4];
#pragma unroll
        for (int j = 0; j < 8; ++j) { pw[0][j] = (f16)p0[j]; pw[1][j] = (f16)p0[8 + j]; pw[2][j] = (f16)p1[j]; pw[3][j] = (f16)p1[8 + j]; }
#pragma unroll
        for (int s_ = 0; s_ < 4; ++s_) pw[s_] = __builtin_elementwise_min(pw[s_], (f16x8){(f16)65504.f, (f16)65504.f, (f16)65504.f, (f16)65504.f, (f16)65504.f, (f16)65504.f, (f16)65504.f, (f16)65504.f});
#pragma unroll
        for (int d1 = 0; d1 < 2; ++d1)
#pragma unroll
            for (int s = 0; s < 4; ++s) { const LAS f16* vp = Vc + (32 * d1 + r32) * TP + 16 * s + 4 * hi; const f16x4 lo = *(const LAS f16x4*)vp, hv = *(const LAS f16x4*)(vp + 8);
                const f16x8 vf = (f16x8){lo[0], lo[1], lo[2], lo[3], hv[0], hv[1], hv[2], hv[3]};
                o[d1] = __builtin_amdgcn_mfma_f32_32x32x16_f16(vf, pw[s], o[d1], 0, 0, 0); }
        if (have) { LAS f16* Kn = KB + (cur ^ 1) * 64 * TP; LAS f16* Vn = VTB + (cur ^ 1) * 64 * TP;
            *(LAS f16x8*)(Kn + srow * TP + 8 * sc8) = kreg;
#pragma unroll
            for (int i = 0; i < 8; ++i) Vn[(8 * sc8 + i) * TP + srow] = vreg[i]; }
        __syncthreads();
        cur ^= 1; tix = nx;
    }
#undef TILE_VALID
#undef TILE_ROW
    const float lt = lsum + __shfl_xor(lsum, 32); const float il = 1.f / lt;
    f16* orow = MIX + qrow * DM + 256 + hq * 64;
#pragma unroll
    for (int d1 = 0; d1 < 2; ++d1)
#pragma unroll
        for (int g = 0; g < 4; ++g) { f16x4 v;
#pragma unroll
            for (int i = 0; i < 4; ++i) v[i] = (f16)(o[d1][4 * g + i] * il);
            *(f16x4*)(orow + 32 * d1 + 8 * g + 4 * hi) = v; }
}
DI void phase_attn(const Params& p, int l, ldsp lds, int tid, int lane, int wave, int vcu, int G, int rep) {
    unsigned* qc = (unsigned*)(p.ws + WS_CTL) + CW_QUEUE + (l * 2 + rep) * 64; volatile LAS unsigned* slot = (volatile LAS unsigned*)(lds + MISC_OFF) + 16;
    const int nitems = (l == DEPTH - 1) ? 1024 : 1056;
    unsigned it = (unsigned)vcu;
    int par = 0;
    __syncthreads();
    while (it < (unsigned)nitems) {
        if (tid == 0) slot[par] = atomicAdd(qc, 1u) + (unsigned)G;
        attn_item(p, l, (int)it, lds, tid, lane, wave);
        it = slot[par]; par ^= 1;
    }
    __syncthreads();
}

DI void phase_outproj_ctx(const Params& p, int l, int lane, int wave, int vcu, int G, int dry) {
    const f16* MIX = (const f16*)(p.ws + WS_MIX) + (size_t)TL * DM; const f16* W = (const f16*)(p.ws + WS_WOUT) + (size_t)l * DM * DM;
    f16* xd = (f16*)(p.ws + (dry ? WS_DUMMY + 136 * MiB : WS_DELTA)) + (dry ? 0 : (size_t)TL * DM);
    const float* g1 = (const float*)(p.ws + WS_MOD) + ((size_t)l * 5 + 4) * 6144 + 2 * 1024;
    const int fr = lane & 15, fq = lane >> 4;
    for (int it = vcu; it < 256; it += G) { const int r0 = (it >> 4) * 64 + 16 * (wave & 3), c0 = (it & 15) * 64 + 32 * (wave >> 2);
        f32x4 acc[2] = {(f32x4){0.f, 0.f, 0.f, 0.f}, (f32x4){0.f, 0.f, 0.f, 0.f}};
        const float gv0 = g1[c0 + fr], gv1 = g1[c0 + 16 + fr];
        const f16* ap = MIX + (size_t)(r0 + fr) * DM + 8 * fq; const f16* bp = W + (size_t)(c0 + fr) * DM + 8 * fq;
#pragma unroll 8
        for (int ks = 0; ks < 32; ++ks) { const f16x8 a = *(const f16x8*)(ap + 32 * ks); const f16x8 b0 = *(const f16x8*)(bp + 32 * ks), b1 = *(const f16x8*)(bp + 16 * DM + 32 * ks);
            acc[0] = mma_f16(a, b0, acc[0]); acc[1] = mma_f16(a, b1, acc[1]); }
#pragma unroll
        for (int n = 0; n < 2; ++n) { const int col = c0 + 16 * n + fr; const float gv = n ? gv1 : gv0;
#pragma unroll
            for (int i = 0; i < 4; ++i) xd[(size_t)(r0 + 4 * fq + i) * DM + col] = (f16)(gv * acc[n][i]); } }
}

DI void phase_router(const Params& p, int l, ldsp lds, int tid, int lane, int wave, int vcu, int G, int dry) {
    const float* MOD = (const float*)(p.ws + WS_MOD); f16* H = (f16*)(p.ws + (dry ? WS_DUMMY : WS_H)); const float* XC = (const float*)(p.ws + WS_XC); const f16* WRH = (const f16*)(p.ws + WS_WR) + (size_t)l * 48 * 1024; const f16* WRL = WRH + (size_t)DEPTH * 48 * 1024;
    int* SLOT = (int*)(p.ws + (dry ? WS_DUMMY + 88 * MiB : WS_SLOT)); float* GT = (float*)(p.ws + (dry ? WS_DUMMY + 80 * MiB : WS_GATES)); int* LIST = (int*)(p.ws + (dry ? WS_DUMMY + 96 * MiB : WS_LIST)); unsigned* CNT = (unsigned*)(p.ws + WS_CTL) + CW_CNT + l * 32 * 16 + (dry ? 4096 : 0);
    constexpr int XP = 1028;
    LAS float* XT = (LAS float*)lds;
    LAS float* PART = XT + 16 * XP;
    LAS float* MODL = PART + 8 * 16 * 40;
    LAS float* LG = (LAS float*)(lds + BLK_OFF);
    const int fr = lane & 15, fq = lane >> 4;
    f16x8 wh[4][3], wl_[4][3];
#pragma unroll
    for (int ks = 0; ks < 4; ++ks)
#pragma unroll
        for (int n = 0; n < 3; ++n) { const size_t o = (size_t)(16 * n + fr) * 1024 + wave * 128 + 32 * ks + 8 * fq; wh[ks][n] = *(const f16x8*)(WRH + o); wl_[ks][n] = *(const f16x8*)(WRL + o); }
    const int ntiles = (l == DEPTH - 1 ? TL : TT) / 16;
    LAS int* SEL = (LAS int*)(LG + 16 * 48);
    LAS int* BASE = SEL + 64;
    f32x4 v[2][4];
    const float* xsl = (l == 0) ? p.x : p.out; const float* xsc = (l == 0) ? p.ctx : XC; const f16* DL = (const f16*)(p.ws + WS_DELTA);
    float* xwl = dry ? (float*)(p.ws + WS_DUMMY + 8 * MiB) : p.out; float* xwc = dry ? (float*)(p.ws + WS_DUMMY + 8 * MiB) : (float*)(p.ws + WS_XC);
    f16x4 dv[2][4];
#define RT_LOAD(tile_) do { _Pragma("unroll") for (int q = 0; q < 2; ++q) { const int row = (tile_) * 16 + wave + 8 * q; const float* xr_ = (row < TL) ? xsl + (size_t)row * DM : xsc + (size_t)(row - TL) * DM; \
        _Pragma("unroll") for (int j = 0; j < 4; ++j) { v[q][j] = *(const f32x4*)(xr_ + 256 * j + 4 * lane); dv[q][j] = *(const f16x4*)(DL + (size_t)row * DM + 256 * j + 4 * lane); } } } while (0)
#define RT_FLUSH(buf_, row0_) do { if (tid >= 64 && tid < 96) { const int ft_ = tid - 64; const int e = SEL[(buf_) * 32 + ft_]; int rank = 0;        \
        _Pragma("unroll") for (int j = 0; j < 32; ++j) rank += (j < ft_ && SEL[(buf_) * 32 + j] == e) ? 1 : 0; \
        const int pos_ = BASE[(buf_) * 32 + e] + rank; const int ent_ = ((row0_) + (ft_ >> 1)) * 2 + (ft_ & 1); LIST[(size_t)e * TT + pos_] = ent_; SLOT[ent_] = (e << 20) | pos_; } } while (0)
    { const float* gn_ = p.norm2_g + l * DM;
#pragma unroll
      for (int it_ = 0; it_ < 10; ++it_) { const int i = tid + 512 * it_; const int b_ = i >> 10, k_ = i & 1023; const float* m2_ = MOD + ((size_t)l * 5 + b_) * 6144;
          MODL[b_ * 2048 + k_] = gn_[k_] * (1.f + m2_[4 * 1024 + k_]); MODL[b_ * 2048 + 1024 + k_] = m2_[3 * 1024 + k_]; } }
    const int o0_ = tid % 36, o1_ = (tid + 512) % 36;
    const float bias0 = (o0_ < 4) ? p.rgb[l * 4 + o0_] : p.reb[l * 32 + (o0_ - 4)], bias1 = (o1_ < 4) ? p.rgb[l * 4 + o1_] : p.reb[l * 32 + (o1_ - 4)];
    __syncthreads();
    int tile = vcu; int cur = 0; int prev_row0 = -1; unsigned pend = 0u; bool pend_valid = false;
    if (tile < ntiles) RT_LOAD(tile);
    for (; tile < ntiles; tile += G, cur ^= 1) {
        const int row0 = tile * 16;
        { float ssum[2];
#pragma unroll
          for (int q = 0; q < 2; ++q) { float s = 0.f; const int row = row0 + wave + 8 * q; float* xw_ = (row < TL) ? xwl + (size_t)(dry ? (row & 1023) : row) * DM : xwc + (size_t)(row - TL) * DM;
#pragma unroll
              for (int j = 0; j < 4; ++j) {
#pragma unroll
                  for (int i = 0; i < 4; ++i) v[q][j][i] += (float)dv[q][j][i];
                  s += v[q][j][0] * v[q][j][0] + v[q][j][1] * v[q][j][1] + v[q][j][2] * v[q][j][2] + v[q][j][3] * v[q][j][3]; }
              ssum[q] = s; }
#pragma unroll
          for (int o = 1; o < 64; o <<= 1) { ssum[0] += __shfl_xor(ssum[0], o); ssum[1] += __shfl_xor(ssum[1], o); }
          const int b = modb_of_row(row0); const LAS float* ml = MODL + b * 2048;
#pragma unroll
          for (int j = 0; j < 4; ++j) { const int c = 256 * j + 4 * lane; const f32x4 ga = *(const LAS f32x4*)(ml + c), sh = *(const LAS f32x4*)(ml + 1024 + c);
#pragma unroll
              for (int q = 0; q < 2; ++q) { const int rr = wave + 8 * q; const float r = __builtin_amdgcn_rsqf(ssum[q] * (1.f / DM) + EPS); f32x4 hv; f16x4 o;
#pragma unroll
                  for (int i = 0; i < 4; ++i) { hv[i] = v[q][j][i] * r * ga[i] + sh[i]; o[i] = (f16)hv[i]; }
                  *(f16x4*)(H + (size_t)(row0 + rr) * DM + c) = o; *(LAS f32x4*)(XT + rr * XP + c) = hv; } } }
        if (pend_valid) BASE[(cur ^ 1) * 32 + tid] = (int)pend;
        __syncthreads();
        if (tile + G < ntiles) RT_LOAD(tile + G);
        if (prev_row0 >= 0) RT_FLUSH(cur ^ 1, prev_row0);
        { f32x4 acc[3];
#pragma unroll
          for (int n = 0; n < 3; ++n) acc[n] = (f32x4){0.f, 0.f, 0.f, 0.f};
#pragma unroll
          for (int ks = 0; ks < 4; ++ks) { const LAS float* xp = XT + fr * XP + wave * 128 + 32 * ks + 8 * fq; const f32x4 x0 = *(const LAS f32x4*)xp, x1 = *(const LAS f32x4*)(xp + 4);
              f16x8 ah, al;
#pragma unroll
              for (int j = 0; j < 4; ++j) { ah[j] = (f16)x0[j]; al[j] = (f16)(x0[j] - (float)ah[j]); ah[4 + j] = (f16)x1[j]; al[4 + j] = (f16)(x1[j] - (float)ah[4 + j]); }
#pragma unroll
              for (int n = 0; n < 3; ++n) { acc[n] = mma_f16(ah, wh[ks][n], acc[n]); acc[n] = mma_f16(ah, wl_[ks][n], acc[n]); acc[n] = mma_f16(al, wh[ks][n], acc[n]); } }
#pragma unroll
          for (int n = 0; n < 3; ++n)
#pragma unroll
              for (int i = 0; i < 4; ++i) if (n < 2 || fr < 8) PART[(wave * 16 + 4 * fq + i) * 40 + 16 * n + fr] = acc[n][i] * (1.f / 1024.f); }
        __syncthreads();
        for (int i = tid; i < 16 * 36; i += 512) { const int tk = i / 36, o = i % 36; float s = 0.f;
#pragma unroll
            for (int w = 0; w < 8; ++w) s += PART[(w * 16 + tk) * 40 + o];
            LG[tk * 48 + o] = s + (i < 512 ? bias0 : bias1); }
        __syncthreads();
        if (tid < 16) { const int row = row0 + tid; const LAS float* lg = LG + tid * 48;
            int g = 0; float gm = lg[0];
#pragma unroll
            for (int j = 1; j < 4; ++j) if (lg[j] > gm) { gm = lg[j]; g = j; }
            float den = 0.f;
#pragma unroll
            for (int j = 0; j < 4; ++j) den += __builtin_amdgcn_exp2f((lg[j] - gm) * LOG2E);
            const float pg = __builtin_amdgcn_rcpf(den);
            const LAS float* le = lg + 4 + 8 * g; int e0 = 0; float m0 = le[0];
#pragma unroll
            for (int j = 1; j < 8; ++j) if (le[j] > m0) { m0 = le[j]; e0 = j; }
            int e1 = -1; float m1 = -INFINITY;
#pragma unroll
            for (int j = 0; j < 8; ++j) if (j != e0 && le[j] > m1) { m1 = le[j]; e1 = j; }
            const float w0 = __builtin_amdgcn_rcpf(1.f + __builtin_amdgcn_exp2f((m1 - m0) * LOG2E)), w1 = 1.f - w0;
            *(f32x2*)(GT + row * 2) = (f32x2){pg * w0, pg * w1};
            SEL[cur * 32 + tid * 2] = 8 * g + e0; SEL[cur * 32 + tid * 2 + 1] = 8 * g + e1; }
        if (tid < 64) asm volatile("s_waitcnt lgkmcnt(0)" ::: "memory");
        pend_valid = false;
        if (tid < 32) { int c = 0;
#pragma unroll
            for (int j = 0; j < 32; ++j) c += (SEL[cur * 32 + j] == tid) ? 1 : 0;
            if (c > 0) { pend = atomicAdd(CNT + tid * 16, (unsigned)c); pend_valid = true; } }
        prev_row0 = row0;
    }
    if (pend_valid) BASE[(cur ^ 1) * 32 + tid] = (int)pend;
    __syncthreads();
    if (prev_row0 >= 0) RT_FLUSH(cur ^ 1, prev_row0);
    __syncthreads();
#undef RT_LOAD
#undef RT_FLUSH
}

DI int moe_setup(const Params& p, int l, ldsp lds, int tid, int G, int bx) {
    LAS int* blk = (LAS int*)(lds + BLK_OFF); LAS int* cnt = blk + 40; LAS int* utab = blk + 80;
    const unsigned* CNT = (const unsigned*)(p.ws + WS_CTL) + CW_CNT + l * 32 * 16;
    if (tid < 64) {
        const int c = (tid < 32) ? (int)__hip_atomic_load(CNT + (tid & 31) * 16, __ATOMIC_RELAXED, __HIP_MEMORY_SCOPE_AGENT) : 0;
        const int nb = (c + 255) >> 8; int incl = nb;
#pragma unroll
        for (int o = 1; o < 32; o <<= 1) { const int t = __shfl_up(incl, o); if (tid >= o) incl += t; }
        if (tid < 32) { cnt[tid] = c; blk[tid] = incl - nb; }
        if (tid == 31) blk[32] = incl; }
    __syncthreads();
    if (tid < 16) { const int Lq = pg8::moe_unit(tid, G, bx, blk[32] * 4); const int L = Lq < 0 ? 0 : Lq; const int rb = L >> 2; int e = 0;
        for (int j = 1; j < NEXP; ++j) e = (blk[j] <= rb) ? j : e;
        utab[tid] = (e << 16) | ((rb - blk[e]) & 0xffff); }
    __syncthreads();
    return blk[32];
}


#if defined(__HIP_DEVICE_COMPILE__)
#define LOADP() Params p; { const __attribute__((address_space(4))) Params* kp_ = (const __attribute__((address_space(4))) Params*)__builtin_amdgcn_kernarg_segment_ptr(); asm volatile("" : "+s"(kp_)); \
    __builtin_memcpy(&p, (const Params*)kp_, sizeof(Params)); }
#else
#define LOADP() Params p = p_unused;
#endif
#define PV() int tid = tid0; asm volatile("" : "+v"(tid)); const int lane = tid & 63, wave = __builtin_amdgcn_readfirstlane(tid >> 6); int G = G0, bx = bx0; asm volatile("" : "+s"(G), "+s"(bx)); \
    const int vcu = (G % 8 == 0) ? (bx % 8) * (G / 8) + bx / 8 : bx; int l = l0; asm volatile("" : "+s"(l)); (void)lane; (void)wave; (void)vcu; (void)l;
#define AMP_T0(n) unsigned long long amp_t0_ = 0; if (AMP_PHASE == (n)) amp_t0_ = __builtin_amdgcn_s_memrealtime();
#define AMP_WAIT(n) if (AMP_PHASE == (n)) { const unsigned long long t1_ = __builtin_amdgcn_s_memrealtime(); const unsigned long long w_ = (t1_ - amp_t0_) * AMP_K; while (__builtin_amdgcn_s_memrealtime() - t1_ < w_) __builtin_amdgcn_s_sleep(8); }
template <int L0> DI void layer_body(const XcdBarrier& bar, ldsp lds, const int tid0, const int G0, const int bx0, const Params& p_unused) {
    constexpr int l0 = L0;


{ AMP_T0(2)
#ifndef SKIP_INPROJ
        for (int rep_ = 0; rep_ < (DUP_PHASE == 2 ? 2 : 1); ++rep_) { LOADP(); PV(); unsigned char* ws = p.ws; pg8::Gemm g{(const f16*)(ws + WS_H), (const f16*)(ws + WS_WIN) + (size_t)l * INC * DM, DM, 0}; pg8::StaticOrder S; S.init(TT, INC, G, bx);
          EpiP E{(f16*)(ws + WS_P), INC};
          pg8::gemm_phase<EpiP, pg8::StaticOrder, true, false>(lds, g, S, E, tid);
          if (l < DEPTH - 1 && rep_ == 0) { const int nu = (TT / 256) * (INC / 256); if ((nu - bx + G - 1) / G < (nu + G - 1) / G) convert_steal(p, l + 1, 2, lds, tid, lane, wave); } }
#endif

        xcd_barrier(bar); AMP_WAIT(2) }

{ AMP_T0(3)
#ifndef SKIP_PREP
        for (int rep_ = 0; rep_ < (DUP_PHASE == 3 ? 2 : 1); ++rep_) { LOADP(); PV(); phase_prep_w(p, l, lds, lane, wave, vcu, G); }
#endif

        xcd_barrier(bar); AMP_WAIT(3) }

{ AMP_T0(5)
#ifndef SKIP_SCAN
        for (int rep_ = (DUP_PHASE == 4 ? 1 : 0); rep_ >= 0; --rep_) { LOADP(); PV(); phase_scan(p, tid, vcu, G, rep_); }
#endif
        xcd_barrier(bar); AMP_WAIT(5) }
{ AMP_T0(6)
#ifndef SKIP_HOUT
        for (int rep_ = 0; rep_ < (DUP_PHASE == 6 ? 2 : 1); ++rep_) { LOADP(); PV(); phase_hgrn_out_w(p, l, lds, lane, wave, vcu, G); }
#endif
#ifndef SKIP_ATTN
        for (int rep_ = 0; rep_ < (DUP_PHASE == 5 ? 2 : 1); ++rep_) { LOADP(); PV(); phase_attn(p, l, lds, tid, lane, wave, vcu, G, rep_); }
#endif
        xcd_barrier(bar); AMP_WAIT(6) }

{ AMP_T0(7)
#ifndef SKIP_OUTPROJ
        for (int rep_ = (DUP_PHASE == 7 ? 1 : 0); rep_ >= 0; --rep_) { LOADP(); PV(); unsigned char* ws = p.ws; pg8::Gemm g{(const f16*)(ws + WS_MIX), (const f16*)(ws + WS_WOUT) + (size_t)l * DM * DM, DM, 0}; pg8::StaticOrder S; S.init(TL, DM, G, bx);
          EpiOut E{(f16*)(ws + (rep_ ? WS_DUMMY : WS_DELTA)), (const float*)(ws + WS_MOD) + (size_t)l * 5 * 6144};
          pg8::gemm_phase<EpiOut, pg8::StaticOrder, true, false>(lds, g, S, E, tid);
          if (l < DEPTH - 1) phase_outproj_ctx(p, l, lane, wave, vcu, G, rep_); }
#endif

        xcd_barrier(bar); AMP_WAIT(7) }

{ AMP_T0(8)
#ifndef SKIP_ROUTER
        for (int rep_ = (DUP_PHASE == 8 ? 1 : 0); rep_ >= 0; --rep_) { LOADP(); PV(); if (l > 0 && rep_ == 0) convert_steal(p, l, 1 << 20, lds, tid, lane, wave); phase_router(p, l, lds, tid, lane, wave, vcu, G, rep_); }
#endif

        xcd_barrier(bar); AMP_WAIT(8) }

{ AMP_T0(9)
#ifndef SKIP_MOE1
        for (int rep_ = 0; rep_ < (DUP_PHASE == 9 ? 2 : 1); ++rep_) { LOADP(); PV(); unsigned char* ws = p.ws; const int nblk = moe_setup(p, l, lds, tid, G, bx);
          pg8::Gemm g{(const f16*)(ws + WS_H), (const f16*)(ws + WS_WGU) + (size_t)l * NEXP * 1024 * 1024, DM, (size_t)1024 * 1024};
          pg8::MoeOrder S{G, bx, nblk, (const LAS int*)(lds + BLK_OFF), (const LAS int*)(lds + BLK_OFF) + 40, (const int*)(ws + WS_LIST), DM * 2, (const LAS int*)(lds + BLK_OFF) + 80};
          EpiMoe1 E{(f16*)(ws + WS_HID)};
          pg8::gemm_phase<EpiMoe1, pg8::MoeOrder, true, true>(lds, g, S, E, tid);
          if (l < DEPTH - 1 && rep_ == 0) { const int nu = nblk * 4; if (pg8::moe_unit((nu + G - 1) / G - 1, G, bx, nu) < 0) convert_steal(p, l + 1, 2, lds, tid, lane, wave); } }
#endif

        xcd_barrier(bar); AMP_WAIT(9) }

{ AMP_T0(10)
#ifndef SKIP_MOE2
        for (int rep_ = 0; rep_ < (DUP_PHASE == 10 ? 2 : 1); ++rep_) { LOADP(); PV(); unsigned char* ws = p.ws; const int nblk = ((const LAS int*)(lds + BLK_OFF))[32];
          pg8::Gemm g{(const f16*)(ws + WS_HID), (const f16*)(ws + WS_WD) + (size_t)l * NEXP * 1024 * 512, EH, (size_t)1024 * 512};
          pg8::MoeOrder S{G, bx, nblk, (const LAS int*)(lds + BLK_OFF), (const LAS int*)(lds + BLK_OFF) + 40, (const int*)(ws + WS_LIST), EH * 2, (const LAS int*)(lds + BLK_OFF) + 80};
          EpiMoe2 E{(f16*)(ws + WS_Y2)};
          pg8::gemm_phase<EpiMoe2, pg8::MoeOrder, true, false>(lds, g, S, E, tid);
          if (l < DEPTH - 1 && rep_ == 0) { const int nu = nblk * 4; if (pg8::moe_unit((nu + G - 1) / G - 1, G, bx, nu) < 0) convert_steal(p, l + 1, 1, lds, tid, lane, wave); } }
#endif

        xcd_barrier(bar); AMP_WAIT(10) }

{ AMP_T0(11)
#ifndef SKIP_COMBINE
        for (int rep_ = (DUP_PHASE == 11 ? 1 : 0); rep_ >= 0; --rep_) { LOADP(); PV(); phase_combine(p, l, lds, lane, wave, vcu, G, rep_); }
#endif

        if (l0 < DEPTH - 1) xcd_barrier(bar); AMP_WAIT(11) }
        if (DUP_PHASE == 13) { for (int q_ = 0; q_ < 8; ++q_) xcd_barrier(bar); }

}

__global__ void __launch_bounds__(512, 2) fwd_kernel(Params p_unused) {
    extern __shared__ __attribute__((aligned(16))) unsigned char lds_raw[];
    ldsp lds = (ldsp)lds_raw;
    const int tid0 = threadIdx.x; const int G0 = gridDim.x; const int bx0 = blockIdx.x;
    const int tid = tid0;
    volatile LAS unsigned* MISC = (volatile LAS unsigned*)(lds + MISC_OFF);
    for (int u = tid; u < (LDS_BYTES - MISC_OFF) / 4; u += 512) ((LAS unsigned*)(lds + MISC_OFF))[u] = 0u;
    __syncthreads();
    XcdBarrier bar;
    { LOADP(); bar = xcd_barrier_post((unsigned*)(p.ws + WS_CTL) + CW_BAR, MISC + 8); }


    const int l0 = 0;
#ifndef SKIP_PROLOGUE
    for (int rep_ = 0; rep_ < (DUP_PHASE == 1 ? 2 : 1); ++rep_) { LOADP(); PV(); phase_prologue(p, lds, tid, lane, wave, vcu, G); __syncthreads(); }
#endif

    xcd_barrier(bar);

#ifndef SKIP_MOD0
        for (int rep_ = 0; rep_ < (DUP_PHASE == 12 ? 2 : 1); ++rep_) { LOADP(); PV(); phase_mod0(p, lane, wave, vcu, G); }
#endif

    xcd_barrier(bar);
    layer_body<0>(bar, lds, tid0, G0, bx0, p_unused); layer_body<1>(bar, lds, tid0, G0, bx0, p_unused); layer_body<2>(bar, lds, tid0, G0, bx0, p_unused); layer_body<3>(bar, lds, tid0, G0, bx0, p_unused);
}

extern "C" void kernel_launch(void* const* d_in, const int* in_sizes, int n_in, void* d_out, int out_size, void* d_ws, size_t ws_size, hipStream_t stream) {
    static int grid = 0;
    if (grid == 0) {
        if (n_in != 24 || out_size != TL * DM || ws_size < WS_END) { fprintf(stderr, "kernel_launch: unexpected shapes (n_in %d, out %d, ws %zu < %zu)\n", n_in, out_size, ws_size, (size_t)WS_END); grid = -1; return; }
        int dev = 0, cus = 0, per_cu = 0;
        if (hipGetDevice(&dev) != hipSuccess || hipDeviceGetAttribute(&cus, hipDeviceAttributeMultiprocessorCount, dev) != hipSuccess) { grid = -1; return; }
        if (hipFuncSetAttribute((const void*)fwd_kernel, hipFuncAttributeMaxDynamicSharedMemorySize, LDS_BYTES) != hipSuccess) { fprintf(stderr, "kernel_launch: hipFuncSetAttribute failed\n"); grid = -1; return; }
        if (hipOccupancyMaxActiveBlocksPerMultiprocessor(&per_cu, (const void*)fwd_kernel, 512, LDS_BYTES) != hipSuccess || per_cu < 1) { fprintf(stderr, "kernel_launch: occupancy query reports %d\n", per_cu); }
        (void)hipGetLastError();
        grid = cus;
    }
    if (grid < 0) return;
    (void)hipMemsetAsync((char*)d_ws + WS_CTL, 0, CTL_ZERO_BYTES, stream);
    Params p{};
    const float** pp = (const float**)&p;
    for (int i = 0; i < 24; ++i) pp[i] = (const float*)d_in[i];
    p.out = (float*)d_out; p.ws = (unsigned char*)d_ws;
    hipLaunchKernelGGL(fwd_kernel, dim3(grid), dim3(512), LDS_BYTES, stream, p);
}
```
